# Optimizing an MI355X kernel written in HIP

```python
import math
import jax, jax.numpy as jnp
from jax import lax
import numpy as np

D_MODEL = 1024
BATCH = 16
SEQ = 2048
DEPTH = 2

CHUNK = 64
Q_BLOCK = 128
NORM_EPS = 1e-6

POOL_WIDTH = D_MODEL // 4
POOL_GROUPS = 4
POOL_GROUP_DIM = POOL_WIDTH // POOL_GROUPS
POOL_WINDOWS = (2, 4, 8, 16)
CONV_WIDTH = D_MODEL // 4
CONV_K = 3
SGU_WIDTH = D_MODEL // 4
SGU_GROUPS = 4
SGU_GROUP_DIM = SGU_WIDTH // SGU_GROUPS
SGU_SEG = 128
DIFF_HEADS = 4
DIFF_QK_DIM = 64
DIFF_V_DIM = 2 * DIFF_QK_DIM
ATTN_WIDTH = DIFF_HEADS * DIFF_V_DIM
REL_BUCKETS = 32
REL_MAX_DIST = 128
N_SOFTMAX_MAPS = 2 * DIFF_HEADS
N_BRANCH = 4
D_FF = 2816
N_EXPERTS = 8
TOP_K = 2
D_FF_EXPERT = 3584
N_DENSE = (DEPTH + 1) // 2
N_MOE = DEPTH // 2

OFF_POOL = 0
OFF_CONV = OFF_POOL + POOL_WIDTH
OFF_SGU = OFF_CONV + 3 * CONV_WIDTH
OFF_ATTN = OFF_SGU + 2 * SGU_WIDTH
OFF_GATE = OFF_ATTN + 3 * ATTN_WIDTH
IN_COLS = OFF_GATE + N_BRANCH * D_MODEL

kernel_name = "hybrid_pool_conv_sgu_diffattn_moe"


def rms_norm(x, g):
    xf = x.astype(jnp.float32)
    y = xf * lax.rsqrt(jnp.mean(xf * xf, axis=-1, keepdims=True) + NORM_EPS)
    return (y * g.astype(jnp.float32)).astype(x.dtype)


def pool_mixer(a, pool_w, pool_scale):
    b_, s_, _ = a.shape
    af = a.astype(jnp.float32).reshape(b_, s_, POOL_GROUPS, POOL_GROUP_DIM)
    cs = jnp.pad(jnp.cumsum(af, axis=1), ((0, 0), (1, 0), (0, 0), (0, 0)))
    pos = jnp.arange(s_)
    outs = []
    for g, w in enumerate(POOL_WINDOWS):
        upper = cs[:, 1:, g]
        lower = jnp.pad(cs[:, :s_ + 1 - w, g], ((0, 0), (w - 1, 0), (0, 0)))
        count = jnp.minimum(pos + 1, w).astype(jnp.float32)[None, :, None]
        outs.append((upper - lower) / count - af[:, :, g])
    pooled = jnp.stack(outs, axis=2).astype(a.dtype)
    mixed = jnp.einsum('bsgc,gcd->bsgd', pooled, pool_w).reshape(b_, s_, POOL_WIDTH)
    return mixed * pool_scale


def short_conv_mixer(b_gate, c_gate, hin, conv_w):
    z = c_gate * hin
    y = lax.conv_general_dilated(
        z, conv_w[:, None, :].astype(z.dtype), window_strides=(1,),
        padding=((CONV_K - 1, 0),), dimension_numbers=('NWC', 'WIO', 'NWC'),
        feature_group_count=CONV_WIDTH)
    return b_gate * y


def spatial_gating_mixer(u, v, ln_g, sgu_w, sgu_b):
    b_, s_, _ = v.shape
    vf = v.astype(jnp.float32)
    mu = jnp.mean(vf, axis=-1, keepdims=True)
    var = jnp.mean(jnp.square(vf - mu), axis=-1, keepdims=True)
    vn = ((vf - mu) * lax.rsqrt(var + NORM_EPS) * ln_g.astype(jnp.float32)).astype(v.dtype)
    vn = vn.reshape(b_, s_ // SGU_SEG, SGU_SEG, SGU_GROUPS, SGU_GROUP_DIM)
    tri = jnp.tril(jnp.ones((SGU_SEG, SGU_SEG), dtype=bool))
    w = jnp.where(tri[None], sgu_w, 0.0)
    s = jnp.einsum('gpq,bnqgc->bnpgc', w, vn) + sgu_b.T[None, None, :, :, None]
    return u * s.reshape(b_, s_, SGU_WIDTH)


def rel_buckets(q_pos, k_pos):
    rel = k_pos[None, :] - q_pos[:, None]
    nb = REL_BUCKETS // 2
    max_exact = nb // 2
    n = jnp.abs(rel)
    nf = jnp.maximum(n, 1).astype(jnp.float32)
    large = max_exact + (jnp.log(nf / max_exact) / math.log(REL_MAX_DIST / max_exact)
                         * (nb - max_exact)).astype(jnp.int32)
    large = jnp.minimum(large, nb - 1)
    return jnp.where(rel > 0, nb, 0) + jnp.where(n < max_exact, n, large)


def diff_attention(q, k, v, rel_bias, q_g, k_g, lam, subln_g, lam_init):
    b_, s_ = q.shape[0], q.shape[1]
    q = rms_norm(q, q_g).transpose(0, 2, 3, 1, 4)
    k = rms_norm(k, k_g).transpose(0, 2, 3, 1, 4)
    v = v.transpose(0, 2, 1, 3)
    scale = DIFF_QK_DIM ** -0.5
    pos = jnp.arange(s_)
    outs = []
    for i in range(s_ // Q_BLOCK):
        q0 = i * Q_BLOCK
        k_end = q0 + Q_BLOCK
        qb = q[:, :, :, q0:k_end]
        kb = k[:, :, :, :k_end]
        vb = v[:, :, :k_end]
        qp = pos[q0:k_end]
        kp = pos[:k_end]
        bias = rel_bias[rel_buckets(qp, kp)].astype(jnp.float32)
        bias = bias.reshape(Q_BLOCK, k_end, DIFF_HEADS, 2).transpose(2, 3, 0, 1)
        mask = (qp[:, None] // CHUNK) >= (kp[None, :] // CHUNK)
        logits = jnp.einsum('bhmqd,bhmkd->bhmqk', qb, kb).astype(jnp.float32) * scale + bias
        logits = jnp.where(mask, logits, -jnp.inf)
        p = jax.nn.softmax(logits, axis=-1)
        a = (p[:, :, 0] - lam * p[:, :, 1]).astype(vb.dtype)
        outs.append(jnp.einsum('bhqk,bhkd->bhqd', a, vb))
    o = jnp.concatenate(outs, axis=2)
    o = rms_norm(o, subln_g) * (1.0 - lam_init)
    return o.transpose(0, 2, 1, 3).reshape(b_, s_, ATTN_WIDTH)


def swiglu(x, w_gate_up, w_down):
    g, u = jnp.split(x @ w_gate_up, 2, axis=-1)
    return (jax.nn.silu(g) * u) @ w_down


def moe_swiglu(xn, router_w, w_gate_up, w_down):
    b_, s_, d_ = xn.shape
    xf = xn.reshape(-1, d_)
    logits = (xf @ router_w).astype(jnp.float32)
    top_v, top_i = lax.top_k(logits, TOP_K)
    top_w = jax.nn.softmax(top_v, axis=-1)
    combine = jnp.sum(jax.nn.one_hot(top_i, N_EXPERTS, dtype=jnp.float32) * top_w[..., None],
                      axis=1).astype(xn.dtype)
    out = jnp.zeros_like(xf)
    for e in range(N_EXPERTS):
        out = out + combine[:, e:e + 1] * swiglu(xf, w_gate_up[e], w_down[e])
    return out.reshape(b_, s_, d_)


def token_mixer(xn, layer, lam_init, rel_bias, w_in, pool_w, pool_scale, conv_w, sgu_ln_g,
                sgu_w, sgu_b, q_norm_g, k_norm_g, diff_lambda, subln_g, w_branch_pool,
                w_branch_conv, w_branch_sgu, w_branch_attn, w_out):
    b_, s_, _ = xn.shape
    z = xn @ w_in[layer]
    y_a = pool_mixer(z[..., OFF_POOL:OFF_CONV], pool_w[layer], pool_scale[layer])
    b_gate, c_gate, hin = jnp.split(z[..., OFF_CONV:OFF_SGU], 3, axis=-1)
    y_b = short_conv_mixer(b_gate, c_gate, hin, conv_w[layer])
    u, v = jnp.split(jax.nn.gelu(z[..., OFF_SGU:OFF_ATTN], approximate=False), 2, axis=-1)
    y_c = spatial_gating_mixer(u, v, sgu_ln_g[layer], sgu_w[layer], sgu_b[layer])
    q, k, va = jnp.split(z[..., OFF_ATTN:OFF_GATE], 3, axis=-1)
    q = q.reshape(b_, s_, DIFF_HEADS, 2, DIFF_QK_DIM)
    k = k.reshape(b_, s_, DIFF_HEADS, 2, DIFF_QK_DIM)
    va = va.reshape(b_, s_, DIFF_HEADS, DIFF_V_DIM)
    lp = diff_lambda[layer].astype(jnp.float32)
    lam = jnp.exp(jnp.sum(lp[0] * lp[1])) - jnp.exp(jnp.sum(lp[2] * lp[3])) + lam_init
    y_d = diff_attention(q, k, va, rel_bias, q_norm_g[layer], k_norm_g[layer], lam,
                         subln_g[layer], lam_init)
    gates = jax.nn.sigmoid(z[..., OFF_GATE:].reshape(b_, s_, N_BRANCH, D_MODEL))
    merged = (gates[:, :, 0] * (y_a @ w_branch_pool[layer])
              + gates[:, :, 1] * (y_b @ w_branch_conv[layer])
              + gates[:, :, 2] * (y_c @ w_branch_sgu[layer])
              + gates[:, :, 3] * (y_d @ w_branch_attn[layer]))
    return merged @ w_out[layer]


def setup_inputs(seed: int = 0) -> dict:
    key = jax.random.key(seed)
    ks = jax.random.split(key, 32)
    f32 = jnp.float32
    L = DEPTH

    def nrm(k, shape, scale):
        return jax.random.normal(k, shape, f32) * scale

    def gain(k, shape):
        return 1.0 + 0.02 * jax.random.normal(k, shape, f32)

    return {
        "x": jax.random.normal(ks[0], (BATCH, SEQ, D_MODEL), f32),
        "rel_bias": nrm(ks[1], (REL_BUCKETS, N_SOFTMAX_MAPS), 0.5),
        "norm1_g": gain(ks[2], (L, D_MODEL)),
        "w_in": nrm(ks[3], (L, D_MODEL, IN_COLS), D_MODEL ** -0.5),
        "pool_w": nrm(ks[4], (L, POOL_GROUPS, POOL_GROUP_DIM, POOL_GROUP_DIM), POOL_GROUP_DIM ** -0.5),
        "pool_scale": 1.0 + 0.1 * jax.random.normal(ks[5], (L, POOL_WIDTH), f32),
        "conv_w": nrm(ks[6], (L, CONV_K, CONV_WIDTH), CONV_K ** -0.5),
        "sgu_ln_g": gain(ks[7], (L, SGU_WIDTH)),
        "sgu_w": nrm(ks[8], (L, SGU_GROUPS, SGU_SEG, SGU_SEG), SGU_SEG ** -0.5),
        "sgu_b": 1.0 + 0.1 * jax.random.normal(ks[9], (L, SGU_GROUPS, SGU_SEG), f32),
        "q_norm_g": gain(ks[10], (L, DIFF_QK_DIM)),
        "k_norm_g": gain(ks[11], (L, DIFF_QK_DIM)),
        "diff_lambda": nrm(ks[12], (L, 4, DIFF_QK_DIM), 0.1),
        "subln_g": gain(ks[13], (L, DIFF_V_DIM)),
        "w_branch_pool": nrm(ks[14], (L, POOL_WIDTH, D_MODEL), POOL_WIDTH ** -0.5),
        "w_branch_conv": nrm(ks[15], (L, CONV_WIDTH, D_MODEL), CONV_WIDTH ** -0.5),
        "w_branch_sgu": nrm(ks[16], (L, SGU_WIDTH, D_MODEL), SGU_WIDTH ** -0.5),
        "w_branch_attn": nrm(ks[17], (L, ATTN_WIDTH, D_MODEL), ATTN_WIDTH ** -0.5),
        "w_out": nrm(ks[18], (L, D_MODEL, D_MODEL), D_MODEL ** -0.5),
        "norm2_g": gain(ks[19], (L, D_MODEL)),
        "ffn_w_gate_up": nrm(ks[20], (N_DENSE, D_MODEL, 2 * D_FF), D_MODEL ** -0.5),
        "ffn_w_down": nrm(ks[21], (N_DENSE, D_FF, D_MODEL), D_FF ** -0.5),
        "router_w": nrm(ks[22], (N_MOE, D_MODEL, N_EXPERTS), D_MODEL ** -0.5),
        "moe_w_gate_up": nrm(ks[23], (N_MOE, N_EXPERTS, D_MODEL, 2 * D_FF_EXPERT), D_MODEL ** -0.5),
        "moe_w_down": nrm(ks[24], (N_MOE, N_EXPERTS, D_FF_EXPERT, D_MODEL), D_FF_EXPERT ** -0.5),
    }


def reference(x, rel_bias, norm1_g, w_in, pool_w, pool_scale, conv_w, sgu_ln_g, sgu_w, sgu_b,
              q_norm_g, k_norm_g, diff_lambda, subln_g, w_branch_pool, w_branch_conv,
              w_branch_sgu, w_branch_attn, w_out, norm2_g, ffn_w_gate_up, ffn_w_down,
              router_w, moe_w_gate_up, moe_w_down):
    h = x
    for layer in range(DEPTH):
        lam_init = 0.8 - 0.6 * math.exp(-0.3 * layer)
        xn = rms_norm(h, norm1_g[layer])
        h = h + token_mixer(xn, layer, lam_init, rel_bias, w_in, pool_w, pool_scale, conv_w,
                            sgu_ln_g, sgu_w, sgu_b, q_norm_g, k_norm_g, diff_lambda, subln_g,
                            w_branch_pool, w_branch_conv, w_branch_sgu, w_branch_attn, w_out)
        hn = rms_norm(h, norm2_g[layer])
        if layer % 2 == 0:
            h = h + swiglu(hn, ffn_w_gate_up[layer // 2], ffn_w_down[layer // 2])
        else:
            h = h + moe_swiglu(hn, router_w[layer // 2], moe_w_gate_up[layer // 2],
                               moe_w_down[layer // 2])
    return h
```

```cpp
#include <hip/hip_runtime.h>
#include <stdint.h>
#include <stdio.h>

typedef unsigned short bf16_t;
constexpr int T = 32768, D = 1024, SEQ = 2048;
constexpr int INC = 7168;
constexpr int ZP = 3072;
constexpr int OFF_POOL = 0, OFF_CONV = 256, OFF_SGU = 1024, OFF_ATTN = 1536, OFF_GATE = 3072;
constexpr int DFF = 2816, DFE = 3584, NE = 8;
constexpr int YW = 1280;
constexpr float EPS = 1e-6f;

__device__ __forceinline__ float bf2f(bf16_t v) { return __uint_as_float((unsigned)v << 16); }
__device__ __forceinline__ bf16_t f2bf(float f) { unsigned u = __float_as_uint(f); return (bf16_t)((u + 0x7fffu + ((u >> 16) & 1u)) >> 16); }
template <int CTRL> __device__ __forceinline__ float dpp_(float x) { return __builtin_bit_cast(float, __builtin_amdgcn_mov_dpp(__builtin_bit_cast(int, x), CTRL, 0xf, 0xf, true)); }
__device__ __forceinline__ float sum_xor16(float x) { auto s_ = __builtin_amdgcn_permlane16_swap(__float_as_uint(x), __float_as_uint(x), false, false); return __uint_as_float(s_[0]) + __uint_as_float(s_[1]); }
__device__ __forceinline__ float sum_xor32(float x) { auto s_ = __builtin_amdgcn_permlane32_swap(__float_as_uint(x), __float_as_uint(x), false, false); return __uint_as_float(s_[0]) + __uint_as_float(s_[1]); }
__device__ __forceinline__ float max_xor16(float x) { auto s_ = __builtin_amdgcn_permlane16_swap(__float_as_uint(x), __float_as_uint(x), false, false); return fmaxf(__uint_as_float(s_[0]), __uint_as_float(s_[1])); }
__device__ __forceinline__ float max_xor32(float x) { auto s_ = __builtin_amdgcn_permlane32_swap(__float_as_uint(x), __float_as_uint(x), false, false); return fmaxf(__uint_as_float(s_[0]), __uint_as_float(s_[1])); }
__device__ __forceinline__ float quad_sum(float v) { v += dpp_<0xB1>(v); v += dpp_<0x4E>(v); return v; }
__device__ __forceinline__ float wave_sum(float v) {
    v += dpp_<0xB1>(v); v += dpp_<0x4E>(v); v += dpp_<0x141>(v); v += dpp_<0x128>(v);
    return sum_xor32(sum_xor16(v));
}
__device__ __forceinline__ float wave_max(float v) {
    v = fmaxf(v, dpp_<0xB1>(v)); v = fmaxf(v, dpp_<0x4E>(v)); v = fmaxf(v, dpp_<0x141>(v)); v = fmaxf(v, dpp_<0x128>(v));
    return max_xor32(max_xor16(v));
}

__device__ __forceinline__ int rel_bucket(int rel) {
    const int n = rel < 0 ? -rel : rel; int v;
    if (n < 8) v = n; else if (n < 12) v = 8; else if (n < 16) v = 9; else if (n < 23) v = 10; else if (n < 32) v = 11; else if (n < 46) v = 12; else if (n < 64) v = 13; else if (n < 91) v = 14; else v = 15;
    return (rel > 0 ? 16 : 0) + v;
}


#define GAS __attribute__((address_space(1)))
#define LAS __attribute__((address_space(3)))
typedef float f32x4 __attribute__((ext_vector_type(4)));
typedef float f32x2 __attribute__((ext_vector_type(2)));
typedef short bf16x8 __attribute__((ext_vector_type(8)));
typedef unsigned u32x4 __attribute__((ext_vector_type(4)));
typedef unsigned u32x2 __attribute__((ext_vector_type(2)));
typedef int i32x4 __attribute__((ext_vector_type(4)));
typedef int i32x8 __attribute__((ext_vector_type(8)));

constexpr int NWAVES = 8;
constexpr size_t MiB = 1u << 20;
constexpr size_t WS_CTL = 0, CTL_ZERO_BYTES = 64 * 1024;
constexpr size_t WS_CNT = 64 * 1024;
constexpr size_t WS_TOKE = 128 * 1024;
constexpr size_t WS_TOKW = WS_TOKE + 256 * 1024;
constexpr size_t WS_SLOTT = WS_TOKW + 256 * 1024;
constexpr size_t WS_SLOTW = WS_SLOTT + 320 * 1024;
constexpr size_t WS_W = 4 * MiB;
constexpr size_t WOFF_IN = 0;
constexpr size_t WOFF_MRG = WOFF_IN + 2ull * 7168 * 1024 * 2;
constexpr size_t WOFF_OUT = WOFF_MRG + 2ull * 1024 * 1280 * 2;
constexpr size_t WOFF_FGU = WOFF_OUT + 2ull * 1024 * 1024 * 2;
constexpr size_t WOFF_FDN = WOFF_FGU + 5632ull * 1024 * 2;
constexpr size_t WOFF_MGU = WOFF_FDN + 1024ull * 2816 * 2;
constexpr size_t WOFF_XN8 = WOFF_MGU + 56 * MiB;
constexpr size_t WOFF_IN8 = WOFF_MGU + 88 * MiB;
constexpr size_t WOFF_MDN = WOFF_MGU + 8ull * 7168 * 1024 * 2;
constexpr size_t WOFF_SGU = WOFF_MDN + 8ull * 1024 * 3584 * 2;
constexpr size_t WOFF_POOL = WOFF_SGU + 2ull * 4 * 128 * 128 * 2;
constexpr size_t W_BYTES = WOFF_POOL + 2ull * 4 * 64 * 64 * 2;
static_assert(W_BYTES <= 222 * MiB, "weights");
constexpr size_t WS_XN = WS_W + 222 * MiB;
constexpr size_t WS_Z = WS_XN + 64 * MiB;
constexpr size_t WS_G = WS_Z + 192 * MiB;
constexpr size_t WS_Y = WS_Z + 448 * MiB;
constexpr size_t WS_HS = WS_Y + 80 * MiB;
constexpr size_t WS_END = WS_HS + 64 * MiB;
constexpr int SLOT_CAP = 69632;

constexpr int CW_BAR = 1024;
constexpr int RING_BYTES = 131072;
constexpr int MISC_OFF = RING_BYTES + 12288;
constexpr int TG_OFF = MISC_OFF + 256;
constexpr int LDS_BYTES = 151552;

#define XB_TMO      128
#define XB_XCNT(j)  (256  + 64 * (j))
#define XB_XSUB(j)  (1280 + 64 * (j))
#define XB_XGEN(j)  (2304 + 64 * (j))
#define XB_TOP      3328
#define XB_TOPGEN   3392
#define XCD_BAR_WORDS 3456
#define XB_SPIN_CAP (1u << 22)
__device__ __forceinline__ unsigned xb_ld(unsigned* p)              { return __hip_atomic_load(p, __ATOMIC_RELAXED, __HIP_MEMORY_SCOPE_AGENT); }
__device__ __forceinline__ unsigned xb_add(unsigned* p, unsigned v) { return __hip_atomic_fetch_add(p, v, __ATOMIC_RELAXED, __HIP_MEMORY_SCOPE_AGENT); }
__device__ __forceinline__ unsigned xb_xcc_id() { return (unsigned)__builtin_amdgcn_s_getreg((3 << 11) | 20) & 0xFu; }
#define XB_SPIN(cond, bar) do { unsigned _sp = 0; while (cond) { __builtin_amdgcn_s_sleep(1); \
    if ((++_sp & 255u) == 0u) { if (xb_ld(&(bar)[XB_TMO])) break; if (_sp > XB_SPIN_CAP) { atomicAdd(&(bar)[XB_TMO], 1u); break; } } } } while (0)
__device__ __forceinline__ int lane_id() { unsigned m = ~0u; asm volatile("" : "+s"(m)); return (int)__builtin_amdgcn_mbcnt_hi(m, __builtin_amdgcn_mbcnt_lo(m, 0u)); }
struct XcdBarrier { unsigned* bar; unsigned x; volatile LAS unsigned* st; int wave; };
__device__ __forceinline__ XcdBarrier xcd_barrier_post(unsigned* bar, volatile LAS unsigned* st, int wave) {
    XcdBarrier b; b.bar = bar; b.x = xb_xcc_id(); b.st = st; b.wave = wave;
    if (threadIdx.x == 0) (void)xb_add(&bar[XB_XCNT(b.x)], 1u);
    return b;
}
__device__ __forceinline__ void xcd_barrier_complete(unsigned* bar, unsigned x, unsigned& nloc, unsigned& nx) {
    const unsigned G = gridDim.x * gridDim.y * gridDim.z;
    unsigned sum, cnt, mine, sp = 0u;
    for (;;) {
        sum = 0u; cnt = 0u; mine = 0u;
#pragma unroll
        for (unsigned j = 0; j < 16; ++j) { const unsigned c = xb_ld(&bar[XB_XCNT(j)]); sum += c; cnt += (c > 0u) ? 1u : 0u; mine = (j == x) ? c : mine; }
        if (sum == G) break;
        __builtin_amdgcn_s_sleep(1);
        if ((++sp & 255u) == 0u) { if (xb_ld(&bar[XB_TMO])) break; if (sp > XB_SPIN_CAP) { atomicAdd(&bar[XB_TMO], 1u); break; } }
    }
    nloc = mine > 0u ? mine : 1u; nx = cnt > 0u ? cnt : 1u;
}
__device__ __forceinline__ void xcd_barrier(const XcdBarrier& b) {
    asm volatile("s_waitcnt vmcnt(0)" ::: "memory");
    __syncthreads();
    if (b.wave == 0 && lane_id() == 0) {
        unsigned* bar = b.bar; unsigned bx_ = b.x;
        asm volatile("" : "+s"(bar), "+s"(bx_));
        __builtin_amdgcn_s_waitcnt(0);
        unsigned nloc = b.st[0], nx = b.st[1];
        if (nloc == 0u) { xcd_barrier_complete(bar, bx_, nloc, nx); b.st[0] = nloc; b.st[1] = nx; }
        const unsigned old = xb_add(&bar[XB_XSUB(bx_)], 1u);
        const unsigned gen = old / nloc;
        if (old + 1u == (gen + 1u) * nloc) {
            __builtin_amdgcn_fence(__ATOMIC_RELEASE, "agent");
            asm volatile("s_waitcnt vmcnt(0)" ::: "memory");
            const unsigned og = xb_add(&bar[XB_TOP], 1u);
            const unsigned tg = og / nx;
            if (og + 1u == (tg + 1u) * nx) xb_add(&bar[XB_TOPGEN], 1u);
            else XB_SPIN(xb_ld(&bar[XB_TOPGEN]) == tg, bar);
            __builtin_amdgcn_fence(__ATOMIC_ACQUIRE, "agent");
            xb_add(&bar[XB_XGEN(bx_)], 1u);
            asm volatile("s_waitcnt vmcnt(0)" ::: "memory");
        } else {
            XB_SPIN(xb_ld(&bar[XB_XGEN(bx_)]) == gen, bar);
            __builtin_amdgcn_fence(__ATOMIC_ACQUIRE, "agent");
            asm volatile("s_waitcnt vmcnt(0)" ::: "memory");
        }
    }
    __syncthreads();
}

namespace pg8 {
constexpr int BM = 256, BK = 64, HALF = 128, HTB = HALF * BK * 2, STAGE_BYTES = 8 * HTB, NXCD = 8;
#ifndef WGM_BIG
#define WGM_BIG 2
#endif
#ifndef WGM_SMALL
#define WGM_SMALL 4
#endif
__host__ __device__ __forceinline__ int lds_byte(int r, int c) { const int st = (r >> 4) * 2 + (c >> 5), rr = r & 15, cc = c & 31, ob = rr * 64 + cc * 2; return st * 1024 + (ob ^ (((ob >> 9) & 1) << 5)); }
__host__ __device__ __forceinline__ void stage_rc(int b, int& R, int& C) { const int st = b / 1024, sb = b % 1024, swz = sb ^ (((sb >> 9) & 1) << 5); R = (st >> 1) * 16 + swz / 64; C = (st & 1) * 32 + (swz % 64) / 2; }
__host__ __device__ __forceinline__ int perm32(int rho) { const int n = rho >> 4, i = rho & 15; return 8 * (i >> 2) + 4 * n + (i & 3); }

struct Unit { int pm, pn, kb, nt, idx; const char* B; };
struct Gemm { const char* A; int lda, ldb; };

__device__ __forceinline__ bool static_tile(int nM, int nN, int G, int c, int i, int& pm, int& pn) {
    const int WGM = nN > 4 ? WGM_BIG : WGM_SMALL;
    const int nwg = nM * nN; const long L = (long)i * G + c; if (L >= nwg) return false;
    int wgid = (int)L; { const int q = nwg / NXCD, r = nwg % NXCD, xcd = wgid % NXCD, off = wgid / NXCD; wgid = (xcd < r ? xcd * (q + 1) : r * (q + 1) + (xcd - r) * q) + off; }
    const int nig = WGM * nN, gid = wgid / nig, fm = gid * WGM, gsz = (nM - fm) < WGM ? (nM - fm) : WGM;
    pm = fm + ((wgid % nig) % gsz); pn = (wgid % nig) / gsz; return true;
}
struct SchedPlain {
    static constexpr bool GATHER = false;
    int nM, nN, G, c, nt; const char* B;
    __device__ __forceinline__ bool next(int i, Unit& u) const { if (!static_tile(nM, nN, G, c, i, u.pm, u.pn)) return false; u.kb = 0; u.nt = nt; u.B = B; return true; }
    __device__ __forceinline__ int arow(const Unit& u, int r) const { return u.pm * BM + r; }
};
struct SchedPlainRev {
    static constexpr bool GATHER = false;
    int nM, nN, G, c, nt; const char* B;
    __device__ __forceinline__ bool next(int i, Unit& u) const { if (!static_tile(nM, nN, G, c, i, u.pm, u.pn)) return false; u.pm = nM - 1 - u.pm; u.kb = 0; u.nt = nt; u.B = B; return true; }
    __device__ __forceinline__ int arow(const Unit& u, int r) const { return u.pm * BM + r; }
};
struct SchedPlainOff {
    static constexpr bool GATHER = false;
    int nM, nN, pn0, G, c, nt; const char* B;
    __device__ __forceinline__ bool next(int i, Unit& u) const { if (!static_tile(nM, nN, G, c, i, u.pm, u.pn)) return false; u.pn += pn0; u.kb = 0; u.nt = nt; u.B = B; return true; }
    __device__ __forceinline__ int arow(const Unit& u, int r) const { return u.pm * BM + r; }
};
struct SchedMerge {
    static constexpr bool GATHER = false;
    int nM, nN, G, c; const char* B;
    __device__ __forceinline__ bool next(int i, Unit& u) const { if (!static_tile(nM, nN, G, c, i >> 2, u.pm, u.pn)) return false; const int br = i & 3; u.kb = br * 512; u.nt = br == 3 ? 8 : 4; u.idx = i; u.B = B; return true; }
    __device__ __forceinline__ int arow(const Unit& u, int r) const { return u.pm * BM + r; }
};
struct SchedMoe1 {
    static constexpr bool GATHER = true;
    int nT, G, c; const char* B; const int* slot_tok; const LAS int* tg;
    __device__ __forceinline__ bool next(int i, Unit& u) const { if (!static_tile(nT, 28, G, c, i, u.pm, u.pn)) return false; u.kb = 0; u.nt = 8; u.B = B + (size_t)(__builtin_amdgcn_readfirstlane(tg[u.pm]) & 7) * (7168ull * 1024); return true; }
    __device__ __forceinline__ int arow(const Unit& u, int r) const { const int t = slot_tok[u.pm * BM + r]; return t < 0 ? 0 : t; }
};
struct SchedMoe2 {
    static constexpr bool GATHER = false;
    int t0, nT, G, c; const char* B; const LAS int* tg;
    __device__ __forceinline__ bool next(int i, Unit& u) const { if (!static_tile(nT, 4, G, c, i, u.pm, u.pn)) return false; u.pm = t0 + nT - 1 - u.pm; u.kb = 0; u.nt = 28; u.B = B + (size_t)(__builtin_amdgcn_readfirstlane(tg[u.pm]) & 7) * (1024ull * 3584); return true; }
    __device__ __forceinline__ int arow(const Unit& u, int r) const { return u.pm * BM + r; }
};

struct SchedMoe3 {
    static constexpr bool GATHER = false;
    int s0, s1, t1, G, c; const char* B; const LAS int* tg;
    __device__ __forceinline__ bool next(int i, Unit& u) const { const int L = i * G + c; if (L >= (s0 + s1) * 16) return false; const int kp = L & 3, st = L >> 4;
        u.pn = (L >> 2) & 3; u.pm = st < s0 ? 128 + st : t1 + 128 + (st - s0); u.kb = (kp < 2 ? kp * 8 : 16 + (kp - 2) * 6) * 128; u.nt = kp < 2 ? 8 : 6; u.B = B + (size_t)(__builtin_amdgcn_readfirstlane(tg[u.pm]) & 7) * (1024ull * 3584); return true; }
    __device__ __forceinline__ int arow(const Unit& u, int r) const { return u.pm * BM + r; }
};

__device__ __forceinline__ unsigned cvt_pk_bf16(float lo, float hi) { unsigned r; asm volatile("v_cvt_pk_bf16_f32 %0, %1, %2" : "=v"(r) : "v"(lo), "v"(hi)); return r; }
__device__ __forceinline__ f32x2 gelu_pk(f32x2 v) {
    const f32x2 av = __builtin_elementwise_abs(v), d = av * 0.2316418882f + 1.0f;
    f32x2 t; t.x = __builtin_amdgcn_rcpf(d.x); t.y = __builtin_amdgcn_rcpf(d.y);
    f32x2 q = t * 0.5307027145f + (-0.7265760135f); q = q * t + 0.7107068705f; q = q * t + (-0.142248368f); q = q * t + 0.127414796f; q = q * t;
    const f32x2 s = (v * v) * (-0.72134752044f);
    f32x2 e; e.x = __builtin_amdgcn_exp2f(s.x); e.y = __builtin_amdgcn_exp2f(s.y);
    const f32x2 m = v * (q * e), r = v - m;
    f32x2 o; o.x = v.x < 0.f ? m.x : r.x; o.y = v.y < 0.f ? m.y : r.y; return o;
}
__device__ __forceinline__ void swiglu8(const f32x4 G0, const f32x4 G1, const f32x4 U0, const f32x4 U1, float negl, float c2, f32x4& v0, f32x4& v1) {
    const f32x4 a0 = G0 * negl, a1 = G1 * negl;
    f32x4 e0, e1;
#pragma unroll
    for (int j = 0; j < 4; ++j) { e0[j] = __builtin_amdgcn_exp2f(a0[j]); e1[j] = __builtin_amdgcn_exp2f(a1[j]); }
    const f32x4 p0 = (G0 * U0) * c2, p1 = (G1 * U1) * c2;
    const f32x4 d0 = e0 + 1.0f, d1 = e1 + 1.0f;
    f32x4 r0, r1;
#pragma unroll
    for (int j = 0; j < 4; ++j) { r0[j] = __builtin_amdgcn_rcpf(d0[j]); r1[j] = __builtin_amdgcn_rcpf(d1[j]); }
    v0 = p0 * r0; v1 = p1 * r1;
}
__device__ __forceinline__ void sigm8(f32x4& v0, f32x4& v1, float negl) {
    const f32x4 a0 = v0 * negl, a1 = v1 * negl;
    f32x4 e0, e1;
#pragma unroll
    for (int j = 0; j < 4; ++j) { e0[j] = __builtin_amdgcn_exp2f(a0[j]); e1[j] = __builtin_amdgcn_exp2f(a1[j]); }
    const f32x4 d0 = e0 + 1.0f, d1 = e1 + 1.0f;
#pragma unroll
    for (int j = 0; j < 4; ++j) { v0[j] = __builtin_amdgcn_rcpf(d0[j]); v1[j] = __builtin_amdgcn_rcpf(d1[j]); }
}
__device__ __forceinline__ float sigm(float v) { return __builtin_amdgcn_rcpf(1.0f + __builtin_amdgcn_exp2f(-1.44269504089f * v)); }

template <bool IN8>
struct EpiZ {
    static constexpr bool PERM = true, CHAIN = false;
    bf16_t* Z; bf16_t* Gt; const float* qg; const float* kg; LAS float* X;
    __device__ __forceinline__ void operator()(const f32x4 (&acc)[2][2][4][2], const Unit& u, int wr, int wc, int fr, int fq) const {
        asm volatile("" : "+v"(fr), "+v"(fq));
        const int row0 = u.pm * BM + wr * 64 + fr, col0 = u.pn * BM + wc * 32 + 8 * fq;
        const int mode = (u.pn >= 12) ? 2 : ((u.pn == 4 || u.pn == 5) ? 1 : ((u.pn >= 6 && u.pn <= 9) ? 3 : 0));
        const unsigned toff = (unsigned)(((wr * 4 + wc) * 64 + fq * 16 + fr) * 16);
        const int gti = u.pn - 12;
        char* gbase = (char*)Gt + (size_t)(((gti >> 2) * 128 + u.pm) * 4 + (gti & 3)) * 131072 + toff;
        float rs[2][4][2];
#pragma unroll
        for (int ai = 0; ai < 2; ++ai)
#pragma unroll
            for (int m = 0; m < 4; ++m) { rs[ai][m][0] = 1.f; rs[ai][m][1] = 1.f; }
        f32x4 g0 = {1.f, 1.f, 1.f, 1.f}, g1 = {1.f, 1.f, 1.f, 1.f};
        if (mode == 3) {
#pragma unroll
            for (int ai = 0; ai < 2; ++ai)
#pragma unroll
                for (int m = 0; m < 4; ++m)
#pragma unroll
                    for (int bj = 0; bj < 2; ++bj) { const f32x4 v0 = acc[ai][bj][m][0], v1 = acc[ai][bj][m][1];
                        float ss = (v0[0] * v0[0] + v0[1] * v0[1]) + (v0[2] * v0[2] + v0[3] * v0[3]) + (v1[0] * v1[0] + v1[1] * v1[1]) + (v1[2] * v1[2] + v1[3] * v1[3]);
                        ss = sum_xor32(sum_xor16(ss));
                        if (fq == 0) X[((ai * 128 + wr * 64 + m * 16 + fr) * 2 + bj) * 4 + wc] = ss;
                        rs[ai][m][bj] = ss; }
            asm volatile("s_waitcnt lgkmcnt(0)\n\ts_barrier" ::: "memory");
#pragma unroll
            for (int ai = 0; ai < 2; ++ai)
#pragma unroll
                for (int m = 0; m < 4; ++m)
#pragma unroll
                    for (int bj = 0; bj < 2; ++bj) rs[ai][m][bj] = rsqrtf((rs[ai][m][bj] + X[((ai * 128 + wr * 64 + m * 16 + fr) * 2 + bj) * 4 + (wc ^ 1)]) * (1.0f / 64.0f) + EPS);
            const float* gp = (u.pn < 8 ? qg : kg) + 32 * (wc & 1) + 8 * fq;
            const float qs_ = u.pn < 8 ? 0.125f * 1.4426950408889634f : 1.0f;
            g0 = *(const f32x4*)gp * qs_; g1 = *(const f32x4*)(gp + 4) * qs_;
            asm volatile("s_waitcnt lgkmcnt(0)\n\ts_barrier" ::: "memory");
        }
#pragma unroll
        for (int ai = 0; ai < 2; ++ai)
#pragma unroll
            for (int m = 0; m < 4; ++m) { bf16_t* rowp = Z + (size_t)(row0 + ai * HALF + m * 16) * ZP + col0;
#pragma unroll
                for (int bj = 0; bj < 2; ++bj) { f32x4 v0 = acc[ai][bj][m][0], v1 = acc[ai][bj][m][1];
                    if (mode == 1) { f32x2 a = gelu_pk((f32x2){v0[0], v0[1]}), b = gelu_pk((f32x2){v0[2], v0[3]}), c = gelu_pk((f32x2){v1[0], v1[1]}), d = gelu_pk((f32x2){v1[2], v1[3]});
                        v0 = (f32x4){a.x, a.y, b.x, b.y}; v1 = (f32x4){c.x, c.y, d.x, d.y}; }
                    else if (mode == 2) sigm8(v0, v1, IN8 ? -1.44269504089f / 1024.0f : -1.44269504089f);
                    else if (mode == 3) { const float r = rs[ai][m][bj]; v0 = v0 * g0 * r; v1 = v1 * g1 * r; }
                    u32x4 w; w.x = cvt_pk_bf16(v0[0], v0[1]); w.y = cvt_pk_bf16(v0[2], v0[3]); w.z = cvt_pk_bf16(v1[0], v1[1]); w.w = cvt_pk_bf16(v1[2], v1[3]);
                    if (mode == 2) *(u32x4*)(gbase + ((ai * 4 + m) * 2 + bj) * 8192) = w; else *(u32x4*)(rowp + bj * HALF) = w; } }
    }
};
__device__ __forceinline__ float sat8(float v) { return __builtin_amdgcn_fmed3f(v, -448.f, 448.f); }
__device__ __forceinline__ unsigned pk4_fp8(float a, float b, float c, float d) { unsigned w = 0; w = __builtin_amdgcn_cvt_pk_fp8_f32(a, b, w, false); w = __builtin_amdgcn_cvt_pk_fp8_f32(c, d, w, true); return w; }
constexpr float F8S_HN = 16.f, F8S_WGU = 64.f, F8S_ACT = 4.f, F8S_WDN = 128.f;
template <bool IN8>
struct EpiSwi8 {
    static constexpr bool PERM = true, CHAIN = false;
    unsigned char* ACT; int ldc;
    __device__ __forceinline__ void operator()(const f32x4 (&acc)[2][2][4][2], const Unit& u, int wr, int wc, int fr, int fq) const {
        asm volatile("" : "+v"(fr), "+v"(fq));
        const int row0 = u.pm * BM + wr * 64 + fr, col0 = u.pn * HALF + wc * 32 + 8 * fq;
        constexpr float US = IN8 ? 1.0f / (F8S_HN * F8S_WGU) : 1.0f;
#pragma unroll
        for (int ai = 0; ai < 2; ++ai)
#pragma unroll
            for (int m = 0; m < 4; ++m) { unsigned char* rowp = ACT + (size_t)(row0 + ai * HALF + m * 16) * ldc + col0;
                f32x4 v0, v1;
                swiglu8(acc[ai][0][m][0], acc[ai][0][m][1], acc[ai][1][m][0], acc[ai][1][m][1], -1.44269504089f * US, US * US * F8S_ACT, v0, v1);
                u32x2 w; w.x = pk4_fp8(sat8(v0[0]), sat8(v0[1]), sat8(v0[2]), sat8(v0[3])); w.y = pk4_fp8(sat8(v1[0]), sat8(v1[1]), sat8(v1[2]), sat8(v1[3]));
                *(u32x2*)rowp = w; }
    }
};
struct EpiSwi {
    static constexpr bool PERM = true, CHAIN = false;
    bf16_t* ACT; int ldc;
    __device__ __forceinline__ void operator()(const f32x4 (&acc)[2][2][4][2], const Unit& u, int wr, int wc, int fr, int fq) const {
        asm volatile("" : "+v"(fr), "+v"(fq));
        const int row0 = u.pm * BM + wr * 64 + fr, col0 = u.pn * HALF + wc * 32 + 8 * fq;
#pragma unroll
        for (int ai = 0; ai < 2; ++ai)
#pragma unroll
            for (int m = 0; m < 4; ++m) { bf16_t* rowp = ACT + (size_t)(row0 + ai * HALF + m * 16) * ldc + col0;
                f32x4 v0, v1;
                swiglu8(acc[ai][0][m][0], acc[ai][0][m][1], acc[ai][1][m][0], acc[ai][1][m][1], -1.44269504089f, 1.0f, v0, v1);
                u32x4 w; w.x = cvt_pk_bf16(v0[0], v0[1]); w.y = cvt_pk_bf16(v0[2], v0[3]); w.z = cvt_pk_bf16(v1[0], v1[1]); w.w = cvt_pk_bf16(v1[2], v1[3]);
                *(u32x4*)rowp = w; }
    }
};
template <bool INBF, bool OUTBF, bool F8ACC = false>
struct EpiResid {
    static constexpr bool PERM = false, CHAIN = false;
    const void* hin; void* out;
    __device__ __forceinline__ void operator()(const f32x4 (&acc)[2][2][4][2], const Unit& u, int wr, int wc, int fr, int fq) const {
        asm volatile("" : "+v"(fr), "+v"(fq));
        const int row0 = u.pm * BM + wr * 64 + fr, col0 = u.pn * BM + wc * 32 + 4 * fq;
#pragma unroll
        for (int ai = 0; ai < 2; ++ai) {
            f32x4 hv[4][2][2];
#pragma unroll
            for (int m = 0; m < 4; ++m) { const size_t ro = (size_t)(row0 + ai * HALF + m * 16) * D + col0;
#pragma unroll
                for (int bj = 0; bj < 2; ++bj)
#pragma unroll
                    for (int n = 0; n < 2; ++n) {
                        if constexpr (INBF) { const u32x2 h2 = *(const u32x2*)((const bf16_t*)hin + ro + bj * HALF + n * 16);
                            hv[m][bj][n] = (f32x4){__uint_as_float(h2.x << 16), __uint_as_float(h2.x & 0xffff0000u), __uint_as_float(h2.y << 16), __uint_as_float(h2.y & 0xffff0000u)}; }
                        else hv[m][bj][n] = *(const f32x4*)((const float*)hin + ro + bj * HALF + n * 16); } }
            asm volatile("" ::: "memory");
#pragma unroll
            for (int m = 0; m < 4; ++m) { const size_t ro = (size_t)(row0 + ai * HALF + m * 16) * D + col0;
#pragma unroll
                for (int bj = 0; bj < 2; ++bj)
#pragma unroll
                    for (int n = 0; n < 2; ++n) { const f32x4 v = F8ACC ? hv[m][bj][n] + acc[ai][bj][m][n] * (1.0f / (F8S_ACT * F8S_WDN)) : hv[m][bj][n] + acc[ai][bj][m][n];
                        if constexpr (OUTBF) { u32x2 hb; hb.x = cvt_pk_bf16(v[0], v[1]); hb.y = cvt_pk_bf16(v[2], v[3]); *(u32x2*)((bf16_t*)out + ro + bj * HALF + n * 16) = hb; }
                        else *(f32x4*)((float*)out + ro + bj * HALF + n * 16) = v; } }
            asm volatile("" ::: "memory");
        }
    }
};
template <bool FIRST>
struct EpiMoeDown {
    static constexpr bool PERM = false, CHAIN = false;
    const int* slot_tok; const float* slot_w; float* out; bf16_t* hs;
    __device__ __forceinline__ void operator()(const f32x4 (&acc)[2][2][4][2], const Unit& u, int wr, int wc, int fr, int fq) const {
        asm volatile("" : "+v"(fr), "+v"(fq));
        const int row0 = u.pm * BM + wr * 64 + fr, col0 = u.pn * BM + wc * 32 + 4 * fq;
#pragma unroll
        for (int ai = 0; ai < 2; ++ai) {
            int tk[4]; float ww[4];
#pragma unroll
            for (int m = 0; m < 4; ++m) { const int slot = row0 + ai * HALF + m * 16; tk[m] = slot_tok[slot]; ww[m] = slot_w[slot]; }
            f32x4 hv[4][2][2];
#pragma unroll
            for (int m = 0; m < 4; ++m) { const size_t ro = (size_t)(tk[m] < 0 ? 0 : tk[m]) * D + col0;
#pragma unroll
                for (int bj = 0; bj < 2; ++bj)
#pragma unroll
                    for (int n = 0; n < 2; ++n) {
                        { const u32x2 h2 = *(const u32x2*)(hs + ro + bj * HALF + n * 16);
                            hv[m][bj][n] = (f32x4){__uint_as_float(h2.x << 16), __uint_as_float(h2.x & 0xffff0000u), __uint_as_float(h2.y << 16), __uint_as_float(h2.y & 0xffff0000u)}; } } }
            asm volatile("" ::: "memory");
#pragma unroll
            for (int m = 0; m < 4; ++m) { if (tk[m] >= 0) { const size_t ro = (size_t)tk[m] * D + col0; const float w = ww[m];
#pragma unroll
                for (int bj = 0; bj < 2; ++bj)
#pragma unroll
                    for (int n = 0; n < 2; ++n) { const f32x4 v = hv[m][bj][n] + acc[ai][bj][m][n] * w;
                        if constexpr (FIRST) { u32x2 hb; hb.x = cvt_pk_bf16(v[0], v[1]); hb.y = cvt_pk_bf16(v[2], v[3]); *(u32x2*)(hs + ro + bj * HALF + n * 16) = hb; }
                        else *(f32x4*)(out + ro + bj * HALF + n * 16) = v; } } }
            asm volatile("" ::: "memory");
        }
    }
};
struct EpiMoeDownAtomic {
    static constexpr bool PERM = false, CHAIN = false;
    const int* slot_tok; const float* slot_w; float* out;
    __device__ __forceinline__ void operator()(const f32x4 (&acc)[2][2][4][2], const Unit& u, int wr, int wc, int fr, int fq) const {
        asm volatile("" : "+v"(fr), "+v"(fq));
        const int row0 = u.pm * BM + wr * 64 + fr, col0 = u.pn * BM + wc * 32 + 4 * fq;
#pragma unroll
        for (int ai = 0; ai < 2; ++ai)
#pragma unroll
            for (int m = 0; m < 4; ++m) { const int slot = row0 + ai * HALF + m * 16; const int tok = slot_tok[slot]; const float w = slot_w[slot];
                if (tok >= 0) { float* ro = out + (size_t)tok * D + col0;
#pragma unroll
                    for (int bj = 0; bj < 2; ++bj)
#pragma unroll
                        for (int n = 0; n < 2; ++n)
#pragma unroll
                            for (int e = 0; e < 4; ++e) __hip_atomic_fetch_add(ro + bj * HALF + n * 16 + e, acc[ai][bj][m][n][e] * w, __ATOMIC_RELAXED, __HIP_MEMORY_SCOPE_AGENT); } }
    }
};
struct EpiMerge {
    static constexpr bool PERM = true, CHAIN = true;
    const bf16_t* Gt; bf16_t* MG;
    __device__ __forceinline__ bool resets(const Unit& u) const { return (u.kb >> 9) == 3; }
    __device__ __forceinline__ void operator()(f32x4 (&acc)[2][2][4][2], const Unit& u, int wr, int wc, int fr, int fq) const {
        asm volatile("" : "+v"(fr), "+v"(fq));
        const unsigned toff = (unsigned)(((wr * 4 + wc) * 64 + fq * 16 + fr) * 16);
        const int br = u.kb >> 9;
        const unsigned moff = (unsigned)((wr * 64 + fr) * D + wc * 32 + 8 * fq) * 2u;
        const char* gt = (const char*)Gt + (size_t)((br * 128 + u.pm) * 4 + u.pn) * 131072 + toff;
        const size_t nxo = br != 3 ? (size_t)128 * 4 * 131072 : 0;
        char* mt = (char*)MG + ((size_t)u.pm * BM * D + u.pn * BM) * 2;
#pragma unroll
        for (int ai = 0; ai < 2; ++ai) {
            u32x4 gv[4][2], nv[4][2];
#pragma unroll
            for (int m = 0; m < 4; ++m)
#pragma unroll
                for (int bj = 0; bj < 2; ++bj) { const size_t o = (size_t)(((ai * 4 + m) * 2 + bj) * 8192);
                    gv[m][bj] = *(const u32x4*)(gt + o); nv[m][bj] = *(const u32x4*)(gt + o + nxo); }
#pragma unroll
            for (int m = 0; m < 4; ++m)
#pragma unroll
                for (int bj = 0; bj < 2; ++bj) {
                    const u32x4 g4 = gv[m][bj], n4 = nv[m][bj];
                    f32x4 ga = {__uint_as_float(g4.x << 16), __uint_as_float(g4.x & 0xffff0000u), __uint_as_float(g4.y << 16), __uint_as_float(g4.y & 0xffff0000u)};
                    f32x4 gb = {__uint_as_float(g4.z << 16), __uint_as_float(g4.z & 0xffff0000u), __uint_as_float(g4.w << 16), __uint_as_float(g4.w & 0xffff0000u)};
#pragma unroll
                    for (int e = 0; e < 4; ++e) { ga[e] = fmaxf(ga[e], 1e-20f); gb[e] = fmaxf(gb[e], 1e-20f); }
                    if (br != 3) {
                        const f32x4 na = {__uint_as_float(n4.x << 16), __uint_as_float(n4.x & 0xffff0000u), __uint_as_float(n4.y << 16), __uint_as_float(n4.y & 0xffff0000u)};
                        const f32x4 nb = {__uint_as_float(n4.z << 16), __uint_as_float(n4.z & 0xffff0000u), __uint_as_float(n4.w << 16), __uint_as_float(n4.w & 0xffff0000u)};
#pragma unroll
                        for (int e = 0; e < 4; ++e) { ga[e] *= __builtin_amdgcn_rcpf(fmaxf(na[e], 1e-20f)); gb[e] *= __builtin_amdgcn_rcpf(fmaxf(nb[e], 1e-20f)); }
                        acc[ai][bj][m][0] *= ga; acc[ai][bj][m][1] *= gb;
                    } else {
                        const f32x4 v0 = acc[ai][bj][m][0] * ga, v1 = acc[ai][bj][m][1] * gb;
                        u32x4 w; w.x = cvt_pk_bf16(v0[0], v0[1]); w.y = cvt_pk_bf16(v0[2], v0[3]); w.z = cvt_pk_bf16(v1[0], v1[1]); w.w = cvt_pk_bf16(v1[2], v1[3]);
                        *(u32x4*)(mt + (size_t)((ai * HALF + m * 16) * D + bj * HALF) * 2 + moff) = w; } }
            asm volatile("" ::: "memory");
        }
    }
};

__device__ __forceinline__ f32x4 zero4() { f32x2 lo, hi; asm volatile("v_mov_b64 %0, 0" : "=v"(lo)); asm volatile("v_mov_b64 %0, 0" : "=v"(hi)); return __builtin_shufflevector(lo, hi, 0, 1, 2, 3); }
template <class Sched> __device__ __forceinline__ unsigned a_off(const Sched& S, const Unit& u, int lda, int tid, int h, int i) {
    int R, C; stage_rc(tid * 16 + i * 8192, R, C);
    if constexpr (Sched::GATHER) return (unsigned)(S.arow(u, h * HALF + R) * lda + C) * 2u; else return (unsigned)((h * HALF + R) * lda + C) * 2u;
}
template <class Epi, class Sched, bool ALIGN_EPI, bool F8 = false>
__device__ __forceinline__ void gemm_phase(LAS unsigned char* lds, const Gemm g, const Sched& S, const Epi& E, int wave_) {
    int tid = wave_ * 64 + lane_id(); asm volatile("" : "+v"(tid));
    const int wid = __builtin_amdgcn_readfirstlane(tid >> 6), lane = tid & 63, wr = wid >> 2, wc = wid & 3, fr = lane & 15, fq = lane >> 4;
    unsigned voffB[2];
#pragma unroll
    for (int i = 0; i < 2; ++i) { int R, C; stage_rc(tid * 16 + i * 8192, R, C); const int Rb = Epi::PERM ? ((R & ~31) + perm32(R & 31)) : R; voffB[i] = (unsigned)(Rb * g.ldb + C) * 2u; }
    const size_t kstep = (size_t)(BK * 2);
    const size_t hstepB = (size_t)HALF * g.ldb * 2, tstepB = 2 * hstepB;
    const size_t tstepA = (size_t)BM * g.lda * 2;
    const unsigned ldsw = (unsigned)wid * 1024u;
    const int aoff = lds_byte(wr * 64 + fr, fq * 8), boff = lds_byte(wc * 32 + fr, fq * 8);
#define PG8_SA(b, h) (((b) * 2 + (h)) * HTB)
#define PG8_SB(b, h) ((4 + (b) * 2 + (h)) * HTB)
#define PG8_STAGE2(bufoff, gbase, v0_, v1_) do { \
        __builtin_amdgcn_global_load_lds((const unsigned*)((const char*)(gbase) + (v0_)), (LAS unsigned*)(lds + (bufoff) + ldsw), 16, 0, 0); \
        __builtin_amdgcn_global_load_lds((const unsigned*)((const char*)(gbase) + (v1_)), (LAS unsigned*)(lds + (bufoff) + ldsw + 8192), 16, 0, 0); } while (0)
#define PG8_STAGEB(bufoff, gbase) PG8_STAGE2(bufoff, gbase, voffB[0], voffB[1])
#define PG8_AOFF(u_, h_, i_) a_off<Sched>(S, u_, g.lda, tid, h_, i_)
#define PG8_ABASE(u_) (Sched::GATHER ? g.A + (u_).kb : g.A + (size_t)(u_).pm * tstepA + (u_).kb)
#define PG8_LDA(dst, b, h) do { _Pragma("unroll") for (int m = 0; m < 4; ++m) { \
        if constexpr (F8) { const i32x4 lo_ = *(const LAS i32x4*)(lds + PG8_SA(b, h) + aoff + m * 2048), hi_ = *(const LAS i32x4*)(lds + PG8_SA(b, h) + aoff + m * 2048 + 1024); dst##8[m] = __builtin_shufflevector(lo_, hi_, 0, 1, 2, 3, 4, 5, 6, 7); } \
        else { _Pragma("unroll") for (int k = 0; k < 2; ++k) dst[m][k] = *(const LAS bf16x8*)(lds + PG8_SA(b, h) + aoff + m * 2048 + k * 1024); } } } while (0)
#define PG8_LDB(dst, b, h) do { _Pragma("unroll") for (int n = 0; n < 2; ++n) { \
        if constexpr (F8) { const i32x4 lo_ = *(const LAS i32x4*)(lds + PG8_SB(b, h) + boff + n * 2048), hi_ = *(const LAS i32x4*)(lds + PG8_SB(b, h) + boff + n * 2048 + 1024); dst##8[n] = __builtin_shufflevector(lo_, hi_, 0, 1, 2, 3, 4, 5, 6, 7); } \
        else { _Pragma("unroll") for (int k = 0; k < 2; ++k) dst[n][k] = *(const LAS bf16x8*)(lds + PG8_SB(b, h) + boff + n * 2048 + k * 1024); } } } while (0)
#define PG8_MMA(ai, bj, At, Bt) do { __builtin_amdgcn_s_setprio(1); _Pragma("unroll") for (int m = 0; m < 4; ++m) _Pragma("unroll") for (int n = 0; n < 2; ++n) { \
        if constexpr (F8) asm volatile("v_mfma_f32_16x16x128_f8f6f4 %0, %1, %2, %0" : "+v"(acc[ai][bj][m][n]) : "v"(Bt##8[n]), "v"(At##8[m])); \
        else { _Pragma("unroll") for (int k = 0; k < 2; ++k) acc[ai][bj][m][n] = __builtin_amdgcn_mfma_f32_16x16x32_bf16(Bt[n][k], At[m][k], acc[ai][bj][m][n], 0, 0, 0); } } \
        __builtin_amdgcn_s_setprio(0); } while (0)
#define PG8_WAIT_V(n) asm volatile("s_waitcnt vmcnt(" #n ")" ::: "memory")
#define PG8_WAIT_L(n) asm volatile("s_waitcnt lgkmcnt(" #n ")" ::: "memory")
#define PG8_BAR __builtin_amdgcn_s_barrier()
#define PG8_SCHED __builtin_amdgcn_sched_barrier(0)
    Unit cur, nxt; int ui = 0;
    if (!S.next(0, cur)) return;
    f32x4 acc[2][2][4][2];
#pragma unroll
    for (int a = 0; a < 2; ++a)
#pragma unroll
        for (int b = 0; b < 2; ++b)
#pragma unroll
            for (int m = 0; m < 4; ++m)
#pragma unroll
                for (int n = 0; n < 2; ++n) acc[a][b][m][n] = zero4();
    bf16x8 At[4][2], B0[2][2], B1[2][2];
    i32x8 At8[4], B08[2], B18[2];
    unsigned ca00 = PG8_AOFF(cur, 0, 0), ca01 = PG8_AOFF(cur, 0, 1), ca10 = PG8_AOFF(cur, 1, 0), ca11 = PG8_AOFF(cur, 1, 1);
    const char* cA = PG8_ABASE(cur);
    const char* cB = cur.B + (size_t)cur.pn * tstepB + cur.kb;
    {
        PG8_STAGEB(PG8_SB(0, 0), cB); PG8_STAGEB(PG8_SB(0, 1), cB + hstepB); PG8_STAGE2(PG8_SA(0, 0), cA, ca00, ca01); PG8_STAGE2(PG8_SA(0, 1), cA, ca10, ca11);
        if (wr == 1) PG8_BAR;
        PG8_WAIT_V(2); PG8_BAR;
        PG8_STAGEB(PG8_SB(1, 0), cB + kstep); PG8_STAGE2(PG8_SA(1, 0), cA + kstep, ca00, ca01); PG8_STAGEB(PG8_SB(1, 1), cB + hstepB + kstep);
        PG8_WAIT_V(6); PG8_BAR;
    }
    for (;;) {
        const bool has_next = S.next(ui + 1, nxt);
        const char* nA = cA; const char* nB = cB;
        if (has_next) { nA = PG8_ABASE(nxt); nB = nxt.B + (size_t)nxt.pn * tstepB + nxt.kb; }
        const int nt = cur.nt;
        for (int t = 0; t < nt; t += 2) {
            const bool last = (t == nt - 2);
            const char* a1 = cA + (size_t)(t + 1) * kstep;
            const char* a2 = last ? nA : cA + (size_t)(t + 2) * kstep; const char* b2 = last ? nB : cB + (size_t)(t + 2) * kstep;
            const char* a3 = a2 + kstep; const char* b3 = b2 + kstep;
            unsigned o00 = ca00, o01 = ca01, o10 = ca10, o11 = ca11;
            if constexpr (Sched::GATHER) { if (last && has_next) { o00 = PG8_AOFF(nxt, 0, 0); o01 = PG8_AOFF(nxt, 0, 1); o10 = PG8_AOFF(nxt, 1, 0); o11 = PG8_AOFF(nxt, 1, 1); } }
            PG8_LDB(B0, 0, 0); PG8_LDB(B1, 0, 1); PG8_SCHED; PG8_LDA(At, 0, 0); PG8_STAGE2(PG8_SA(1, 1), a1, ca10, ca11);
            PG8_WAIT_V(8); PG8_WAIT_L(0); PG8_BAR; PG8_MMA(0, 0, At, B0); PG8_MMA(0, 1, At, B1); PG8_BAR; PG8_SCHED;
            PG8_LDA(At, 0, 1); PG8_STAGEB(PG8_SB(0, 0), b2); PG8_STAGEB(PG8_SB(0, 1), b2 + hstepB); PG8_STAGE2(PG8_SA(0, 0), a2, o00, o01);
            PG8_WAIT_V(8); PG8_WAIT_L(0); PG8_BAR; PG8_MMA(1, 0, At, B0); PG8_MMA(1, 1, At, B1); PG8_BAR; PG8_SCHED;
            PG8_LDB(B0, 1, 0); PG8_LDB(B1, 1, 1); PG8_SCHED; PG8_LDA(At, 1, 0); PG8_STAGE2(PG8_SA(0, 1), a2, o10, o11);
            PG8_WAIT_V(8); PG8_WAIT_L(0); PG8_BAR; PG8_MMA(0, 0, At, B0); PG8_MMA(0, 1, At, B1); PG8_BAR; PG8_SCHED;
            PG8_LDA(At, 1, 1); PG8_STAGEB(PG8_SB(1, 0), b3); PG8_STAGEB(PG8_SB(1, 1), b3 + hstepB); PG8_STAGE2(PG8_SA(1, 0), a3, o00, o01);
            PG8_WAIT_V(8); PG8_WAIT_L(0); PG8_BAR; PG8_MMA(1, 0, At, B0); PG8_MMA(1, 1, At, B1); PG8_BAR; PG8_SCHED;
            if constexpr (Sched::GATHER) { if (last) { ca00 = o00; ca01 = o01; ca10 = o10; ca11 = o11; } }
        }
        if constexpr (ALIGN_EPI) { if (wr == 0) PG8_BAR; }
        if constexpr (F8) asm volatile("s_nop 15\n\ts_nop 15" ::: "memory");
        E(acc, cur, wr, wc, fr, fq);
        if (!has_next) break;
        bool zero_acc = true;
        if constexpr (Epi::CHAIN) zero_acc = E.resets(cur);
        if (zero_acc)
#pragma unroll
        for (int a = 0; a < 2; ++a)
#pragma unroll
            for (int b = 0; b < 2; ++b)
#pragma unroll
                for (int m = 0; m < 4; ++m)
#pragma unroll
                    for (int n = 0; n < 2; ++n) acc[a][b][m][n] = zero4();
        cur = nxt; cA = nA; cB = nB; ++ui;
        if constexpr (ALIGN_EPI) { if (wr == 1) PG8_BAR; }
    }
    PG8_WAIT_V(0);
    if constexpr (!ALIGN_EPI) { if (wr == 0) PG8_BAR; }
    PG8_BAR;
#undef PG8_SA
#undef PG8_SB
#undef PG8_STAGE2
#undef PG8_STAGEB
#undef PG8_AOFF
#undef PG8_ABASE
#undef PG8_LDA
#undef PG8_LDB
#undef PG8_MMA
#undef PG8_WAIT_V
#undef PG8_WAIT_L
#undef PG8_BAR
#undef PG8_SCHED
}
}

__device__ __forceinline__ unsigned pk2(float lo, float hi) { return (unsigned)f2bf(lo) | ((unsigned)f2bf(hi) << 16); }

__device__ __forceinline__ void p0_transpose_item(const float* W, int K, int N, bf16_t* WT, int ldk, int koff, int mode, LAS float* scr, int item, int lane) {
    const int nblk = N / 32, kb = item / nblk, nb = item % nblk, k0 = 64 * kb, n0 = 32 * nb;
    float tv[32];
#pragma unroll
    for (int i = 0; i < 32; ++i) { const int kk = 2 * i + (lane >> 5); tv[i] = W[(size_t)(k0 + kk) * N + n0 + (lane & 31)]; }
#pragma unroll
    for (int i = 0; i < 32; ++i) { const int kk = 2 * i + (lane >> 5); scr[kk * 33 + (lane & 31)] = tv[i]; }
    asm volatile("s_waitcnt lgkmcnt(0)" ::: "memory");
    int r0 = n0;
    if (mode == 1) { const int dff = N >> 1, hf = n0 >= dff ? 1 : 0, c = n0 - hf * dff; r0 = (c >> 7) * 256 + hf * 128 + (c & 127); }
    const int c8 = lane & 7;
#pragma unroll
    for (int j = 0; j < 4; ++j) { const int n = (lane >> 3) + 8 * j; const LAS float* s = scr + (8 * c8) * 33 + n;
        u32x4 o; o.x = pk2(s[0 * 33], s[1 * 33]); o.y = pk2(s[2 * 33], s[3 * 33]); o.z = pk2(s[4 * 33], s[5 * 33]); o.w = pk2(s[6 * 33], s[7 * 33]);
        *(u32x4*)(WT + (size_t)(r0 + n) * ldk + koff + k0 + 8 * c8) = o; }
    asm volatile("s_waitcnt lgkmcnt(0)" ::: "memory");
}

__device__ __forceinline__ void p0_transpose_item_f8(const float* W, int K, int N, unsigned char* WT8, int ldk, int mode, float sc, LAS float* scr, int item, int lane) {
    const int nblk = N / 32, kb = item / nblk, nb = item % nblk, k0 = 64 * kb, n0 = 32 * nb;
    float tv[32];
#pragma unroll
    for (int i = 0; i < 32; ++i) { const int kk = 2 * i + (lane >> 5); tv[i] = W[(size_t)(k0 + kk) * N + n0 + (lane & 31)]; }
#pragma unroll
    for (int i = 0; i < 32; ++i) { const int kk = 2 * i + (lane >> 5); scr[kk * 33 + (lane & 31)] = tv[i] * sc; }
    asm volatile("s_waitcnt lgkmcnt(0)" ::: "memory");
    int r0 = n0;
    if (mode == 1) { const int dff = N >> 1, hf = n0 >= dff ? 1 : 0, c = n0 - hf * dff; r0 = (c >> 7) * 256 + hf * 128 + (c & 127); }
    const int c8 = lane & 7;
#pragma unroll
    for (int j = 0; j < 4; ++j) { const int n = (lane >> 3) + 8 * j; const LAS float* s = scr + (8 * c8) * 33 + n;
        u32x2 o; o.x = pg8::pk4_fp8(pg8::sat8(s[0 * 33]), pg8::sat8(s[1 * 33]), pg8::sat8(s[2 * 33]), pg8::sat8(s[3 * 33])); o.y = pg8::pk4_fp8(pg8::sat8(s[4 * 33]), pg8::sat8(s[5 * 33]), pg8::sat8(s[6 * 33]), pg8::sat8(s[7 * 33]));
        *(u32x2*)(WT8 + (size_t)(r0 + n) * ldk + k0 + 8 * c8) = o; }
    asm volatile("s_waitcnt lgkmcnt(0)" ::: "memory");
}

struct Args {
    const float* in[25]; float* out; unsigned char* ws;
    int ph_lo, ph_hi;
};

template <bool O8>
__device__ __forceinline__ void rms_row(const float* __restrict__ xrow, const float* __restrict__ g, bf16_t* __restrict__ orow, unsigned char* __restrict__ o8row, int lane) {
    const f32x4* p = (const f32x4*)xrow;
    f32x4 v[4]; float ss = 0.f;
#pragma unroll
    for (int j = 0; j < 4; ++j) { v[j] = p[lane + 64 * j]; ss += (v[j].x * v[j].x + v[j].y * v[j].y) + (v[j].z * v[j].z + v[j].w * v[j].w); }
    ss = wave_sum(ss);
    const float r = rsqrtf(ss * (1.0f / D) + EPS);
    u32x2* op = (u32x2*)orow;
#pragma unroll
    for (int j = 0; j < 4; ++j) { const f32x4 gg = ((const f32x4*)g)[lane + 64 * j]; const float y0 = v[j].x * r * gg.x, y1 = v[j].y * r * gg.y, y2 = v[j].z * r * gg.z, y3 = v[j].w * r * gg.w;
        u32x2 w; w.x = pk2(y0, y1); w.y = pk2(y2, y3); op[lane + 64 * j] = w;
        if constexpr (O8) ((unsigned*)o8row)[lane + 64 * j] = pg8::pk4_fp8(pg8::sat8(y0 * pg8::F8S_HN), pg8::sat8(y1 * pg8::F8S_HN), pg8::sat8(y2 * pg8::F8S_HN), pg8::sat8(y3 * pg8::F8S_HN)); }
}


template <bool O8>
__device__ __forceinline__ void rms_rows4(const float* __restrict__ x, int row, int st, const float* __restrict__ g, bf16_t* __restrict__ o, unsigned char* __restrict__ o8, int lane) {
    f32x4 v[4][4];
#pragma unroll
    for (int i = 0; i < 4; ++i)
#pragma unroll
        for (int j = 0; j < 4; ++j) v[i][j] = ((const f32x4*)(x + (size_t)(row + i * st) * D))[lane + 64 * j];
    f32x4 gg[4];
#pragma unroll
    for (int j = 0; j < 4; ++j) gg[j] = ((const f32x4*)g)[lane + 64 * j];
    float ss[4];
#pragma unroll
    for (int i = 0; i < 4; ++i) { ss[i] = 0.f;
#pragma unroll
        for (int j = 0; j < 4; ++j) ss[i] += (v[i][j].x * v[i][j].x + v[i][j].y * v[i][j].y) + (v[i][j].z * v[i][j].z + v[i][j].w * v[i][j].w); }
#pragma unroll
    for (int i = 0; i < 4; ++i) ss[i] = wave_sum(ss[i]);
    float eps_ = EPS; asm volatile("" : "+v"(eps_));
#pragma unroll
    for (int i = 0; i < 4; ++i) { const float r = rsqrtf(ss[i] * (1.0f / D) + eps_); u32x2* op = (u32x2*)(o + (size_t)(row + i * st) * D);
#pragma unroll
        for (int j = 0; j < 4; ++j) { const float y0 = v[i][j].x * r * gg[j].x, y1 = v[i][j].y * r * gg[j].y, y2 = v[i][j].z * r * gg[j].z, y3 = v[i][j].w * r * gg[j].w;
            u32x2 w; w.x = pk2(y0, y1); w.y = pk2(y2, y3); op[lane + 64 * j] = w;
            if constexpr (O8) ((unsigned*)(o8 + (size_t)(row + i * st) * D))[lane + 64 * j] = pg8::pk4_fp8(pg8::sat8(y0 * pg8::F8S_HN), pg8::sat8(y1 * pg8::F8S_HN), pg8::sat8(y2 * pg8::F8S_HN), pg8::sat8(y3 * pg8::F8S_HN)); } }
}

__device__ __forceinline__ void bf8_to_f32(const u32x4 a, float (&v)[8]) {
    v[0] = __uint_as_float(a.x << 16); v[1] = __uint_as_float(a.x & 0xffff0000u); v[2] = __uint_as_float(a.y << 16); v[3] = __uint_as_float(a.y & 0xffff0000u);
    v[4] = __uint_as_float(a.z << 16); v[5] = __uint_as_float(a.z & 0xffff0000u); v[6] = __uint_as_float(a.w << 16); v[7] = __uint_as_float(a.w & 0xffff0000u);
}
template <bool O8>
__device__ __forceinline__ void rms_row_bf(const bf16_t* __restrict__ xrow, const float* __restrict__ g, bf16_t* __restrict__ orow, unsigned char* __restrict__ o8row, int lane) {
    float v[2][8]; float ss = 0.f;
#pragma unroll
    for (int j = 0; j < 2; ++j) { bf8_to_f32(((const u32x4*)xrow)[lane + 64 * j], v[j]);
#pragma unroll
        for (int e = 0; e < 8; ++e) ss += v[j][e] * v[j][e]; }
    ss = wave_sum(ss);
    const float r = rsqrtf(ss * (1.0f / D) + EPS);
#pragma unroll
    for (int j = 0; j < 2; ++j) { const f32x4 ga = ((const f32x4*)g)[2 * (lane + 64 * j)], gb = ((const f32x4*)g)[2 * (lane + 64 * j) + 1];
        const float y0 = v[j][0] * r * ga.x, y1 = v[j][1] * r * ga.y, y2 = v[j][2] * r * ga.z, y3 = v[j][3] * r * ga.w, y4 = v[j][4] * r * gb.x, y5 = v[j][5] * r * gb.y, y6 = v[j][6] * r * gb.z, y7 = v[j][7] * r * gb.w;
        u32x4 w; w.x = pk2(y0, y1); w.y = pk2(y2, y3); w.z = pk2(y4, y5); w.w = pk2(y6, y7);
        ((u32x4*)orow)[lane + 64 * j] = w;
        if constexpr (O8) { u32x2 w8; w8.x = pg8::pk4_fp8(pg8::sat8(y0 * pg8::F8S_HN), pg8::sat8(y1 * pg8::F8S_HN), pg8::sat8(y2 * pg8::F8S_HN), pg8::sat8(y3 * pg8::F8S_HN)); w8.y = pg8::pk4_fp8(pg8::sat8(y4 * pg8::F8S_HN), pg8::sat8(y5 * pg8::F8S_HN), pg8::sat8(y6 * pg8::F8S_HN), pg8::sat8(y7 * pg8::F8S_HN)); ((u32x2*)o8row)[lane + 64 * j] = w8; } }
}
template <bool O8>
__device__ __forceinline__ void rms_rows4_bf(const bf16_t* __restrict__ x, int row, int st, const float* __restrict__ g, bf16_t* __restrict__ o, unsigned char* __restrict__ o8, int lane) {
    u32x4 raw[4][2];
#pragma unroll
    for (int i = 0; i < 4; ++i)
#pragma unroll
        for (int j = 0; j < 2; ++j) raw[i][j] = ((const u32x4*)(x + (size_t)(row + i * st) * D))[lane + 64 * j];
    f32x4 gg[2][2];
#pragma unroll
    for (int j = 0; j < 2; ++j) { gg[j][0] = ((const f32x4*)g)[2 * (lane + 64 * j)]; gg[j][1] = ((const f32x4*)g)[2 * (lane + 64 * j) + 1]; }
    float eps_ = EPS; asm volatile("" : "+v"(eps_));
#pragma unroll
    for (int i = 0; i < 4; ++i) { float v[2][8]; float ss = 0.f;
#pragma unroll
        for (int j = 0; j < 2; ++j) { bf8_to_f32(raw[i][j], v[j]);
#pragma unroll
            for (int e = 0; e < 8; ++e) ss += v[j][e] * v[j][e]; }
        ss = wave_sum(ss);
        const float r = rsqrtf(ss * (1.0f / D) + eps_);
#pragma unroll
        for (int j = 0; j < 2; ++j) { const f32x4 ga = gg[j][0], gb = gg[j][1];
            const float y0 = v[j][0] * r * ga.x, y1 = v[j][1] * r * ga.y, y2 = v[j][2] * r * ga.z, y3 = v[j][3] * r * ga.w, y4 = v[j][4] * r * gb.x, y5 = v[j][5] * r * gb.y, y6 = v[j][6] * r * gb.z, y7 = v[j][7] * r * gb.w;
            u32x4 w; w.x = pk2(y0, y1); w.y = pk2(y2, y3); w.z = pk2(y4, y5); w.w = pk2(y6, y7);
            ((u32x4*)(o + (size_t)(row + i * st) * D))[lane + 64 * j] = w;
            if constexpr (O8) { u32x2 w8; w8.x = pg8::pk4_fp8(pg8::sat8(y0 * pg8::F8S_HN), pg8::sat8(y1 * pg8::F8S_HN), pg8::sat8(y2 * pg8::F8S_HN), pg8::sat8(y3 * pg8::F8S_HN)); w8.y = pg8::pk4_fp8(pg8::sat8(y4 * pg8::F8S_HN), pg8::sat8(y5 * pg8::F8S_HN), pg8::sat8(y6 * pg8::F8S_HN), pg8::sat8(y7 * pg8::F8S_HN)); ((u32x2*)(o8 + (size_t)(row + i * st) * D))[lane + 64 * j] = w8; } } }
}

__device__ __forceinline__ void qknorm_row(bf16_t* __restrict__ Z, int t, const float* __restrict__ qg, const float* __restrict__ kg, int lane) {
    bf16_t* p = Z + (size_t)t * ZP + OFF_ATTN + lane * 16;
    const u32x4 a = *(const u32x4*)p, b = *(const u32x4*)(p + 8);
    float v[16];
    v[0] = __uint_as_float(a.x << 16); v[1] = __uint_as_float(a.x & 0xffff0000u); v[2] = __uint_as_float(a.y << 16); v[3] = __uint_as_float(a.y & 0xffff0000u);
    v[4] = __uint_as_float(a.z << 16); v[5] = __uint_as_float(a.z & 0xffff0000u); v[6] = __uint_as_float(a.w << 16); v[7] = __uint_as_float(a.w & 0xffff0000u);
    v[8] = __uint_as_float(b.x << 16); v[9] = __uint_as_float(b.x & 0xffff0000u); v[10] = __uint_as_float(b.y << 16); v[11] = __uint_as_float(b.y & 0xffff0000u);
    v[12] = __uint_as_float(b.z << 16); v[13] = __uint_as_float(b.z & 0xffff0000u); v[14] = __uint_as_float(b.w << 16); v[15] = __uint_as_float(b.w & 0xffff0000u);
    float ss = 0.f;
#pragma unroll
    for (int i = 0; i < 16; ++i) ss += v[i] * v[i];
    ss = quad_sum(ss);
    const float r = rsqrtf(ss * (1.0f / 64.0f) + EPS);
    const float* g = (lane < 32 ? qg : kg) + (lane & 3) * 16;
    unsigned o[8];
#pragma unroll
    for (int i = 0; i < 8; ++i) o[i] = pk2(v[2 * i] * r * g[2 * i], v[2 * i + 1] * r * g[2 * i + 1]);
    *(u32x4*)p = (u32x4){o[0], o[1], o[2], o[3]}; *(u32x4*)(p + 8) = (u32x4){o[4], o[5], o[6], o[7]};
}

__device__ __forceinline__ void conv_row(const bf16_t* __restrict__ Z, int t, const float* __restrict__ cw, bf16_t* __restrict__ Y, int lane) {
    const int s = t & (SEQ - 1), c = lane * 4;
    float y0 = 0.f, y1 = 0.f, y2 = 0.f, y3 = 0.f;
#pragma unroll
    for (int j = 0; j < 3; ++j) {
        if (s - 2 + j >= 0) { const bf16_t* zr = Z + (size_t)(t - 2 + j) * ZP + OFF_CONV;
            const u32x2 cg = *(const u32x2*)(zr + 256 + c), hh = *(const u32x2*)(zr + 512 + c); const f32x4 w = *(const f32x4*)(cw + j * 256 + c);
            y0 += w.x * __uint_as_float(cg.x << 16) * __uint_as_float(hh.x << 16); y1 += w.y * __uint_as_float(cg.x & 0xffff0000u) * __uint_as_float(hh.x & 0xffff0000u);
            y2 += w.z * __uint_as_float(cg.y << 16) * __uint_as_float(hh.y << 16); y3 += w.w * __uint_as_float(cg.y & 0xffff0000u) * __uint_as_float(hh.y & 0xffff0000u); }
    }
    const u32x2 bg = *(const u32x2*)(Z + (size_t)t * ZP + OFF_CONV + c);
    u32x2 o; o.x = pk2(__uint_as_float(bg.x << 16) * y0, __uint_as_float(bg.x & 0xffff0000u) * y1); o.y = pk2(__uint_as_float(bg.y << 16) * y2, __uint_as_float(bg.y & 0xffff0000u) * y3);
    *(u32x2*)(Y + (size_t)t * YW + 256 + c) = o;
}


__device__ __forceinline__ void qknorm_rows4(bf16_t* __restrict__ Z, int t, int st, const float* __restrict__ qg, const float* __restrict__ kg, int lane) {
    u32x4 a[4], b[4];
#pragma unroll
    for (int i = 0; i < 4; ++i) { const bf16_t* p = Z + (size_t)(t + i * st) * ZP + OFF_ATTN + lane * 16; a[i] = *(const u32x4*)p; b[i] = *(const u32x4*)(p + 8); }
    const float* g = (lane < 32 ? qg : kg) + (lane & 3) * 16;
    const f32x4 g0 = *(const f32x4*)g, g1 = *(const f32x4*)(g + 4), g2 = *(const f32x4*)(g + 8), g3 = *(const f32x4*)(g + 12);
#pragma unroll
    for (int i = 0; i < 4; ++i) {
        float v[16];
        v[0] = __uint_as_float(a[i].x << 16); v[1] = __uint_as_float(a[i].x & 0xffff0000u); v[2] = __uint_as_float(a[i].y << 16); v[3] = __uint_as_float(a[i].y & 0xffff0000u);
        v[4] = __uint_as_float(a[i].z << 16); v[5] = __uint_as_float(a[i].z & 0xffff0000u); v[6] = __uint_as_float(a[i].w << 16); v[7] = __uint_as_float(a[i].w & 0xffff0000u);
        v[8] = __uint_as_float(b[i].x << 16); v[9] = __uint_as_float(b[i].x & 0xffff0000u); v[10] = __uint_as_float(b[i].y << 16); v[11] = __uint_as_float(b[i].y & 0xffff0000u);
        v[12] = __uint_as_float(b[i].z << 16); v[13] = __uint_as_float(b[i].z & 0xffff0000u); v[14] = __uint_as_float(b[i].w << 16); v[15] = __uint_as_float(b[i].w & 0xffff0000u);
        float ss = 0.f;
#pragma unroll
        for (int e = 0; e < 16; ++e) ss += v[e] * v[e];
        ss = quad_sum(ss);
        const float r = rsqrtf(ss * (1.0f / 64.0f) + EPS);
        u32x4 o0, o1;
        o0.x = pk2(v[0] * r * g0.x, v[1] * r * g0.y); o0.y = pk2(v[2] * r * g0.z, v[3] * r * g0.w); o0.z = pk2(v[4] * r * g1.x, v[5] * r * g1.y); o0.w = pk2(v[6] * r * g1.z, v[7] * r * g1.w);
        o1.x = pk2(v[8] * r * g2.x, v[9] * r * g2.y); o1.y = pk2(v[10] * r * g2.z, v[11] * r * g2.w); o1.z = pk2(v[12] * r * g3.x, v[13] * r * g3.y); o1.w = pk2(v[14] * r * g3.z, v[15] * r * g3.w);
        bf16_t* p = Z + (size_t)(t + i * st) * ZP + OFF_ATTN + lane * 16;
        *(u32x4*)p = o0; *(u32x4*)(p + 8) = o1;
    }
}
__device__ __forceinline__ void conv_rows4(const bf16_t* __restrict__ Z, int t, int st, const float* __restrict__ cw, bf16_t* __restrict__ Y, int lane) {
    const int c = lane * 4;
    u32x2 cg[4][3], hh[4][3], bg[4];
#pragma unroll
    for (int i = 0; i < 4; ++i) { const int tt = t + i * st, s = tt & (SEQ - 1);
#pragma unroll
        for (int j = 0; j < 3; ++j) { const int back = (s - 2 + j >= 0) ? (2 - j) : 0;
            const bf16_t* zr = Z + (size_t)(tt - back) * ZP + OFF_CONV; cg[i][j] = *(const u32x2*)(zr + 256 + c); hh[i][j] = *(const u32x2*)(zr + 512 + c); }
        bg[i] = *(const u32x2*)(Z + (size_t)tt * ZP + OFF_CONV + c); }
    f32x4 w[3];
#pragma unroll
    for (int j = 0; j < 3; ++j) w[j] = *(const f32x4*)(cw + j * 256 + c);
#pragma unroll
    for (int i = 0; i < 4; ++i) { const int tt = t + i * st, s = tt & (SEQ - 1);
        float y0 = 0.f, y1 = 0.f, y2 = 0.f, y3 = 0.f;
#pragma unroll
        for (int j = 0; j < 3; ++j) { const float mk = (s - 2 + j >= 0) ? 1.0f : 0.0f;
            y0 += mk * w[j].x * __uint_as_float(cg[i][j].x << 16) * __uint_as_float(hh[i][j].x << 16); y1 += mk * w[j].y * __uint_as_float(cg[i][j].x & 0xffff0000u) * __uint_as_float(hh[i][j].x & 0xffff0000u);
            y2 += mk * w[j].z * __uint_as_float(cg[i][j].y << 16) * __uint_as_float(hh[i][j].y << 16); y3 += mk * w[j].w * __uint_as_float(cg[i][j].y & 0xffff0000u) * __uint_as_float(hh[i][j].y & 0xffff0000u); }
        u32x2 o; o.x = pk2(__uint_as_float(bg[i].x << 16) * y0, __uint_as_float(bg[i].x & 0xffff0000u) * y1); o.y = pk2(__uint_as_float(bg[i].y << 16) * y2, __uint_as_float(bg[i].y & 0xffff0000u) * y3);
        *(u32x2*)(Y + (size_t)tt * YW + 256 + c) = o; }
}

__device__ __forceinline__ unsigned offb_(unsigned row, unsigned ch) { return 256u * row + 16u * (ch ^ (((row & 3u) << 2) | ((row >> 2) & 3u))); }
typedef float f32x16_t __attribute__((ext_vector_type(16)));
typedef short s16x4_t __attribute__((ext_vector_type(4)));
__device__ __forceinline__ s16x4_t vtr_(const LAS unsigned char* p) { return __builtin_bit_cast(s16x4_t, __builtin_amdgcn_ds_read_tr16_b64_v4i16((LAS s16x4_t*)p)); }
__device__ __forceinline__ unsigned cvtpk_(float lo, float hi) { unsigned r; asm volatile("v_cvt_pk_bf16_f32 %0, %1, %2" : "=v"(r) : "v"(lo), "v"(hi)); return r; }
__device__ __forceinline__ void sgu_seg_mfma(const bf16_t* __restrict__ Z, const float* __restrict__ lng, const bf16_t* __restrict__ wsb  , const float* __restrict__ sb,
                                             bf16_t* __restrict__ Y, LAS unsigned char* L, int seg, int tid) {
    const int lane = tid & 63, w = __builtin_amdgcn_readfirstlane(tid >> 6), t0 = seg * 128;
    {
        const f32x4 gg = *(const f32x4*)(lng + 4 * lane);
        u32x2 raw[16];
#pragma unroll
        for (int i = 0; i < 16; ++i) raw[i] = *(const u32x2*)(Z + (size_t)(t0 + w * 16 + i) * ZP + OFF_SGU + 256 + 4 * lane);
#pragma unroll
        for (int i = 0; i < 16; ++i) {
            const float x0 = __uint_as_float(raw[i].x << 16), x1 = __uint_as_float(raw[i].x & 0xffff0000u), x2 = __uint_as_float(raw[i].y << 16), x3 = __uint_as_float(raw[i].y & 0xffff0000u);
            const float s = wave_sum((x0 + x1) + (x2 + x3));
            const float mu = s * (1.0f / 256.0f);
            const float d0 = x0 - mu, d1 = x1 - mu, d2 = x2 - mu, d3 = x3 - mu;
            const float q = wave_sum((d0 * d0 + d1 * d1) + (d2 * d2 + d3 * d3));
            const float rs = rsqrtf(q * (1.0f / 256.0f) + EPS);
            u32x2 o; o.x = cvtpk_(d0 * rs * gg.x, d1 * rs * gg.y); o.y = cvtpk_(d2 * rs * gg.z, d3 * rs * gg.w);
            const unsigned row = (unsigned)(w * 16 + i), ch = (unsigned)(4 * lane);
            *(LAS u32x2*)(L + (ch >> 7) * 32768u + offb_(row, (ch & 127u) >> 3) + ((ch & 4u) ? 8u : 0u)) = o;
        }
    }
    __syncthreads();
    const int r = lane & 31, hh = lane >> 5, ct = w >> 2;
    const unsigned blk = (lane >> 4) & 1, qq = (lane & 15) >> 2, pp = lane & 3;
#pragma unroll
    for (int g = 0; g < 4; ++g) {
        const int pt = (w + g) & 3;
        const unsigned c = (unsigned)((g & 1) * 2 + ct);
        const LAS unsigned char* img = L + (g >> 1) * 32768;
        const unsigned va0 = offb_(8u * hh + qq, 4u * c + 2u * blk + (pp >> 1)) + 8u * (pp & 1), va1 = offb_(8u * hh + 4u + qq, 4u * c + 2u * blk + (pp >> 1)) + 8u * (pp & 1);
        const bf16_t* wrow = wsb + ((size_t)g * 128 + 32 * pt + r) * 128 + 8 * hh;
        f32x16_t acc;
#pragma unroll
        for (int i = 0; i < 16; ++i) acc[i] = 0.f;
        const int nks = 2 * (pt + 1);
        for (int ks = 0; ks < nks; ++ks) {
            const s16x4_t lo = vtr_(img + va0 + ks * 4096), hi = vtr_(img + va1 + ks * 4096);
            const bf16x8 a = {lo[0], lo[1], lo[2], lo[3], hi[0], hi[1], hi[2], hi[3]};
            const bf16x8 bw = *(const bf16x8*)(wrow + 16 * ks);
            acc = __builtin_amdgcn_mfma_f32_32x32x16_bf16(a, bw, acc, 0, 0, 0);
        }
        const int p = 32 * pt + r;
        const float bias = sb[g * 128 + p];
        const bf16_t* up = Z + (size_t)(t0 + p) * ZP + OFF_SGU + g * 64 + 32 * ct + 4 * hh;
        bf16_t* yp = Y + (size_t)(t0 + p) * YW + 512 + g * 64 + 32 * ct + 4 * hh;
        u32x2 uvv[4];
#pragma unroll
        for (int gq = 0; gq < 4; ++gq) uvv[gq] = *(const u32x2*)(up + 8 * gq);
        asm volatile("" ::: "memory");
#pragma unroll
        for (int gq = 0; gq < 4; ++gq) { const u32x2 uv = uvv[gq];
            u32x2 o; o.x = cvtpk_(__uint_as_float(uv.x << 16) * (acc[4 * gq + 0] + bias), __uint_as_float(uv.x & 0xffff0000u) * (acc[4 * gq + 1] + bias));
            o.y = cvtpk_(__uint_as_float(uv.y << 16) * (acc[4 * gq + 2] + bias), __uint_as_float(uv.y & 0xffff0000u) * (acc[4 * gq + 3] + bias));
            *(u32x2*)(yp + 8 * gq) = o; }
    }
    __syncthreads();
}

__device__ __forceinline__ void pool_unit_mfma(const bf16_t* __restrict__ Z, const bf16_t* __restrict__ pwt  , const float* __restrict__ ps, bf16_t* __restrict__ Y, int unit, int lane) {
    const int g = unit & 3, tt = unit >> 2, r = lane & 31, hh = lane >> 5;
    const int t = tt * 32 + r, s = t & (SEQ - 1), win = 2 << g;
    const int cnt = (s + 1) < win ? (s + 1) : win;
    const float icnt = 1.0f / (float)cnt;
    f32x16_t acc0, acc1;
#pragma unroll
    for (int i = 0; i < 16; ++i) { acc0[i] = 0.f; acc1[i] = 0.f; }
#pragma unroll
    for (int ks = 0; ks < 4; ++ks) {
        const bf16_t* zp = Z + (size_t)t * ZP + OFF_POOL + g * 64 + 16 * ks + 8 * hh;
        float sm[8];
#pragma unroll
        for (int e = 0; e < 8; ++e) sm[e] = 0.f;
        u32x4 self = {0u, 0u, 0u, 0u};
        for (int d = 0; d < win; ++d) {
            if (d < cnt) { const u32x4 v = *(const u32x4*)(zp - (size_t)d * ZP); if (d == 0) self = v;
                sm[0] += __uint_as_float(v.x << 16); sm[1] += __uint_as_float(v.x & 0xffff0000u); sm[2] += __uint_as_float(v.y << 16); sm[3] += __uint_as_float(v.y & 0xffff0000u);
                sm[4] += __uint_as_float(v.z << 16); sm[5] += __uint_as_float(v.z & 0xffff0000u); sm[6] += __uint_as_float(v.w << 16); sm[7] += __uint_as_float(v.w & 0xffff0000u); }
        }
        u32x4 pb;
        pb.x = cvtpk_(sm[0] * icnt - __uint_as_float(self.x << 16), sm[1] * icnt - __uint_as_float(self.x & 0xffff0000u));
        pb.y = cvtpk_(sm[2] * icnt - __uint_as_float(self.y << 16), sm[3] * icnt - __uint_as_float(self.y & 0xffff0000u));
        pb.z = cvtpk_(sm[4] * icnt - __uint_as_float(self.z << 16), sm[5] * icnt - __uint_as_float(self.z & 0xffff0000u));
        pb.w = cvtpk_(sm[6] * icnt - __uint_as_float(self.w << 16), sm[7] * icnt - __uint_as_float(self.w & 0xffff0000u));
        const bf16x8 bp = __builtin_bit_cast(bf16x8, pb);
        const bf16x8 a0 = *(const bf16x8*)(pwt + ((size_t)g * 64 + r) * 64 + 16 * ks + 8 * hh);
        const bf16x8 a1 = *(const bf16x8*)(pwt + ((size_t)g * 64 + 32 + r) * 64 + 16 * ks + 8 * hh);
        acc0 = __builtin_amdgcn_mfma_f32_32x32x16_bf16(a0, bp, acc0, 0, 0, 0);
        acc1 = __builtin_amdgcn_mfma_f32_32x32x16_bf16(a1, bp, acc1, 0, 0, 0);
    }
    bf16_t* yp = Y + (size_t)t * YW + g * 64 + 4 * hh;
    f32x4 sc0[4], sc1[4];
#pragma unroll
    for (int gq = 0; gq < 4; ++gq) { sc0[gq] = *(const f32x4*)(ps + g * 64 + 8 * gq + 4 * hh); sc1[gq] = *(const f32x4*)(ps + g * 64 + 32 + 8 * gq + 4 * hh); }
    asm volatile("" ::: "memory");
#pragma unroll
    for (int gq = 0; gq < 4; ++gq) {
        const f32x4 s0 = sc0[gq], s1 = sc1[gq];
        u32x2 o; o.x = cvtpk_(acc0[4 * gq + 0] * s0.x, acc0[4 * gq + 1] * s0.y); o.y = cvtpk_(acc0[4 * gq + 2] * s0.z, acc0[4 * gq + 3] * s0.w); *(u32x2*)(yp + 8 * gq) = o;
        o.x = cvtpk_(acc1[4 * gq + 0] * s1.x, acc1[4 * gq + 1] * s1.y); o.y = cvtpk_(acc1[4 * gq + 2] * s1.z, acc1[4 * gq + 3] * s1.w); *(u32x2*)(yp + 32 + 8 * gq) = o;
    }
}

__device__ __forceinline__ void router_row(const float* __restrict__ hrow, const float* __restrict__ g, const float* __restrict__ rw, bf16_t* __restrict__ orow, int& e0o, int& e1o, float& w0o, float& w1o, int lane) {
    const f32x4* p = (const f32x4*)hrow;
    f32x4 v[4]; float ss = 0.f;
#pragma unroll
    for (int j = 0; j < 4; ++j) { v[j] = p[lane + 64 * j]; ss += (v[j].x * v[j].x + v[j].y * v[j].y) + (v[j].z * v[j].z + v[j].w * v[j].w); }
    ss = wave_sum(ss);
    const float r = rsqrtf(ss * (1.0f / D) + EPS);
    float lg[8];
#pragma unroll
    for (int e = 0; e < 8; ++e) lg[e] = 0.f;
    u32x2* op = (u32x2*)orow;
#pragma unroll
    for (int j = 0; j < 4; ++j) {
        const int k = (lane + 64 * j) * 4; const f32x4 gg = *(const f32x4*)(g + k);
        const float x0 = v[j].x * r * gg.x, x1 = v[j].y * r * gg.y, x2 = v[j].z * r * gg.z, x3 = v[j].w * r * gg.w;
        u32x2 w; w.x = pk2(x0, x1); w.y = pk2(x2, x3); op[lane + 64 * j] = w;
        const f32x4* rp = (const f32x4*)(rw + (size_t)k * 8);
#pragma unroll
        for (int q = 0; q < 4; ++q) { const float xx = q == 0 ? x0 : (q == 1 ? x1 : (q == 2 ? x2 : x3)); const f32x4 ra = rp[q * 2], rb = rp[q * 2 + 1];
            lg[0] = fmaf(xx, ra.x, lg[0]); lg[1] = fmaf(xx, ra.y, lg[1]); lg[2] = fmaf(xx, ra.z, lg[2]); lg[3] = fmaf(xx, ra.w, lg[3]);
            lg[4] = fmaf(xx, rb.x, lg[4]); lg[5] = fmaf(xx, rb.y, lg[5]); lg[6] = fmaf(xx, rb.z, lg[6]); lg[7] = fmaf(xx, rb.w, lg[7]); }
    }
#pragma unroll
    for (int e = 0; e < 8; ++e) lg[e] = wave_sum(lg[e]);
    int i0 = 0; float v0 = lg[0];
#pragma unroll
    for (int e = 1; e < 8; ++e) if (lg[e] > v0) { v0 = lg[e]; i0 = e; }
    int i1 = -1; float v1 = -3e38f;
#pragma unroll
    for (int e = 0; e < 8; ++e) if (e != i0 && lg[e] > v1) { v1 = lg[e]; i1 = e; }
    const float e1 = __expf(v1 - v0);
    e0o = i0; e1o = i1; w0o = 1.0f / (1.0f + e1); w1o = e1 / (1.0f + e1);
}


namespace fa {
typedef float f32x16 __attribute__((ext_vector_type(16)));
typedef short s16x4 __attribute__((ext_vector_type(4)));
typedef short v4i16_t __attribute__((ext_vector_type(4)));
constexpr int TAB_OFF = 131072;
constexpr int TABN = 328;
constexpr float C2 = 0.125f * 1.4426950408889634f;
constexpr float LOG2E = 1.4426950408889634f;
__device__ __forceinline__ unsigned off_b(unsigned row, unsigned ch) { return 256u * row + 16u * (ch ^ (((row & 3u) << 2) | ((row >> 2) & 3u))); }
__device__ __forceinline__ s16x4 vtr(const LAS unsigned char* p) { return __builtin_bit_cast(s16x4, __builtin_amdgcn_ds_read_tr16_b64_v4i16((LAS v4i16_t*)p)); }
__device__ __forceinline__ float max3f(float a, float b, float c) { float r; asm("v_max3_f32 %0, %1, %2, %3" : "=v"(r) : "v"(a), "v"(b), "v"(c)); return r; }
__device__ __forceinline__ float max2f(float a, float b) { float r; asm("v_max_f32_e32 %0, %1, %2" : "=v"(r) : "v"(a), "v"(b)); return r; }
__device__ __forceinline__ unsigned cvtpk(float lo, float hi) { unsigned r; asm volatile("v_cvt_pk_bf16_f32 %0, %1, %2" : "=v"(r) : "v"(lo), "v"(hi)); return r; }

__device__ __forceinline__ void attn_phase(LAS unsigned char* lds, const bf16_t* __restrict__ Z, const float* __restrict__ relb, const float* __restrict__ dl, const float* __restrict__ sg,
                                           float lam_init, bf16_t* __restrict__ Y, int G, int bx, int wave_) {
    int tid = wave_ * 64 + lane_id(); asm volatile("" : "+v"(tid));
    const int lane = tid & 63, w = __builtin_amdgcn_readfirstlane(tid >> 6), m = w >> 2, r32 = w & 3, r = lane & 31, hh = lane >> 5;
    const float l1 = wave_sum(dl[lane] * dl[64 + lane]), l2 = wave_sum(dl[128 + lane] * dl[192 + lane]);
    const float lam = __expf(l1) - __expf(l2) + lam_init;
    LAS float* TAB = (LAS float*)(lds + TAB_OFF);
    unsigned goff[2];
#pragma unroll
    for (int i = 0; i < 2; ++i) { const unsigned pos = (unsigned)w * 1024u + (unsigned)i * 8192u + (unsigned)lane * 16u, row = pos >> 8, p = (pos >> 4) & 15u;
        const unsigned ch = p ^ (((row & 3u) << 2) | ((row >> 2) & 3u)); goff[i] = row * (unsigned)(ZP * 2) + ch * 16u; }
    unsigned kaddr[4];
#pragma unroll
    for (int s = 0; s < 4; ++s) kaddr[s] = off_b((unsigned)r, (unsigned)(m * 8 + 2 * s + hh));
    unsigned vaddr[4][2];
    { const unsigned blk = (lane >> 4) & 1, q = (lane & 15) >> 2, p = lane & 3;
#pragma unroll
      for (int c = 0; c < 4; ++c)
#pragma unroll
          for (int t = 0; t < 2; ++t) vaddr[c][t] = off_b(8u * t + 4u * hh + q, 4u * c + 2u * blk + (p >> 1)) + 8u * (p & 1); }

    const int vcu = (G % 8 == 0) ? (bx % 8) * (G / 8) + bx / 8 : bx;
    int tab_h = -1;
    for (int ui = 0;; ++ui) {
        const int pidx = vcu + G * (ui >> 1);
        if (pidx >= 512) break;
        const int j8 = pidx & 7, h = (pidx >> 3) & 3, b = pidx >> 5;
        const int qb = (ui & 1) ? 15 - j8 : j8;
        const int q0 = qb * 128, nkt = 2 * qb + 2, qs = q0 + 32 * r32;
        const int my_nkt = r32 < 2 ? nkt - 1 : nkt;
        const char* zb = (const char*)Z + (size_t)(b * SEQ) * ZP * 2;
        const char* kbase = zb + (OFF_ATTN + 512 + h * 128) * 2;
        const char* vbase = zb + (OFF_ATTN + 1024 + h * 128) * 2;
        __syncthreads();
        if (h != tab_h) {
            for (int idx = tid; idx < 2 * 4 * TABN; idx += 512) { const int mm = idx / (4 * TABN), c = (idx / TABN) & 3, y = idx % TABN; TAB[idx] = relb[rel_bucket(y - c - 256) * 8 + h * 2 + mm] * LOG2E; }
            tab_h = h;
        }
        const float b15p = relb[15 * 8 + h * 2 + m] * LOG2E;
        bf16x8 Qf[4];
        { const char* qp = zb + ((size_t)(qs + r) * ZP + OFF_ATTN + h * 128 + m * 64 + 8 * hh) * 2;
#pragma unroll
          for (int s = 0; s < 4; ++s) Qf[s] = *(const bf16x8*)(qp + s * 32); }
        asm volatile("s_waitcnt vmcnt(0)" ::: "memory");
#define FA_LOAD_TILE(kt_, buf_) do { const size_t to_ = (size_t)(kt_) * 64 * ZP * 2; LAS unsigned char* lb_ = lds + (buf_) * 32768 + w * 1024; \
        __builtin_amdgcn_global_load_lds((const unsigned*)(kbase + to_ + goff[0]), (LAS unsigned*)(lb_), 16, 0, 0); \
        __builtin_amdgcn_global_load_lds((const unsigned*)(kbase + to_ + goff[1]), (LAS unsigned*)(lb_ + 8192), 16, 0, 0); \
        __builtin_amdgcn_global_load_lds((const unsigned*)(vbase + to_ + goff[0]), (LAS unsigned*)(lb_ + 16384), 16, 0, 0); \
        __builtin_amdgcn_global_load_lds((const unsigned*)(vbase + to_ + goff[1]), (LAS unsigned*)(lb_ + 16384 + 8192), 16, 0, 0); } while (0)
        FA_LOAD_TILE(0, 0); FA_LOAD_TILE(1, 1);
        f32x16 O[4];
#pragma unroll
        for (int c = 0; c < 4; ++c)
#pragma unroll
            for (int i = 0; i < 16; ++i) O[c][i] = 0.f;
        float mref = 0.f, lsum = 0.f;
        const int sq = qs + r, sqa = sq >> 2, sqc = sq & 3;
        const LAS float* tabl = TAB + (m * 4 + sqc) * TABN + 256 - 4 * sqa + 4 * hh;
        f32x16 S0, S1;
#pragma unroll
        for (int i = 0; i < 16; ++i) { S0[i] = 0.f; S1[i] = 0.f; }
        bf16x8 P[4];
#pragma unroll
        for (int i = 0; i < 4; ++i) P[i] = (bf16x8){0, 0, 0, 0, 0, 0, 0, 0};
        constexpr float THR = 8.0f;
        for (int t = 0; t <= nkt; ++t) {
            if (t < nkt) { if (t + 1 < nkt) asm volatile("s_waitcnt vmcnt(4) lgkmcnt(0)\n\ts_barrier" ::: "memory"); else asm volatile("s_waitcnt vmcnt(0) lgkmcnt(0)\n\ts_barrier" ::: "memory"); }
            else asm volatile("s_waitcnt lgkmcnt(0)\n\ts_barrier" ::: "memory");
            if (t + 2 < nkt) FA_LOAD_TILE(t + 2, (t + 2) & 3);
            const bool do_qk = t < my_nkt, do_pv = t >= 1 && (t - 1) < my_nkt;
            float alpha = 1.f, sub = 0.f; bool moved = false;
            if (do_qk) {
                const LAS unsigned char* Kb = lds + (t & 3) * 32768;
                bf16x8 kf[8];
#pragma unroll
                for (int s_ = 0; s_ < 4; ++s_) { kf[2 * s_] = *(const LAS bf16x8*)(Kb + kaddr[s_]); kf[2 * s_ + 1] = *(const LAS bf16x8*)(Kb + kaddr[s_] + 8192); }
#pragma unroll
                for (int i = 0; i < 16; ++i) { S0[i] = 0.f; S1[i] = 0.f; }
                __builtin_amdgcn_sched_barrier(0);
#pragma unroll
                for (int s_ = 0; s_ < 4; ++s_) { S0 = __builtin_amdgcn_mfma_f32_32x32x16_bf16(kf[2 * s_], Qf[s_], S0, 0, 0, 0); S1 = __builtin_amdgcn_mfma_f32_32x32x16_bf16(kf[2 * s_ + 1], Qf[s_], S1, 0, 0, 0); }
                __builtin_amdgcn_sched_barrier(0);
                const bool nearb = (64 * t + 63 - qs) > -91;
                if (nearb) {
                    const LAS float* tb = tabl + 64 * t;
#pragma unroll
                    for (int g = 0; g < 4; ++g) { const f32x4 b0 = *(const LAS f32x4*)(tb + 8 * g), b1 = *(const LAS f32x4*)(tb + 32 + 8 * g);
#pragma unroll
                        for (int e = 0; e < 4; ++e) { S0[4 * g + e] += b0[e]; S1[4 * g + e] += b1[e]; } }
                }
                float mx = max3f(S0[0], S1[0], S0[1]);
                mx = max3f(mx, S1[1], S0[2]);
#pragma unroll
                for (int i = 2; i < 15; ++i) mx = max3f(mx, S1[i], S0[i + 1]);
                mx = max2f(mx, S1[15]);
                mx = max_xor32(mx);
                if (!nearb) mx += b15p;
                if (!__all(mx <= mref + THR)) {
                    const float mn = fmaxf(mref, mx);
                    alpha = __builtin_amdgcn_exp2f(mref - mn); lsum *= alpha; mref = mn; moved = true;
                }
                sub = nearb ? mref : (mref - b15p);
            }
#define FA_PV_STEP(FILL) do { const LAS unsigned char* Vb = lds + ((t + 3) & 3) * 32768 + 16384; s16x4 vlo[2][4], vhi[2][4]; \
                _Pragma("unroll") for (int c = 0; c < 4; ++c) { vlo[0][c] = vtr(Vb + vaddr[c][0]); vhi[0][c] = vtr(Vb + vaddr[c][1]); } \
                _Pragma("unroll") for (int ks = 0; ks < 4; ++ks) { \
                    if (ks < 3) { _Pragma("unroll") for (int c = 0; c < 4; ++c) { vlo[(ks + 1) & 1][c] = vtr(Vb + vaddr[c][0] + (ks + 1) * 4096); vhi[(ks + 1) & 1][c] = vtr(Vb + vaddr[c][1] + (ks + 1) * 4096); } } \
                    __builtin_amdgcn_sched_barrier(0); \
                    _Pragma("unroll") for (int c = 0; c < 4; ++c) { const s16x4 lo = vlo[ks & 1][c], hi = vhi[ks & 1][c]; \
                        const bf16x8 a = {lo[0], lo[1], lo[2], lo[3], hi[0], hi[1], hi[2], hi[3]}; \
                        O[c] = __builtin_amdgcn_mfma_f32_32x32x16_bf16(a, P[ks], O[c], 0, 0, 0); \
                        if (FILL) { const int j = ks * 4 + c; float e0 = __builtin_amdgcn_exp2f(S0[j] - sub), e1 = __builtin_amdgcn_exp2f(S1[j] - sub); \
                            asm volatile("" : "+v"(e0), "+v"(e1)); S0[j] = e0; S1[j] = e1; lsum += e0 + e1; } \
                        __builtin_amdgcn_sched_barrier(0); } } } while (0)
            if (do_pv) {
                if (!do_qk) sub = 1e30f;
                FA_PV_STEP(true);
                if (moved) {
#pragma unroll
                    for (int c = 0; c < 4; ++c)
#pragma unroll
                        for (int i = 0; i < 16; ++i) O[c][i] *= alpha;
                }
            } else if (do_qk) {
#pragma unroll
                for (int j = 0; j < 16; ++j) { const float e0 = __builtin_amdgcn_exp2f(S0[j] - sub), e1 = __builtin_amdgcn_exp2f(S1[j] - sub); S0[j] = e0; S1[j] = e1; lsum += e0 + e1; }
            }
#undef FA_PV_STEP
            if (do_qk) {
#pragma unroll
                for (int s2 = 0; s2 < 2; ++s2) {
                    u32x4 a, c4;
                    a.x = cvtpk(S0[8 * s2 + 0], S0[8 * s2 + 1]); a.y = cvtpk(S0[8 * s2 + 2], S0[8 * s2 + 3]); a.z = cvtpk(S0[8 * s2 + 4], S0[8 * s2 + 5]); a.w = cvtpk(S0[8 * s2 + 6], S0[8 * s2 + 7]);
                    c4.x = cvtpk(S1[8 * s2 + 0], S1[8 * s2 + 1]); c4.y = cvtpk(S1[8 * s2 + 2], S1[8 * s2 + 3]); c4.z = cvtpk(S1[8 * s2 + 4], S1[8 * s2 + 5]); c4.w = cvtpk(S1[8 * s2 + 6], S1[8 * s2 + 7]);
                    P[s2] = __builtin_bit_cast(bf16x8, a); P[2 + s2] = __builtin_bit_cast(bf16x8, c4);
                }
            }
        }
#undef FA_LOAD_TILE
        lsum = sum_xor32(lsum);
        const float inv = m == 0 ? 1.0f / lsum : lam / lsum;
        asm volatile("s_waitcnt lgkmcnt(0)\n\ts_barrier" ::: "memory");
        LAS float* EX = (LAS float*)lds + (size_t)r32 * 4096 + lane;
        if (m == 1) {
#pragma unroll
            for (int c = 0; c < 4; ++c)
#pragma unroll
                for (int i = 0; i < 16; ++i) EX[(c * 16 + i) * 64] = O[c][i] * inv;
        }
        asm volatile("s_waitcnt lgkmcnt(0)\n\ts_barrier" ::: "memory");
        if (m == 0) {
            float ss = 0.f;
#pragma unroll
            for (int c = 0; c < 4; ++c)
#pragma unroll
                for (int i = 0; i < 16; ++i) { const float o = O[c][i] * inv - EX[(c * 16 + i) * 64]; O[c][i] = o; ss += o * o; }
            ss = sum_xor32(ss);
            const float rn = rsqrtf(ss * (1.0f / 128.0f) + EPS) * (1.0f - lam_init);
            bf16_t* yp = Y + (size_t)(b * SEQ + qs + r) * YW + 768 + h * 128 + 4 * hh;
            f32x4 sgv[4][4];
#pragma unroll
            for (int c = 0; c < 4; ++c)
#pragma unroll
                for (int g = 0; g < 4; ++g) sgv[c][g] = *(const f32x4*)(sg + 32 * c + 8 * g + 4 * hh);
            asm volatile("" ::: "memory");
#pragma unroll
            for (int c = 0; c < 4; ++c)
#pragma unroll
                for (int g = 0; g < 4; ++g) { const f32x4 gg = sgv[c][g];
                    u32x2 o; o.x = cvtpk(O[c][4 * g + 0] * rn * gg.x, O[c][4 * g + 1] * rn * gg.y); o.y = cvtpk(O[c][4 * g + 2] * rn * gg.z, O[c][4 * g + 3] * rn * gg.w);
                    *(u32x2*)(yp + 32 * c + 8 * g) = o; }
        }
    }
    __syncthreads();
}
}


__device__ __forceinline__ void router_rows4(const bf16_t* __restrict__ h, int t, const float* __restrict__ g, const f32x4 (&RW)[4][4][2], unsigned char* __restrict__ XNo,
                                             int* __restrict__ tok_e, float* __restrict__ tok_w, LAS int* hist, int lane) {
    f32x4 v[4][4];
#pragma unroll
    for (int i = 0; i < 4; ++i)
#pragma unroll
        for (int j = 0; j < 4; ++j) { const u32x2 h2 = ((const u32x2*)(h + (size_t)(t + i) * D))[lane + 64 * j];
            v[i][j] = (f32x4){__uint_as_float(h2.x << 16), __uint_as_float(h2.x & 0xffff0000u), __uint_as_float(h2.y << 16), __uint_as_float(h2.y & 0xffff0000u)}; }
    f32x4 gg[4];
#pragma unroll
    for (int j = 0; j < 4; ++j) gg[j] = ((const f32x4*)g)[lane + 64 * j];
#pragma unroll
    for (int i = 0; i < 4; ++i) {
        float ss = 0.f;
#pragma unroll
        for (int j = 0; j < 4; ++j) ss += (v[i][j].x * v[i][j].x + v[i][j].y * v[i][j].y) + (v[i][j].z * v[i][j].z + v[i][j].w * v[i][j].w);
        ss = wave_sum(ss);
        const float r = rsqrtf(ss * (1.0f / D) + EPS);
        float lg[8];
#pragma unroll
        for (int e = 0; e < 8; ++e) lg[e] = 0.f;
        unsigned* op = (unsigned*)(XNo + (size_t)(t + i) * D);
#pragma unroll
        for (int j = 0; j < 4; ++j) {
            const float x0 = v[i][j].x * r * gg[j].x, x1 = v[i][j].y * r * gg[j].y, x2 = v[i][j].z * r * gg[j].z, x3 = v[i][j].w * r * gg[j].w;
            op[lane + 64 * j] = pg8::pk4_fp8(pg8::sat8(x0 * pg8::F8S_HN), pg8::sat8(x1 * pg8::F8S_HN), pg8::sat8(x2 * pg8::F8S_HN), pg8::sat8(x3 * pg8::F8S_HN));
#pragma unroll
            for (int q = 0; q < 4; ++q) { const float xx = q == 0 ? x0 : (q == 1 ? x1 : (q == 2 ? x2 : x3)); const f32x4 ra = RW[j][q][0], rb = RW[j][q][1];
                lg[0] = fmaf(xx, ra.x, lg[0]); lg[1] = fmaf(xx, ra.y, lg[1]); lg[2] = fmaf(xx, ra.z, lg[2]); lg[3] = fmaf(xx, ra.w, lg[3]);
                lg[4] = fmaf(xx, rb.x, lg[4]); lg[5] = fmaf(xx, rb.y, lg[5]); lg[6] = fmaf(xx, rb.z, lg[6]); lg[7] = fmaf(xx, rb.w, lg[7]); }
        }
#pragma unroll
        for (int e = 0; e < 8; ++e) lg[e] = wave_sum(lg[e]);
        int i0 = 0; float v0 = lg[0];
#pragma unroll
        for (int e = 1; e < 8; ++e) if (lg[e] > v0) { v0 = lg[e]; i0 = e; }
        int i1 = -1; float v1 = -3e38f;
#pragma unroll
        for (int e = 0; e < 8; ++e) if (e != i0 && lg[e] > v1) { v1 = lg[e]; i1 = e; }
        const float e1 = __expf(v1 - v0);
        if (lane == 0) { tok_e[2 * (t + i)] = i0; tok_e[2 * (t + i) + 1] = i1; tok_w[2 * (t + i)] = 1.0f / (1.0f + e1); tok_w[2 * (t + i) + 1] = e1 / (1.0f + e1);
            __hip_atomic_fetch_add(&hist[i0], 1, __ATOMIC_RELAXED, __HIP_MEMORY_SCOPE_WORKGROUP); __hip_atomic_fetch_add(&hist[8 + i1], 1, __ATOMIC_RELAXED, __HIP_MEMORY_SCOPE_WORKGROUP); }
    }
}

__device__ __forceinline__ unsigned long long karg_u64(int i) {
    const __attribute__((address_space(4))) unsigned long long* ka = (const __attribute__((address_space(4))) unsigned long long*)__builtin_amdgcn_kernarg_segment_ptr();
    asm volatile("" : "+s"(ka));
    return ka[i];
}
#define AIN(i) ((const float*)karg_u64(i))
#define AOUT ((float*)karg_u64(25))
#define AWS ((unsigned char*)karg_u64(26))
__global__ void __launch_bounds__(NWAVES * 64, 2) mega(Args args) {
    extern __shared__ __attribute__((aligned(16))) unsigned char lds_raw[];
    LAS unsigned char* lds = (LAS unsigned char*)lds_raw;
    volatile LAS unsigned* MISC = (volatile LAS unsigned*)(lds + MISC_OFF);
    const int tid0 = threadIdx.x, wave = __builtin_amdgcn_readfirstlane(tid0 >> 6);
    const int G = gridDim.x, bx = blockIdx.x;
    const int gw = bx * NWAVES + wave, NGW = G * NWAVES;
#define PHASE_TID int tid = wave * 64 + lane_id(); asm volatile("" : "+v"(tid)); const int lane = tid & 63; (void)lane
    for (int u = tid0; u < (LDS_BYTES - MISC_OFF) / 4; u += NWAVES * 64) ((LAS unsigned*)(lds + MISC_OFF))[u] = 0u;
    __syncthreads();
    XcdBarrier bar = xcd_barrier_post((unsigned*)(AWS + WS_CTL) + CW_BAR, MISC + 8, wave);
#define IN(k) true
#define SEAM(k) do { if (IN(k) && IN((k) + 1)) xcd_barrier(bar); } while (0)
#ifndef PROBE_REP
#define PROBE_REP 0
#endif
#define REPFOR(bit) _Pragma("unroll") for (int rep_ = 0; rep_ < 1 + ((PROBE_REP >> (bit)) & 1); ++rep_)
#define REPBAR do { if (rep_) xcd_barrier(bar); } while (0)

#define P_x AIN(0)
#define P_out AOUT
#define P_ws AWS
#define P_Wb ((bf16_t*)(AWS + WS_W))
#define P_XN ((bf16_t*)(AWS + WS_XN))
#define P_Z ((bf16_t*)(AWS + WS_Z))
#define P_Y ((bf16_t*)(AWS + WS_Y))
#define P_HS ((bf16_t*)(AWS + WS_HS))
#define P_cnts ((int*)(AWS + WS_CNT))
#define P_tok_e ((int*)(AWS + WS_TOKE))
#define P_tok_w ((float*)(AWS + WS_TOKW))
#define P_slot_tok ((int*)(AWS + WS_SLOTT))
#define P_slot_w ((float*)(AWS + WS_SLOTW))
#define P_gbases (P_cnts + 256 * 16)

    if (IN(0)) REPFOR(0) {
        REPBAR; PHASE_TID;
        LAS float* scr = (LAS float*)(lds + wave * 16384);
        constexpr int I_IN = (1024 / 64) * (7168 / 32), I_BR = (256 / 64) * (1024 / 32), I_BA = (512 / 64) * (1024 / 32), I_OUT = (1024 / 64) * (1024 / 32);
        constexpr int I_FGU = (1024 / 64) * (5632 / 32), I_FDN = (2816 / 64) * (1024 / 32), I_MGU = (1024 / 64) * (7168 / 32), I_MDN = (3584 / 64) * (1024 / 32);
        constexpr int I_L = I_IN + 3 * I_BR + I_BA + I_OUT;
        constexpr int NITEMS = 2 * I_L + I_FGU + I_FDN + 8 * I_MGU + 8 * I_MDN;
        for (int it = gw; it < NITEMS; it += NGW) {
            int r = it;
            if (r < 2 * I_L) {
                const int layer = r / I_L; r -= layer * I_L;
                if (r < I_IN) {
                    if (32 * (r % (7168 / 32)) >= ZP) p0_transpose_item_f8(AIN(3) + (size_t)layer * 1024 * 7168, 1024, 7168, (unsigned char*)P_Wb + WOFF_IN8 + (size_t)layer * 7168 * 1024, 1024, 0, pg8::F8S_WGU, scr, r, lane);
                    else p0_transpose_item(AIN(3) + (size_t)layer * 1024 * 7168, 1024, 7168, (bf16_t*)((char*)P_Wb + WOFF_IN) + (size_t)layer * 7168 * 1024, 1024, 0, 0, scr, r, lane);
                    continue; } r -= I_IN;
                bf16_t* wm = (bf16_t*)((char*)P_Wb + WOFF_MRG) + (size_t)layer * 1024 * 1280;
                if (r < I_BR) { p0_transpose_item(AIN(14) + (size_t)layer * 256 * 1024, 256, 1024, wm, 1280, 0, 0, scr, r, lane); continue; } r -= I_BR;
                if (r < I_BR) { p0_transpose_item(AIN(15) + (size_t)layer * 256 * 1024, 256, 1024, wm, 1280, 256, 0, scr, r, lane); continue; } r -= I_BR;
                if (r < I_BR) { p0_transpose_item(AIN(16) + (size_t)layer * 256 * 1024, 256, 1024, wm, 1280, 512, 0, scr, r, lane); continue; } r -= I_BR;
                if (r < I_BA) { p0_transpose_item(AIN(17) + (size_t)layer * 512 * 1024, 512, 1024, wm, 1280, 768, 0, scr, r, lane); continue; } r -= I_BA;
                p0_transpose_item(AIN(18) + (size_t)layer * 1024 * 1024, 1024, 1024, (bf16_t*)((char*)P_Wb + WOFF_OUT) + (size_t)layer * 1024 * 1024, 1024, 0, 0, scr, r, lane); continue;
            }
            r -= 2 * I_L;
            if (r < I_FGU) { p0_transpose_item(AIN(20), 1024, 5632, (bf16_t*)((char*)P_Wb + WOFF_FGU), 1024, 0, 1, scr, r, lane); continue; } r -= I_FGU;
            if (r < I_FDN) { p0_transpose_item(AIN(21), 2816, 1024, (bf16_t*)((char*)P_Wb + WOFF_FDN), 2816, 0, 0, scr, r, lane); continue; } r -= I_FDN;
            if (r < 8 * I_MGU) { const int e = r / I_MGU; r -= e * I_MGU; p0_transpose_item_f8(AIN(23) + (size_t)e * 1024 * 7168, 1024, 7168, (unsigned char*)P_Wb + WOFF_MGU + (size_t)e * 7168 * 1024, 1024, 1, pg8::F8S_WGU, scr, r, lane); continue; } r -= 8 * I_MGU;
            { const int e = r / I_MDN; r -= e * I_MDN; p0_transpose_item_f8(AIN(24) + (size_t)e * 3584 * 1024, 3584, 1024, (unsigned char*)P_Wb + WOFF_MDN + (size_t)e * 1024 * 3584, 3584, 0, pg8::F8S_WDN, scr, r, lane); }
        }
        for (int i = bx * 512 + tid; i < 2 * 4 * 128 * 128; i += G * 512) { const int q = i & 127, p_ = (i >> 7) & 127; ((bf16_t*)((char*)P_Wb + WOFF_SGU))[i] = q <= p_ ? f2bf(AIN(8)[i]) : (bf16_t)0; }
        for (int i = bx * 512 + tid; i < 2 * 4 * 64 * 64; i += G * 512) { const int c = i & 63, d = (i >> 6) & 63, lg = i >> 12; ((bf16_t*)((char*)P_Wb + WOFF_POOL))[i] = f2bf(AIN(4)[((size_t)lg * 64 + c) * 64 + d]); }
        {
            const float* g1 = AIN(2); unsigned char* xn8 = (unsigned char*)P_Wb + WOFF_XN8;
            for (int m = gw; m + 3 * NGW < T; m += 4 * NGW) rms_rows4<true>(P_x, m, NGW, g1, P_XN, xn8, lane);
            for (int m = gw + (((T - gw + NGW - 1) / NGW) & ~3) * NGW; m < T; m += NGW) rms_row<true>(P_x + (size_t)m * D, g1, P_XN + (size_t)m * D, xn8 + (size_t)m * D, lane);
        }
    }
    SEAM(0);

#pragma unroll
    for (int layer = 0; layer < 2; ++layer) {
        const int pb = 1 + layer * 16;
        const float lam_init = layer == 0 ? 0.2f : 0.35550906f;

        if (layer != 0) {
            if (IN(pb + 0)) REPFOR(1) { REPBAR; PHASE_TID; const float* g1 = AIN(2) + layer * D;
                unsigned char* xn8 = (unsigned char*)P_Wb + WOFF_XN8;
                for (int m = gw; m + 3 * NGW < T; m += 4 * NGW) rms_rows4_bf<true>(P_HS, m, NGW, g1, P_XN, xn8, lane);
                for (int m = gw + (((T - gw + NGW - 1) / NGW) & ~3) * NGW; m < T; m += NGW) rms_row_bf<true>(P_HS + (size_t)m * D, g1, P_XN + (size_t)m * D, xn8 + (size_t)m * D, lane); }
            SEAM(pb + 0);
        }
        if (IN(pb + 1)) REPFOR(2) {
            REPBAR;
            {
                pg8::Gemm g{(const char*)P_Wb + WOFF_XN8, D / 2, D / 2}; pg8::SchedPlainOff S{T / 256, (INC - ZP) / 256, ZP / 256, G, bx, D / 128, (const char*)P_Wb + WOFF_IN8 + (size_t)layer * 7168 * 1024};
                pg8::EpiZ<true> E{P_Z, (bf16_t*)(P_ws + WS_G), AIN(10) + layer * 64, AIN(11) + layer * 64, (LAS float*)(lds + pg8::STAGE_BYTES)};
                pg8::gemm_phase<pg8::EpiZ<true>, pg8::SchedPlainOff, true, true>(lds, g, S, E, wave);
            }
            {
                pg8::Gemm g{(const char*)P_XN, D, D}; pg8::SchedPlain S{T / 256, ZP / 256, G, bx, D / 64, (const char*)P_Wb + WOFF_IN + (size_t)layer * 7168 * 1024 * 2};
                pg8::EpiZ<false> E{P_Z, (bf16_t*)(P_ws + WS_G), AIN(10) + layer * 64, AIN(11) + layer * 64, (LAS float*)(lds + pg8::STAGE_BYTES)};
                pg8::gemm_phase<pg8::EpiZ<false>, pg8::SchedPlain, true>(lds, g, S, E, wave);
            }
        }
        SEAM(pb + 1);
        if (IN(pb + 2)) {
            PHASE_TID;
            const float* cw = AIN(6) + layer * 768;
            REPFOR(3) { REPBAR;
            for (int t = gw; t + 3 * NGW < T; t += 4 * NGW) conv_rows4(P_Z, t, NGW, cw, P_Y, lane);
            for (int t = gw + (((T - gw + NGW - 1) / NGW) & ~3) * NGW; t < T; t += NGW) conv_row(P_Z, t, cw, P_Y, lane);
            for (int u = gw; u < (T / 32) * 4; u += NGW) pool_unit_mfma(P_Z, (const bf16_t*)((const char*)P_Wb + WOFF_POOL) + (size_t)layer * 16384, AIN(5) + layer * 256, P_Y, u, lane);
            for (int it = bx; it < T / 128; it += G) sgu_seg_mfma(P_Z, AIN(7) + layer * 256, (const bf16_t*)((const char*)P_Wb + WOFF_SGU) + (size_t)layer * 65536, AIN(9) + layer * 512, P_Y, lds, it, tid);
            }
        }
        if (IN(pb + 3)) REPFOR(4) {
            REPBAR;
            fa::attn_phase(lds, P_Z, AIN(1), AIN(12) + layer * 256, AIN(13) + layer * 128, lam_init, P_Y, G, bx, wave);
        }
        SEAM(pb + 3);
        if (IN(pb + 4)) REPFOR(5) {
            REPBAR;
            __syncthreads();
            pg8::Gemm g{(const char*)P_Y, YW, YW}; pg8::SchedMerge S{T / 256, D / 256, G, bx, (const char*)P_Wb + WOFF_MRG + (size_t)layer * 1024 * 1280 * 2};
            pg8::EpiMerge E{(const bf16_t*)(P_ws + WS_G), P_XN};
            pg8::gemm_phase<pg8::EpiMerge, pg8::SchedMerge, true>(lds, g, S, E, wave);
        }
        SEAM(pb + 4);
        if (IN(pb + 5)) {
            pg8::Gemm g{(const char*)P_XN, D, D}; pg8::SchedPlain S{T / 256, D / 256, G, bx, D / 64, (const char*)P_Wb + WOFF_OUT + (size_t)layer * 1024 * 1024 * 2};
            if (layer == 0) { pg8::EpiResid<false, true> E{P_x, P_HS}; pg8::gemm_phase<pg8::EpiResid<false, true>, pg8::SchedPlain, true>(lds, g, S, E, wave); }
            else { pg8::EpiResid<true, true> E{P_HS, P_HS}; pg8::gemm_phase<pg8::EpiResid<true, true>, pg8::SchedPlain, true>(lds, g, S, E, wave); }
        }
        SEAM(pb + 5);
        if (layer == 0) {
            if (IN(pb + 6)) REPFOR(7) { REPBAR; PHASE_TID; const float* g2 = AIN(19); for (int m = gw; m + 3 * NGW < T; m += 4 * NGW) rms_rows4_bf<false>(P_HS, m, NGW, g2, P_XN, nullptr, lane);
                for (int m = gw + (((T - gw + NGW - 1) / NGW) & ~3) * NGW; m < T; m += NGW) rms_row_bf<false>(P_HS + (size_t)m * D, g2, P_XN + (size_t)m * D, nullptr, lane); }
            SEAM(pb + 6);
            if (IN(pb + 7)) REPFOR(8) {
                REPBAR;
                pg8::Gemm g{(const char*)P_XN, D, D}; pg8::SchedPlain S{T / 256, 2 * DFF / 256, G, bx, D / 64, (const char*)P_Wb + WOFF_FGU};
                pg8::EpiSwi E{P_Z, DFF};
                pg8::gemm_phase<pg8::EpiSwi, pg8::SchedPlain, true>(lds, g, S, E, wave);
            }
            SEAM(pb + 7);
            if (IN(pb + 8)) {
                pg8::Gemm g{(const char*)P_Z, DFF, DFF}; pg8::SchedPlainRev S{T / 256, D / 256, G, bx, DFF / 64, (const char*)P_Wb + WOFF_FDN};
                pg8::EpiResid<true, true> E{P_HS, P_HS};
                pg8::gemm_phase<pg8::EpiResid<true, true>, pg8::SchedPlainRev, true>(lds, g, S, E, wave);
            }
            SEAM(pb + 8);
        } else {
            if (IN(pb + 6)) REPFOR(7) {
                REPBAR; PHASE_TID;
                const float* g2 = AIN(19) + D; const float* rw = AIN(22);
                LAS int* hist = (LAS int*)lds;
                f32x4 RW[4][4][2];
#pragma unroll
                for (int j = 0; j < 4; ++j)
#pragma unroll
                    for (int q = 0; q < 4; ++q) { const f32x4* rp = (const f32x4*)(rw + (size_t)((lane + 64 * j) * 4 + q) * 8); RW[j][q][0] = rp[0]; RW[j][q][1] = rp[1]; }
                for (int ch = bx; ch < 256; ch += G) {
                    if (tid < 16) hist[tid] = 0;
                    __syncthreads();
#pragma unroll 1
                    for (int i = 0; i < 16; i += 4) router_rows4(P_HS, ch * 128 + wave * 16 + i, g2, RW, (unsigned char*)P_XN, P_tok_e, P_tok_w, hist, lane);
                    __syncthreads();
                    if (tid < 16) P_cnts[ch * 16 + tid] = hist[tid];
                    __syncthreads();
                }
            }
            SEAM(pb + 6);
            if (IN(pb + 7)) REPFOR(9) {
                REPBAR; PHASE_TID;
                LAS int* C = (LAS int*)lds;
                LAS int* PT = C + 4096;
                LAS int* TOT = PT + 1024; LAS int* BASE = TOT + 16; LAS int* PRE = BASE + 32; LAS int* W0C = PRE + 16;
                for (int i = tid; i < 4096; i += 512) C[i] = P_cnts[i];
                __syncthreads();
                { const int g = tid & 15, part = tid >> 4; int s_ = 0;
#pragma unroll
                  for (int c = 0; c < 8; ++c) s_ += C[(part * 8 + c) * 16 + g];
                  PT[part * 16 + g] = s_; }
                __syncthreads();
                if (tid < 16) { int s_ = 0; for (int q = 0; q < 32; ++q) s_ += PT[q * 16 + tid]; TOT[tid] = s_; }
                __syncthreads();
                if (tid == 0) { int b_ = 0; for (int g = 0; g < 16; ++g) { BASE[g] = b_; b_ += (TOT[g] + 255) & ~255; } BASE[16] = b_; }
                __syncthreads();
                if (bx == 0 && tid < 17) P_gbases[tid] = BASE[tid];
                for (int g = bx; g < 16; g += G) { for (int s_ = BASE[g] + TOT[g] + tid; s_ < BASE[g + 1]; s_ += 512) { P_slot_tok[s_] = -1; P_slot_w[s_] = 0.f; } }
                for (int ch = bx; ch < 256; ch += G) {
                    { const int g = tid & 15, part = tid >> 4; int s_ = 0;
#pragma unroll
                      for (int c = 0; c < 8; ++c) { const int cc = part * 8 + c; s_ += cc < ch ? C[cc * 16 + g] : 0; }
                      PT[512 + part * 16 + g] = s_; }
                    __syncthreads();
                    if (tid < 16) { int s_ = 0; for (int q = 0; q < 32; ++q) s_ += PT[512 + q * 16 + tid]; PRE[tid] = s_; }
                    int e0 = 0, e1 = 0, p0 = 0, p1 = 0;
                    if (tid < 128) { const int t = ch * 128 + tid; e0 = P_tok_e[2 * t]; e1 = 8 + P_tok_e[2 * t + 1];
#pragma unroll
                        for (int g = 0; g < 8; ++g) {
                            const unsigned long long m0 = __ballot(e0 == g), m1 = __ballot(e1 == 8 + g);
                            const int b0 = (int)__builtin_amdgcn_mbcnt_hi((unsigned)(m0 >> 32), __builtin_amdgcn_mbcnt_lo((unsigned)m0, 0u)), b1 = (int)__builtin_amdgcn_mbcnt_hi((unsigned)(m1 >> 32), __builtin_amdgcn_mbcnt_lo((unsigned)m1, 0u));
                            if (e0 == g) p0 = b0;
                            if (e1 == 8 + g) p1 = b1;
                            if (tid == 0) { W0C[g] = __popcll(m0); W0C[8 + g] = __popcll(m1); }
                        } }
                    __syncthreads();
                    if (tid < 128) { const int t = ch * 128 + tid;
                        if (tid >= 64) { p0 += W0C[e0]; p1 += W0C[e1]; }
                        const int s0 = BASE[e0] + PRE[e0] + p0, s1 = BASE[e1] + PRE[e1] + p1;
                        P_slot_tok[s0] = t; P_slot_w[s0] = P_tok_w[2 * t] * (1.0f / (pg8::F8S_ACT * pg8::F8S_WDN)); P_slot_tok[s1] = t; P_slot_w[s1] = P_tok_w[2 * t + 1] * (1.0f / (pg8::F8S_ACT * pg8::F8S_WDN)); }
                    __syncthreads();
                }
            }
            SEAM(pb + 7);
            LAS int* tg = (LAS int*)(lds + TG_OFF);
            if (IN(pb + 8) || IN(pb + 9) || IN(pb + 10) || IN(pb + 11)) {
                PHASE_TID;
                if (tid < 288) { const int r = tid * 256; int g = 0; int gb[16];
#pragma unroll
                    for (int q = 0; q < 16; ++q) gb[q] = P_gbases[q];
#pragma unroll
                    for (int q = 1; q < 16; ++q) if (r >= gb[q]) g = q;
                    tg[tid] = g; }
                __syncthreads();
            }
            if (IN(pb + 8)) REPFOR(10) {
                REPBAR;
                const int nT = __builtin_amdgcn_readfirstlane(P_gbases[16] >> 8);
                pg8::Gemm g{(const char*)P_XN, D / 2, D / 2}; pg8::SchedMoe1 S{nT, G, bx, (const char*)P_Wb + WOFF_MGU, P_slot_tok, tg};
                pg8::EpiSwi8<true> E{(unsigned char*)P_Z, DFE};
                pg8::gemm_phase<pg8::EpiSwi8<true>, pg8::SchedMoe1, true, true>(lds, g, S, E, wave);
            }
            SEAM(pb + 8);
            if (IN(pb + 9)) {
                const int t0 = 0, nT = 128;
                pg8::Gemm g{(const char*)P_Z, DFE / 2, DFE / 2}; pg8::SchedMoe2 S{t0, nT, G, bx, (const char*)P_Wb + WOFF_MDN, tg};
                pg8::EpiMoeDown<true> E{P_slot_tok, P_slot_w, P_out, P_HS};
                pg8::gemm_phase<pg8::EpiMoeDown<true>, pg8::SchedMoe2, true, true>(lds, g, S, E, wave);
            }
            SEAM(pb + 9);
            if (IN(pb + 10)) {
                const int t0 = __builtin_amdgcn_readfirstlane(P_gbases[8] >> 8), nT = 128;
                {
                    PHASE_TID; const int t2 = __builtin_amdgcn_readfirstlane(P_gbases[16] >> 8);
                    for (int s_ = (t0 + 128) * 256 + gw; s_ < t2 * 256; s_ += NGW) { const int tok = __builtin_amdgcn_readfirstlane(P_slot_tok[s_]);
                        if (tok >= 0) {
#pragma unroll
                            for (int j = 0; j < 4; ++j) { const u32x2 h2 = ((const u32x2*)(P_HS + (size_t)tok * D))[lane + 64 * j];
                                ((f32x4*)(P_out + (size_t)tok * D))[lane + 64 * j] = (f32x4){__uint_as_float(h2.x << 16), __uint_as_float(h2.x & 0xffff0000u), __uint_as_float(h2.y << 16), __uint_as_float(h2.y & 0xffff0000u)}; } } }
                }
                pg8::Gemm g{(const char*)P_Z, DFE / 2, DFE / 2}; pg8::SchedMoe2 S{t0, nT, G, bx, (const char*)P_Wb + WOFF_MDN, tg};
                pg8::EpiMoeDown<false> E{P_slot_tok, P_slot_w, P_out, P_HS};
                pg8::gemm_phase<pg8::EpiMoeDown<false>, pg8::SchedMoe2, true, true>(lds, g, S, E, wave);
            }
            SEAM(pb + 10);
            if (IN(pb + 11)) {
                const int t1 = __builtin_amdgcn_readfirstlane(P_gbases[8] >> 8), s0 = t1 - 128, s1 = __builtin_amdgcn_readfirstlane(P_gbases[16] >> 8) - t1 - 128;
                pg8::Gemm g{(const char*)P_Z, DFE / 2, DFE / 2}; pg8::SchedMoe3 S{s0, s1, t1, G, bx, (const char*)P_Wb + WOFF_MDN, tg};
                pg8::EpiMoeDownAtomic E{P_slot_tok, P_slot_w, P_out};
                pg8::gemm_phase<pg8::EpiMoeDownAtomic, pg8::SchedMoe3, true, true>(lds, g, S, E, wave);
            }
        }
    }
#undef IN
#undef SEAM
#undef REPFOR
#undef REPBAR
#undef PHASE_TID
}

static void launch_mega(const Args& base, int lo, int hi, int grid, unsigned char* ws, hipStream_t stream) {
    Args a = base; a.ph_lo = lo; a.ph_hi = hi;
    (void)hipMemsetAsync(ws + WS_CTL, 0, CTL_ZERO_BYTES, stream);
    hipLaunchKernelGGL(mega, dim3(grid), dim3(NWAVES * 64), LDS_BYTES, stream, a);
}

extern "C" void kernel_launch(void* const* d_in, const int* in_sizes, int n_in, void* d_out, int out_size, void* d_ws, size_t ws_size, hipStream_t stream) {
    float* out = (float*)d_out;
    unsigned char* ws = (unsigned char*)d_ws;

    static int grid = 0;
    if (grid == 0) {
        if (n_in != 25 || ws_size < WS_END) { fprintf(stderr, "kernel_launch: n_in %d ws %zu (need %zu)\n", n_in, ws_size, (size_t)WS_END); grid = -1; return; }
        int dev = 0, cus = 0, per_cu = 0;
        if (hipGetDevice(&dev) != hipSuccess || hipDeviceGetAttribute(&cus, hipDeviceAttributeMultiprocessorCount, dev) != hipSuccess) { grid = -1; return; }
        if (hipFuncSetAttribute((const void*)mega, hipFuncAttributeMaxDynamicSharedMemorySize, LDS_BYTES) != hipSuccess) { fprintf(stderr, "hipFuncSetAttribute failed\n"); grid = -1; return; }
        if (hipOccupancyMaxActiveBlocksPerMultiprocessor(&per_cu, (const void*)mega, NWAVES * 64, LDS_BYTES) != hipSuccess || per_cu < 1) { fprintf(stderr, "occupancy query: %d\n", per_cu); }
        (void)hipGetLastError();
        grid = cus;
    }
    if (grid < 0) return;
    Args base{};
    for (int i = 0; i < 25; ++i) base.in[i] = (const float*)d_in[i];
    base.out = out; base.ws = ws;

    launch_mega(base, 0, 29, grid, ws, stream);
}
```

```cpp
#include <hip/hip_runtime.h>
#include <stdint.h>
#include <stdio.h>

typedef unsigned short bf16_t;
constexpr int T = 32768, D = 1024, SEQ = 2048;
constexpr int INC = 7168;
constexpr int ZP = 3072;
constexpr int OFF_POOL = 0, OFF_CONV = 256, OFF_SGU = 1024, OFF_ATTN = 1536, OFF_GATE = 3072;
constexpr int DFF = 2816, DFE = 3584, NE = 8;
constexpr int YW = 1280;
constexpr float EPS = 1e-6f;

__device__ __forceinline__ float bf2f(bf16_t v) { return __uint_as_float((unsigned)v << 16); }
__device__ __forceinline__ bf16_t f2bf(float f) { unsigned u = __float_as_uint(f); return (bf16_t)((u + 0x7fffu + ((u >> 16) & 1u)) >> 16); }
template <int CTRL> __device__ __forceinline__ float dpp_(float x) { return __builtin_bit_cast(float, __builtin_amdgcn_mov_dpp(__builtin_bit_cast(int, x), CTRL, 0xf, 0xf, true)); }
__device__ __forceinline__ float sum_xor16(float x) { auto s_ = __builtin_amdgcn_permlane16_swap(__float_as_uint(x), __float_as_uint(x), false, false); return __uint_as_float(s_[0]) + __uint_as_float(s_[1]); }
__device__ __forceinline__ float sum_xor32(float x) { auto s_ = __builtin_amdgcn_permlane32_swap(__float_as_uint(x), __float_as_uint(x), false, false); return __uint_as_float(s_[0]) + __uint_as_float(s_[1]); }
__device__ __forceinline__ float max_xor16(float x) { auto s_ = __builtin_amdgcn_permlane16_swap(__float_as_uint(x), __float_as_uint(x), false, false); return fmaxf(__uint_as_float(s_[0]), __uint_as_float(s_[1])); }
__device__ __forceinline__ float max_xor32(float x) { auto s_ = __builtin_amdgcn_permlane32_swap(__float_as_uint(x), __float_as_uint(x), false, false); return fmaxf(__uint_as_float(s_[0]), __uint_as_float(s_[1])); }
__device__ __forceinline__ float quad_sum(float v) { v += dpp_<0xB1>(v); v += dpp_<0x4E>(v); return v; }
__device__ __forceinline__ float wave_sum(float v) {
    v += dpp_<0xB1>(v); v += dpp_<0x4E>(v); v += dpp_<0x141>(v); v += dpp_<0x128>(v);
    return sum_xor32(sum_xor16(v));
}
__device__ __forceinline__ float wave_max(float v) {
    v = fmaxf(v, dpp_<0xB1>(v)); v = fmaxf(v, dpp_<0x4E>(v)); v = fmaxf(v, dpp_<0x141>(v)); v = fmaxf(v, dpp_<0x128>(v));
    return max_xor32(max_xor16(v));
}

__device__ __forceinline__ int rel_bucket(int rel) {
    const int n = rel < 0 ? -rel : rel; int v;
    if (n < 8) v = n; else if (n < 12) v = 8; else if (n < 16) v = 9; else if (n < 23) v = 10; else if (n < 32) v = 11; else if (n < 46) v = 12; else if (n < 64) v = 13; else if (n < 91) v = 14; else v = 15;
    return (rel > 0 ? 16 : 0) + v;
}


#define GAS __attribute__((address_space(1)))
#define LAS __attribute__((address_space(3)))
typedef float f32x4 __attribute__((ext_vector_type(4)));
typedef float f32x2 __attribute__((ext_vector_type(2)));
typedef short bf16x8 __attribute__((ext_vector_type(8)));
typedef unsigned u32x4 __attribute__((ext_vector_type(4)));
typedef unsigned u32x2 __attribute__((ext_vector_type(2)));
typedef int i32x4 __attribute__((ext_vector_type(4)));
typedef int i32x8 __attribute__((ext_vector_type(8)));

constexpr int NWAVES = 8;
constexpr size_t MiB = 1u << 20;
constexpr size_t WS_CTL = 0, CTL_ZERO_BYTES = 64 * 1024;
constexpr size_t WS_CNT = 64 * 1024;
constexpr size_t WS_TOKE = 128 * 1024;
constexpr size_t WS_TOKW = WS_TOKE + 256 * 1024;
constexpr size_t WS_SLOTT = WS_TOKW + 256 * 1024;
constexpr size_t WS_SLOTW = WS_SLOTT + 320 * 1024;
constexpr size_t WS_W = 4 * MiB;
constexpr size_t WOFF_IN = 0;
constexpr size_t WOFF_MRG = WOFF_IN + 2ull * 7168 * 1024 * 2;
constexpr size_t WOFF_OUT = WOFF_MRG + 2ull * 1024 * 1280 * 2;
constexpr size_t WOFF_FGU = WOFF_OUT + 2ull * 1024 * 1024 * 2;
constexpr size_t WOFF_FDN = WOFF_FGU + 5632ull * 1024 * 2;
constexpr size_t WOFF_MGU = WOFF_FDN + 1024ull * 2816 * 2;
constexpr size_t WOFF_XN8 = WOFF_MGU + 56 * MiB;
constexpr size_t WOFF_IN8 = WOFF_MGU + 88 * MiB;
constexpr size_t WOFF_MDN = WOFF_MGU + 8ull * 7168 * 1024 * 2;
constexpr size_t WOFF_SGU = WOFF_MDN + 8ull * 1024 * 3584 * 2;
constexpr size_t WOFF_POOL = WOFF_SGU + 2ull * 4 * 128 * 128 * 2;
constexpr size_t W_BYTES = WOFF_POOL + 2ull * 4 * 64 * 64 * 2;
static_assert(W_BYTES <= 222 * MiB, "weights");
constexpr size_t WS_XN = WS_W + 222 * MiB;
constexpr size_t WS_Z = WS_XN + 64 * MiB;
constexpr size_t WS_G = WS_Z + 192 * MiB;
constexpr size_t WS_Y = WS_Z + 448 * MiB;
constexpr size_t WS_HS = WS_Y + 80 * MiB;
constexpr size_t WS_END = WS_HS + 64 * MiB;
constexpr int SLOT_CAP = 69632;

constexpr int CW_BAR = 1024;
constexpr int RING_BYTES = 131072;
constexpr int MISC_OFF = RING_BYTES + 12288;
constexpr int TG_OFF = MISC_OFF + 256;
constexpr int LDS_BYTES = 151552;

#define XB_TMO      128
#define XB_XCNT(j)  (256  + 64 * (j))
#define XB_XSUB(j)  (1280 + 64 * (j))
#define XB_XGEN(j)  (2304 + 64 * (j))
#define XB_TOP      3328
#define XB_TOPGEN   3392
#define XCD_BAR_WORDS 3456
#define XB_SPIN_CAP (1u << 22)
__device__ __forceinline__ unsigned xb_ld(unsigned* p)              { return __hip_atomic_load(p, __ATOMIC_RELAXED, __HIP_MEMORY_SCOPE_AGENT); }
__device__ __forceinline__ unsigned xb_add(unsigned* p, unsigned v) { return __hip_atomic_fetch_add(p, v, __ATOMIC_RELAXED, __HIP_MEMORY_SCOPE_AGENT); }
__device__ __forceinline__ unsigned xb_xcc_id() { return (unsigned)__builtin_amdgcn_s_getreg((3 << 11) | 20) & 0xFu; }
#define XB_SPIN(cond, bar) do { unsigned _sp = 0; while (cond) { __builtin_amdgcn_s_sleep(1); \
    if ((++_sp & 255u) == 0u) { if (xb_ld(&(bar)[XB_TMO])) break; if (_sp > XB_SPIN_CAP) { atomicAdd(&(bar)[XB_TMO], 1u); break; } } } } while (0)
__device__ __forceinline__ int lane_id() { unsigned m = ~0u; asm volatile("" : "+s"(m)); return (int)__builtin_amdgcn_mbcnt_hi(m, __builtin_amdgcn_mbcnt_lo(m, 0u)); }
struct XcdBarrier { unsigned* bar; unsigned x; volatile LAS unsigned* st; int wave; };
__device__ __forceinline__ XcdBarrier xcd_barrier_post(unsigned* bar, volatile LAS unsigned* st, int wave) {
    XcdBarrier b; b.bar = bar; b.x = xb_xcc_id(); b.st = st; b.wave = wave;
    if (threadIdx.x == 0) (void)xb_add(&bar[XB_XCNT(b.x)], 1u);
    return b;
}
__device__ __forceinline__ void xcd_barrier_complete(unsigned* bar, unsigned x, unsigned& nloc, unsigned& nx) {
    const unsigned G = gridDim.x * gridDim.y * gridDim.z;
    unsigned sum, cnt, mine, sp = 0u;
    for (;;) {
        sum = 0u; cnt = 0u; mine = 0u;
#pragma unroll
        for (unsigned j = 0; j < 16; ++j) { const unsigned c = xb_ld(&bar[XB_XCNT(j)]); sum += c; cnt += (c > 0u) ? 1u : 0u; mine = (j == x) ? c : mine; }
        if (sum == G) break;
        __builtin_amdgcn_s_sleep(1);
        if ((++sp & 255u) == 0u) { if (xb_ld(&bar[XB_TMO])) break; if (sp > XB_SPIN_CAP) { atomicAdd(&bar[XB_TMO], 1u); break; } }
    }
    nloc = mine > 0u ? mine : 1u; nx = cnt > 0u ? cnt : 1u;
}
__device__ __forceinline__ void xcd_barrier(const XcdBarrier& b) {
    asm volatile("s_waitcnt vmcnt(0)" ::: "memory");
    __syncthreads();
    if (b.wave == 0 && lane_id() == 0) {
        unsigned* bar = b.bar; unsigned bx_ = b.x;
        asm volatile("" : "+s"(bar), "+s"(bx_));
        __builtin_amdgcn_s_waitcnt(0);
        unsigned nloc = b.st[0], nx = b.st[1];
        if (nloc == 0u) { xcd_barrier_complete(bar, bx_, nloc, nx); b.st[0] = nloc; b.st[1] = nx; }
        const unsigned old = xb_add(&bar[XB_XSUB(bx_)], 1u);
        const unsigned gen = old / nloc;
        if (old + 1u == (gen + 1u) * nloc) {
            __builtin_amdgcn_fence(__ATOMIC_RELEASE, "agent");
            asm volatile("s_waitcnt vmcnt(0)" ::: "memory");
            const unsigned og = xb_add(&bar[XB_TOP], 1u);
            const unsigned tg = og / nx;
            if (og + 1u == (tg + 1u) * nx) xb_add(&bar[XB_TOPGEN], 1u);
            else XB_SPIN(xb_ld(&bar[XB_TOPGEN]) == tg, bar);
            __builtin_amdgcn_fence(__ATOMIC_ACQUIRE, "agent");
            xb_add(&bar[XB_XGEN(bx_)], 1u);
            asm volatile("s_waitcnt vmcnt(0)" ::: "memory");
        } else {
            XB_SPIN(xb_ld(&bar[XB_XGEN(bx_)]) == gen, bar);
            __builtin_amdgcn_fence(__ATOMIC_ACQUIRE, "agent");
            asm volatile("s_waitcnt vmcnt(0)" ::: "memory");
        }
    }
    __syncthreads();
}

namespace pg8 {
constexpr int BM = 256, BK = 64, HALF = 128, HTB = HALF * BK * 2, STAGE_BYTES = 8 * HTB, NXCD = 8;
#ifndef WGM_BIG
#define WGM_BIG 2
#endif
#ifndef WGM_SMALL
#define WGM_SMALL 4
#endif
__host__ __device__ __forceinline__ int lds_byte(int r, int c) { const int st = (r >> 4) * 2 + (c >> 5), rr = r & 15, cc = c & 31, ob = rr * 64 + cc * 2; return st * 1024 + (ob ^ (((ob >> 9) & 1) << 5)); }
__host__ __device__ __forceinline__ void stage_rc(int b, int& R, int& C) { const int st = b / 1024, sb = b % 1024, swz = sb ^ (((sb >> 9) & 1) << 5); R = (st >> 1) * 16 + swz / 64; C = (st & 1) * 32 + (swz % 64) / 2; }
__host__ __device__ __forceinline__ int perm32(int rho) { const int n = rho >> 4, i = rho & 15; return 8 * (i >> 2) + 4 * n + (i & 3); }

struct Unit { int pm, pn, kb, nt, idx; const char* B; };
struct Gemm { const char* A; int lda, ldb; };

__device__ __forceinline__ bool static_tile(int nM, int nN, int G, int c, int i, int& pm, int& pn) {
    const int WGM = nN > 4 ? WGM_BIG : WGM_SMALL;
    const int nwg = nM * nN; const long L = (long)i * G + c; if (L >= nwg) return false;
    int wgid = (int)L; { const int q = nwg / NXCD, r = nwg % NXCD, xcd = wgid % NXCD, off = wgid / NXCD; wgid = (xcd < r ? xcd * (q + 1) : r * (q + 1) + (xcd - r) * q) + off; }
    const int nig = WGM * nN, gid = wgid / nig, fm = gid * WGM, gsz = (nM - fm) < WGM ? (nM - fm) : WGM;
    pm = fm + ((wgid % nig) % gsz); pn = (wgid % nig) / gsz; return true;
}
struct SchedPlain {
    static constexpr bool GATHER = false;
    int nM, nN, G, c, nt; const char* B;
    __device__ __forceinline__ bool next(int i, Unit& u) const { if (!static_tile(nM, nN, G, c, i, u.pm, u.pn)) return false; u.kb = 0; u.nt = nt; u.B = B; return true; }
    __device__ __forceinline__ int arow(const Unit& u, int r) const { return u.pm * BM + r; }
};
struct SchedPlainRev {
    static constexpr bool GATHER = false;
    int nM, nN, G, c, nt; const char* B;
    __device__ __forceinline__ bool next(int i, Unit& u) const { if (!static_tile(nM, nN, G, c, i, u.pm, u.pn)) return false; u.pm = nM - 1 - u.pm; u.kb = 0; u.nt = nt; u.B = B; return true; }
    __device__ __forceinline__ int arow(const Unit& u, int r) const { return u.pm * BM + r; }
};
struct SchedPlainOff {
    static constexpr bool GATHER = false;
    int nM, nN, pn0, G, c, nt; const char* B;
    __device__ __forceinline__ bool next(int i, Unit& u) const { if (!static_tile(nM, nN, G, c, i, u.pm, u.pn)) return false; u.pn += pn0; u.kb = 0; u.nt = nt; u.B = B; return true; }
    __device__ __forceinline__ int arow(const Unit& u, int r) const { return u.pm * BM + r; }
};
struct SchedMerge {
    static constexpr bool GATHER = false;
    int nM, nN, G, c; const char* B;
    __device__ __forceinline__ bool next(int i, Unit& u) const { if (!static_tile(nM, nN, G, c, i >> 2, u.pm, u.pn)) return false; const int br = i & 3; u.kb = br * 512; u.nt = br == 3 ? 8 : 4; u.idx = i; u.B = B; return true; }
    __device__ __forceinline__ int arow(const Unit& u, int r) const { return u.pm * BM + r; }
};
struct SchedMoe1 {
    static constexpr bool GATHER = true;
    int nT, G, c; const char* B; const int* slot_tok; const LAS int* tg;
    __device__ __forceinline__ bool next(int i, Unit& u) const { if (!static_tile(nT, 28, G, c, i, u.pm, u.pn)) return false; u.kb = 0; u.nt = 8; u.B = B + (size_t)(__builtin_amdgcn_readfirstlane(tg[u.pm]) & 7) * (7168ull * 1024); return true; }
    __device__ __forceinline__ int arow(const Unit& u, int r) const { const int t = slot_tok[u.pm * BM + r]; return t < 0 ? 0 : t; }
};
struct SchedMoe2 {
    static constexpr bool GATHER = false;
    int t0, nT, G, c; const char* B; const LAS int* tg;
    __device__ __forceinline__ bool next(int i, Unit& u) const { if (!static_tile(nT, 4, G, c, i, u.pm, u.pn)) return false; u.pm = t0 + nT - 1 - u.pm; u.kb = 0; u.nt = 28; u.B = B + (size_t)(__builtin_amdgcn_readfirstlane(tg[u.pm]) & 7) * (1024ull * 3584); return true; }
    __device__ __forceinline__ int arow(const Unit& u, int r) const { return u.pm * BM + r; }
};

struct SchedMoe3 {
    static constexpr bool GATHER = false;
    int s0, s1, t1, G, c; const char* B; const LAS int* tg;
    __device__ __forceinline__ bool next(int i, Unit& u) const { const int L = i * G + c; if (L >= (s0 + s1) * 16) return false; const int kp = L & 3, st = L >> 4;
        u.pn = (L >> 2) & 3; u.pm = st < s0 ? 128 + st : t1 + 128 + (st - s0); u.kb = (kp < 2 ? kp * 8 : 16 + (kp - 2) * 6) * 128; u.nt = kp < 2 ? 8 : 6; u.B = B + (size_t)(__builtin_amdgcn_readfirstlane(tg[u.pm]) & 7) * (1024ull * 3584); return true; }
    __device__ __forceinline__ int arow(const Unit& u, int r) const { return u.pm * BM + r; }
};

__device__ __forceinline__ unsigned cvt_pk_bf16(float lo, float hi) { unsigned r; asm volatile("v_cvt_pk_bf16_f32 %0, %1, %2" : "=v"(r) : "v"(lo), "v"(hi)); return r; }
__device__ __forceinline__ f32x2 gelu_pk(f32x2 v) {
    const f32x2 av = __builtin_elementwise_abs(v), d = av * 0.2316418882f + 1.0f;
    f32x2 t; t.x = __builtin_amdgcn_rcpf(d.x); t.y = __builtin_amdgcn_rcpf(d.y);
    f32x2 q = t * 0.5307027145f + (-0.7265760135f); q = q * t + 0.7107068705f; q = q * t + (-0.142248368f); q = q * t + 0.127414796f; q = q * t;
    const f32x2 s = (v * v) * (-0.72134752044f);
    f32x2 e; e.x = __builtin_amdgcn_exp2f(s.x); e.y = __builtin_amdgcn_exp2f(s.y);
    const f32x2 m = v * (q * e), r = v - m;
    f32x2 o; o.x = v.x < 0.f ? m.x : r.x; o.y = v.y < 0.f ? m.y : r.y; return o;
}
__device__ __forceinline__ void swiglu8(const f32x4 G0, const f32x4 G1, const f32x4 U0, const f32x4 U1, float negl, float c2, f32x4& v0, f32x4& v1) {
    const f32x4 a0 = G0 * negl, a1 = G1 * negl;
    f32x4 e0, e1;
#pragma unroll
    for (int j = 0; j < 4; ++j) { e0[j] = __builtin_amdgcn_exp2f(a0[j]); e1[j] = __builtin_amdgcn_exp2f(a1[j]); }
    const f32x4 p0 = (G0 * U0) * c2, p1 = (G1 * U1) * c2;
    const f32x4 d0 = e0 + 1.0f, d1 = e1 + 1.0f;
    f32x4 r0, r1;
#pragma unroll
    for (int j = 0; j < 4; ++j) { r0[j] = __builtin_amdgcn_rcpf(d0[j]); r1[j] = __builtin_amdgcn_rcpf(d1[j]); }
    v0 = p0 * r0; v1 = p1 * r1;
}
__device__ __forceinline__ void sigm8(f32x4& v0, f32x4& v1, float negl) {
    const f32x4 a0 = v0 * negl, a1 = v1 * negl;
    f32x4 e0, e1;
#pragma unroll
    for (int j = 0; j < 4; ++j) { e0[j] = __builtin_amdgcn_exp2f(a0[j]); e1[j] = __builtin_amdgcn_exp2f(a1[j]); }
    const f32x4 d0 = e0 + 1.0f, d1 = e1 + 1.0f;
#pragma unroll
    for (int j = 0; j < 4; ++j) { v0[j] = __builtin_amdgcn_rcpf(d0[j]); v1[j] = __builtin_amdgcn_rcpf(d1[j]); }
}
__device__ __forceinline__ float sigm(float v) { return __builtin_amdgcn_rcpf(1.0f + __builtin_amdgcn_exp2f(-1.44269504089f * v)); }

template <bool IN8>
struct EpiZ {
    static constexpr bool PERM = true, CHAIN = false;
    bf16_t* Z; bf16_t* Gt; const float* qg; const float* kg; LAS float* X;
    __device__ __forceinline__ void operator()(const f32x4 (&acc)[2][2][4][2], const Unit& u, int wr, int wc, int fr, int fq) const {
        asm volatile("" : "+v"(fr), "+v"(fq));
        const int row0 = u.pm * BM + wr * 64 + fr, col0 = u.pn * BM + wc * 32 + 8 * fq;
        const int mode = (u.pn >= 12) ? 2 : ((u.pn == 4 || u.pn == 5) ? 1 : ((u.pn >= 6 && u.pn <= 9) ? 3 : 0));
        const unsigned toff = (unsigned)(((wr * 4 + wc) * 64 + fq * 16 + fr) * 16);
        const int gti = u.pn - 12;
        char* gbase = (char*)Gt + (size_t)(((gti >> 2) * 128 + u.pm) * 4 + (gti & 3)) * 131072 + toff;
        float rs[2][4][2];
#pragma unroll
        for (int ai = 0; ai < 2; ++ai)
#pragma unroll
            for (int m = 0; m < 4; ++m) { rs[ai][m][0] = 1.f; rs[ai][m][1] = 1.f; }
        f32x4 g0 = {1.f, 1.f, 1.f, 1.f}, g1 = {1.f, 1.f, 1.f, 1.f};
        if (mode == 3) {
#pragma unroll
            for (int ai = 0; ai < 2; ++ai)
#pragma unroll
                for (int m = 0; m < 4; ++m)
#pragma unroll
                    for (int bj = 0; bj < 2; ++bj) { const f32x4 v0 = acc[ai][bj][m][0], v1 = acc[ai][bj][m][1];
                        float ss = (v0[0] * v0[0] + v0[1] * v0[1]) + (v0[2] * v0[2] + v0[3] * v0[3]) + (v1[0] * v1[0] + v1[1] * v1[1]) + (v1[2] * v1[2] + v1[3] * v1[3]);
                        ss = sum_xor32(sum_xor16(ss));
                        if (fq == 0) X[((ai * 128 + wr * 64 + m * 16 + fr) * 2 + bj) * 4 + wc] = ss;
                        rs[ai][m][bj] = ss; }
            asm volatile("s_waitcnt lgkmcnt(0)\n\ts_barrier" ::: "memory");
#pragma unroll
            for (int ai = 0; ai < 2; ++ai)
#pragma unroll
                for (int m = 0; m < 4; ++m)
#pragma unroll
                    for (int bj = 0; bj < 2; ++bj) rs[ai][m][bj] = rsqrtf((rs[ai][m][bj] + X[((ai * 128 + wr * 64 + m * 16 + fr) * 2 + bj) * 4 + (wc ^ 1)]) * (1.0f / 64.0f) + EPS);
            const float* gp = (u.pn < 8 ? qg : kg) + 32 * (wc & 1) + 8 * fq;
            const float qs_ = u.pn < 8 ? 0.125f * 1.4426950408889634f : 1.0f;
            g0 = *(const f32x4*)gp * qs_; g1 = *(const f32x4*)(gp + 4) * qs_;
            asm volatile("s_waitcnt lgkmcnt(0)\n\ts_barrier" ::: "memory");
        }
#pragma unroll
        for (int ai = 0; ai < 2; ++ai)
#pragma unroll
            for (int m = 0; m < 4; ++m) { bf16_t* rowp = Z + (size_t)(row0 + ai * HALF + m * 16) * ZP + col0;
#pragma unroll
                for (int bj = 0; bj < 2; ++bj) { f32x4 v0 = acc[ai][bj][m][0], v1 = acc[ai][bj][m][1];
                    if (mode == 1) { f32x2 a = gelu_pk((f32x2){v0[0], v0[1]}), b = gelu_pk((f32x2){v0[2], v0[3]}), c = gelu_pk((f32x2){v1[0], v1[1]}), d = gelu_pk((f32x2){v1[2], v1[3]});
                        v0 = (f32x4){a.x, a.y, b.x, b.y}; v1 = (f32x4){c.x, c.y, d.x, d.y}; }
                    else if (mode == 2) sigm8(v0, v1, IN8 ? -1.44269504089f / 1024.0f : -1.44269504089f);
                    else if (mode == 3) { const float r = rs[ai][m][bj]; v0 = v0 * g0 * r; v1 = v1 * g1 * r; }
                    u32x4 w; w.x = cvt_pk_bf16(v0[0], v0[1]); w.y = cvt_pk_bf16(v0[2], v0[3]); w.z = cvt_pk_bf16(v1[0], v1[1]); w.w = cvt_pk_bf16(v1[2], v1[3]);
                    if (mode == 2) *(u32x4*)(gbase + ((ai * 4 + m) * 2 + bj) * 8192) = w; else *(u32x4*)(rowp + bj * HALF) = w; } }
    }
};
__device__ __forceinline__ float sat8(float v) { return __builtin_amdgcn_fmed3f(v, -448.f, 448.f); }
__device__ __forceinline__ unsigned pk4_fp8(float a, float b, float c, float d) { unsigned w = 0; w = __builtin_amdgcn_cvt_pk_fp8_f32(a, b, w, false); w = __builtin_amdgcn_cvt_pk_fp8_f32(c, d, w, true); return w; }
constexpr float F8S_HN = 16.f, F8S_WGU = 64.f, F8S_ACT = 4.f, F8S_WDN = 128.f;
template <bool IN8>
struct EpiSwi8 {
    static constexpr bool PERM = true, CHAIN = false;
    unsigned char* ACT; int ldc;
    __device__ __forceinline__ void operator()(const f32x4 (&acc)[2][2][4][2], const Unit& u, int wr, int wc, int fr, int fq) const {
        asm volatile("" : "+v"(fr), "+v"(fq));
        const int row0 = u.pm * BM + wr * 64 + fr, col0 = u.pn * HALF + wc * 32 + 8 * fq;
        constexpr float US = IN8 ? 1.0f / (F8S_HN * F8S_WGU) : 1.0f;
#pragma unroll
        for (int ai = 0; ai < 2; ++ai)
#pragma unroll
            for (int m = 0; m < 4; ++m) { unsigned char* rowp = ACT + (size_t)(row0 + ai * HALF + m * 16) * ldc + col0;
                f32x4 v0, v1;
                swiglu8(acc[ai][0][m][0], acc[ai][0][m][1], acc[ai][1][m][0], acc[ai][1][m][1], -1.44269504089f * US, US * US * F8S_ACT, v0, v1);
                u32x2 w; w.x = pk4_fp8(sat8(v0[0]), sat8(v0[1]), sat8(v0[2]), sat8(v0[3])); w.y = pk4_fp8(sat8(v1[0]), sat8(v1[1]), sat8(v1[2]), sat8(v1[3]));
                *(u32x2*)rowp = w; }
    }
};
struct EpiSwi {
    static constexpr bool PERM = true, CHAIN = false;
    bf16_t* ACT; int ldc;
    __device__ __forceinline__ void operator()(const f32x4 (&acc)[2][2][4][2], const Unit& u, int wr, int wc, int fr, int fq) const {
        asm volatile("" : "+v"(fr), "+v"(fq));
        const int row0 = u.pm * BM + wr * 64 + fr, col0 = u.pn * HALF + wc * 32 + 8 * fq;
#pragma unroll
        for (int ai = 0; ai < 2; ++ai)
#pragma unroll
            for (int m = 0; m < 4; ++m) { bf16_t* rowp = ACT + (size_t)(row0 + ai * HALF + m * 16) * ldc + col0;
                f32x4 v0, v1;
                swiglu8(acc[ai][0][m][0], acc[ai][0][m][1], acc[ai][1][m][0], acc[ai][1][m][1], -1.44269504089f, 1.0f, v0, v1);
                u32x4 w; w.x = cvt_pk_bf16(v0[0], v0[1]); w.y = cvt_pk_bf16(v0[2], v0[3]); w.z = cvt_pk_bf16(v1[0], v1[1]); w.w = cvt_pk_bf16(v1[2], v1[3]);
                *(u32x4*)rowp = w; }
    }
};
template <bool INBF, bool OUTBF, bool F8ACC = false>
struct EpiResid {
    static constexpr bool PERM = false, CHAIN = false;
    const void* hin; void* out;
    __device__ __forceinline__ void operator()(const f32x4 (&acc)[2][2][4][2], const Unit& u, int wr, int wc, int fr, int fq) const {
        asm volatile("" : "+v"(fr), "+v"(fq));
        const int row0 = u.pm * BM + wr * 64 + fr, col0 = u.pn * BM + wc * 32 + 4 * fq;
#pragma unroll
        for (int ai = 0; ai < 2; ++ai) {
            f32x4 hv[4][2][2];
#pragma unroll
            for (int m = 0; m < 4; ++m) { const size_t ro = (size_t)(row0 + ai * HALF + m * 16) * D + col0;
#pragma unroll
                for (int bj = 0; bj < 2; ++bj)
#pragma unroll
                    for (int n = 0; n < 2; ++n) {
                        if constexpr (INBF) { const u32x2 h2 = *(const u32x2*)((const bf16_t*)hin + ro + bj * HALF + n * 16);
                            hv[m][bj][n] = (f32x4){__uint_as_float(h2.x << 16), __uint_as_float(h2.x & 0xffff0000u), __uint_as_float(h2.y << 16), __uint_as_float(h2.y & 0xffff0000u)}; }
                        else hv[m][bj][n] = *(const f32x4*)((const float*)hin + ro + bj * HALF + n * 16); } }
            asm volatile("" ::: "memory");
#pragma unroll
            for (int m = 0; m < 4; ++m) { const size_t ro = (size_t)(row0 + ai * HALF + m * 16) * D + col0;
#pragma unroll
                for (int bj = 0; bj < 2; ++bj)
#pragma unroll
                    for (int n = 0; n < 2; ++n) { const f32x4 v = F8ACC ? hv[m][bj][n] + acc[ai][bj][m][n] * (1.0f / (F8S_ACT * F8S_WDN)) : hv[m][bj][n] + acc[ai][bj][m][n];
                        if constexpr (OUTBF) { u32x2 hb; hb.x = cvt_pk_bf16(v[0], v[1]); hb.y = cvt_pk_bf16(v[2], v[3]); *(u32x2*)((bf16_t*)out + ro + bj * HALF + n * 16) = hb; }
                        else *(f32x4*)((float*)out + ro + bj * HALF + n * 16) = v; } }
            asm volatile("" ::: "memory");
        }
    }
};
template <bool FIRST>
struct EpiMoeDown {
    static constexpr bool PERM = false, CHAIN = false;
    const int* slot_tok; const float* slot_w; float* out; bf16_t* hs;
    __device__ __forceinline__ void operator()(const f32x4 (&acc)[2][2][4][2], const Unit& u, int wr, int wc, int fr, int fq) const {
        asm volatile("" : "+v"(fr), "+v"(fq));
        const int row0 = u.pm * BM + wr * 64 + fr, col0 = u.pn * BM + wc * 32 + 4 * fq;
#pragma unroll
        for (int ai = 0; ai < 2; ++ai) {
            int tk[4]; float ww[4];
#pragma unroll
            for (int m = 0; m < 4; ++m) { const int slot = row0 + ai * HALF + m * 16; tk[m] = slot_tok[slot]; ww[m] = slot_w[slot]; }
            f32x4 hv[4][2][2];
#pragma unroll
            for (int m = 0; m < 4; ++m) { const size_t ro = (size_t)(tk[m] < 0 ? 0 : tk[m]) * D + col0;
#pragma unroll
                for (int bj = 0; bj < 2; ++bj)
#pragma unroll
                    for (int n = 0; n < 2; ++n) {
                        { const u32x2 h2 = *(const u32x2*)(hs + ro + bj * HALF + n * 16);
                            hv[m][bj][n] = (f32x4){__uint_as_float(h2.x << 16), __uint_as_float(h2.x & 0xffff0000u), __uint_as_float(h2.y << 16), __uint_as_float(h2.y & 0xffff0000u)}; } } }
            asm volatile("" ::: "memory");
#pragma unroll
            for (int m = 0; m < 4; ++m) { if (tk[m] >= 0) { const size_t ro = (size_t)tk[m] * D + col0; const float w = ww[m];
#pragma unroll
                for (int bj = 0; bj < 2; ++bj)
#pragma unroll
                    for (int n = 0; n < 2; ++n) { const f32x4 v = hv[m][bj][n] + acc[ai][bj][m][n] * w;
                        if constexpr (FIRST) { u32x2 hb; hb.x = cvt_pk_bf16(v[0], v[1]); hb.y = cvt_pk_bf16(v[2], v[3]); *(u32x2*)(hs + ro + bj * HALF + n * 16) = hb; }
                        else *(f32x4*)(out + ro + bj * HALF + n * 16) = v; } } }
            asm volatile("" ::: "memory");
        }
    }
};
struct EpiMoeDownAtomic {
    static constexpr bool PERM = false, CHAIN = false;
    const int* slot_tok; const float* slot_w; float* out;
    __device__ __forceinline__ void operator()(const f32x4 (&acc)[2][2][4][2], const Unit& u, int wr, int wc, int fr, int fq) const {
        asm volatile("" : "+v"(fr), "+v"(fq));
        const int row0 = u.pm * BM + wr * 64 + fr, col0 = u.pn * BM + wc * 32 + 4 * fq;
#pragma unroll
        for (int ai = 0; ai < 2; ++ai)
#pragma unroll
            for (int m = 0; m < 4; ++m) { const int slot = row0 + ai * HALF + m * 16; const int tok = slot_tok[slot]; const float w = slot_w[slot];
                if (tok >= 0) { float* ro = out + (size_t)tok * D + col0;
#pragma unroll
                    for (int bj = 0; bj < 2; ++bj)
#pragma unroll
                        for (int n = 0; n < 2; ++n)
#pragma unroll
                            for (int e = 0; e < 4; ++e) __hip_atomic_fetch_add(ro + bj * HALF + n * 16 + e, acc[ai][bj][m][n][e] * w, __ATOMIC_RELAXED, __HIP_MEMORY_SCOPE_AGENT); } }
    }
};
struct EpiMerge {
    static constexpr bool PERM = true, CHAIN = true;
    const bf16_t* Gt; bf16_t* MG;
    __device__ __forceinline__ bool resets(const Unit& u) const { return (u.kb >> 9) == 3; }
    __device__ __forceinline__ void operator()(f32x4 (&acc)[2][2][4][2], const Unit& u, int wr, int wc, int fr, int fq) const {
        asm volatile("" : "+v"(fr), "+v"(fq));
        const unsigned toff = (unsigned)(((wr * 4 + wc) * 64 + fq * 16 + fr) * 16);
        const int br = u.kb >> 9;
        const unsigned moff = (unsigned)((wr * 64 + fr) * D + wc * 32 + 8 * fq) * 2u;
        const char* gt = (const char*)Gt + (size_t)((br * 128 + u.pm) * 4 + u.pn) * 131072 + toff;
        const size_t nxo = br != 3 ? (size_t)128 * 4 * 131072 : 0;
        char* mt = (char*)MG + ((size_t)u.pm * BM * D + u.pn * BM) * 2;
#pragma unroll
        for (int ai = 0; ai < 2; ++ai) {
            u32x4 gv[4][2], nv[4][2];
#pragma unroll
            for (int m = 0; m < 4; ++m)
#pragma unroll
                for (int bj = 0; bj < 2; ++bj) { const size_t o = (size_t)(((ai * 4 + m) * 2 + bj) * 8192);
                    gv[m][bj] = *(const u32x4*)(gt + o); nv[m][bj] = *(const u32x4*)(gt + o + nxo); }
#pragma unroll
            for (int m = 0; m < 4; ++m)
#pragma unroll
                for (int bj = 0; bj < 2; ++bj) {
                    const u32x4 g4 = gv[m][bj], n4 = nv[m][bj];
                    f32x4 ga = {__uint_as_float(g4.x << 16), __uint_as_float(g4.x & 0xffff0000u), __uint_as_float(g4.y << 16), __uint_as_float(g4.y & 0xffff0000u)};
                    f32x4 gb = {__uint_as_float(g4.z << 16), __uint_as_float(g4.z & 0xffff0000u), __uint_as_float(g4.w << 16), __uint_as_float(g4.w & 0xffff0000u)};
#pragma unroll
                    for (int e = 0; e < 4; ++e) { ga[e] = fmaxf(ga[e], 1e-20f); gb[e] = fmaxf(gb[e], 1e-20f); }
                    if (br != 3) {
                        const f32x4 na = {__uint_as_float(n4.x << 16), __uint_as_float(n4.x & 0xffff0000u), __uint_as_float(n4.y << 16), __uint_as_float(n4.y & 0xffff0000u)};
                        const f32x4 nb = {__uint_as_float(n4.z << 16), __uint_as_float(n4.z & 0xffff0000u), __uint_as_float(n4.w << 16), __uint_as_float(n4.w & 0xffff0000u)};
#pragma unroll
                        for (int e = 0; e < 4; ++e) { ga[e] *= __builtin_amdgcn_rcpf(fmaxf(na[e], 1e-20f)); gb[e] *= __builtin_amdgcn_rcpf(fmaxf(nb[e], 1e-20f)); }
                        acc[ai][bj][m][0] *= ga; acc[ai][bj][m][1] *= gb;
                    } else {
                        const f32x4 v0 = acc[ai][bj][m][0] * ga, v1 = acc[ai][bj][m][1] * gb;
                        u32x4 w; w.x = cvt_pk_bf16(v0[0], v0[1]); w.y = cvt_pk_bf16(v0[2], v0[3]); w.z = cvt_pk_bf16(v1[0], v1[1]); w.w = cvt_pk_bf16(v1[2], v1[3]);
                        *(u32x4*)(mt + (size_t)((ai * HALF + m * 16) * D + bj * HALF) * 2 + moff) = w; } }
            asm volatile("" ::: "memory");
        }
    }
};

template <class Sched> __device__ __forceinline__ unsigned a_off(const Sched& S, const Unit& u, int lda, int tid, int h, int i) {
    int R, C; stage_rc(tid * 16 + i * 8192, R, C);
    if constexpr (Sched::GATHER) return (unsigned)(S.arow(u, h * HALF + R) * lda + C) * 2u; else return (unsigned)((h * HALF + R) * lda + C) * 2u;
}
template <class Epi, class Sched, bool ALIGN_EPI, bool F8 = false>
__device__ __forceinline__ void gemm_phase(LAS unsigned char* lds, const Gemm g, const Sched& S, const Epi& E, int wave_) {
    int tid = wave_ * 64 + lane_id(); asm volatile("" : "+v"(tid));
    const int wid = __builtin_amdgcn_readfirstlane(tid >> 6), lane = tid & 63, wr = wid >> 2, wc = wid & 3, fr = lane & 15, fq = lane >> 4;
    unsigned voffB[2];
#pragma unroll
    for (int i = 0; i < 2; ++i) { int R, C; stage_rc(tid * 16 + i * 8192, R, C); const int Rb = Epi::PERM ? ((R & ~31) + perm32(R & 31)) : R; voffB[i] = (unsigned)(Rb * g.ldb + C) * 2u; }
    const size_t kstep = (size_t)(BK * 2);
    const size_t hstepB = (size_t)HALF * g.ldb * 2, tstepB = 2 * hstepB;
    const size_t tstepA = (size_t)BM * g.lda * 2;
    const unsigned ldsw = (unsigned)wid * 1024u;
    const int aoff = lds_byte(wr * 64 + fr, fq * 8), boff = lds_byte(wc * 32 + fr, fq * 8);
#define PG8_SA(b, h) (((b) * 2 + (h)) * HTB)
#define PG8_SB(b, h) ((4 + (b) * 2 + (h)) * HTB)
#define PG8_STAGE2(bufoff, gbase, v0_, v1_) do { \
        __builtin_amdgcn_global_load_lds((const unsigned*)((const char*)(gbase) + (v0_)), (LAS unsigned*)(lds + (bufoff) + ldsw), 16, 0, 0); \
        __builtin_amdgcn_global_load_lds((const unsigned*)((const char*)(gbase) + (v1_)), (LAS unsigned*)(lds + (bufoff) + ldsw + 8192), 16, 0, 0); } while (0)
#define PG8_STAGEB(bufoff, gbase) PG8_STAGE2(bufoff, gbase, voffB[0], voffB[1])
#define PG8_AOFF(u_, h_, i_) a_off<Sched>(S, u_, g.lda, tid, h_, i_)
#define PG8_ABASE(u_) (Sched::GATHER ? g.A + (u_).kb : g.A + (size_t)(u_).pm * tstepA + (u_).kb)
#define PG8_LDA(dst, b, h) do { _Pragma("unroll") for (int m = 0; m < 4; ++m) { \
        if constexpr (F8) { const i32x4 lo_ = *(const LAS i32x4*)(lds + PG8_SA(b, h) + aoff + m * 2048), hi_ = *(const LAS i32x4*)(lds + PG8_SA(b, h) + aoff + m * 2048 + 1024); dst##8[m] = __builtin_shufflevector(lo_, hi_, 0, 1, 2, 3, 4, 5, 6, 7); } \
        else { _Pragma("unroll") for (int k = 0; k < 2; ++k) dst[m][k] = *(const LAS bf16x8*)(lds + PG8_SA(b, h) + aoff + m * 2048 + k * 1024); } } } while (0)
#define PG8_LDB(dst, b, h) do { _Pragma("unroll") for (int n = 0; n < 2; ++n) { \
        if constexpr (F8) { const i32x4 lo_ = *(const LAS i32x4*)(lds + PG8_SB(b, h) + boff + n * 2048), hi_ = *(const LAS i32x4*)(lds + PG8_SB(b, h) + boff + n * 2048 + 1024); dst##8[n] = __builtin_shufflevector(lo_, hi_, 0, 1, 2, 3, 4, 5, 6, 7); } \
        else { _Pragma("unroll") for (int k = 0; k < 2; ++k) dst[n][k] = *(const LAS bf16x8*)(lds + PG8_SB(b, h) + boff + n * 2048 + k * 1024); } } } while (0)
#define PG8_MMA(ai, bj, At, Bt) do { __builtin_amdgcn_s_setprio(1); _Pragma("unroll") for (int m = 0; m < 4; ++m) _Pragma("unroll") for (int n = 0; n < 2; ++n) { \
        if constexpr (F8) asm volatile("v_mfma_f32_16x16x128_f8f6f4 %0, %1, %2, %0" : "+v"(acc[ai][bj][m][n]) : "v"(Bt##8[n]), "v"(At##8[m])); \
        else { _Pragma("unroll") for (int k = 0; k < 2; ++k) acc[ai][bj][m][n] = __builtin_amdgcn_mfma_f32_16x16x32_bf16(Bt[n][k], At[m][k], acc[ai][bj][m][n], 0, 0, 0); } } \
        __builtin_amdgcn_s_setprio(0); } while (0)
#define PG8_WAIT_V(n) asm volatile("s_waitcnt vmcnt(" #n ")" ::: "memory")
#define PG8_WAIT_L(n) asm volatile("s_waitcnt lgkmcnt(" #n ")" ::: "memory")
#define PG8_BAR __builtin_amdgcn_s_barrier()
#define PG8_SCHED __builtin_amdgcn_sched_barrier(0)
    Unit cur, nxt; int ui = 0;
    if (!S.next(0, cur)) return;
    f32x4 acc[2][2][4][2];
#pragma unroll
    for (int a = 0; a < 2; ++a)
#pragma unroll
        for (int b = 0; b < 2; ++b)
#pragma unroll
            for (int m = 0; m < 4; ++m)
#pragma unroll
                for (int n = 0; n < 2; ++n) acc[a][b][m][n] = (f32x4){0.f, 0.f, 0.f, 0.f};
    bf16x8 At[4][2], B0[2][2], B1[2][2];
    i32x8 At8[4], B08[2], B18[2];
    unsigned ca00 = PG8_AOFF(cur, 0, 0), ca01 = PG8_AOFF(cur, 0, 1), ca10 = PG8_AOFF(cur, 1, 0), ca11 = PG8_AOFF(cur, 1, 1);
    const char* cA = PG8_ABASE(cur);
    const char* cB = cur.B + (size_t)cur.pn * tstepB + cur.kb;
    {
        PG8_STAGEB(PG8_SB(0, 0), cB); PG8_STAGEB(PG8_SB(0, 1), cB + hstepB); PG8_STAGE2(PG8_SA(0, 0), cA, ca00, ca01); PG8_STAGE2(PG8_SA(0, 1), cA, ca10, ca11);
        if (wr == 1) PG8_BAR;
        PG8_WAIT_V(2); PG8_BAR;
        PG8_STAGEB(PG8_SB(1, 0), cB + kstep); PG8_STAGE2(PG8_SA(1, 0), cA + kstep, ca00, ca01); PG8_STAGEB(PG8_SB(1, 1), cB + hstepB + kstep);
        PG8_WAIT_V(6); PG8_BAR;
    }
    for (;;) {
        const bool has_next = S.next(ui + 1, nxt);
        const char* nA = cA; const char* nB = cB;
        if (has_next) { nA = PG8_ABASE(nxt); nB = nxt.B + (size_t)nxt.pn * tstepB + nxt.kb; }
        const int nt = cur.nt;
        for (int t = 0; t < nt; t += 2) {
            const bool last = (t == nt - 2);
            const char* a1 = cA + (size_t)(t + 1) * kstep;
            const char* a2 = last ? nA : cA + (size_t)(t + 2) * kstep; const char* b2 = last ? nB : cB + (size_t)(t + 2) * kstep;
            const char* a3 = a2 + kstep; const char* b3 = b2 + kstep;
            unsigned o00 = ca00, o01 = ca01, o10 = ca10, o11 = ca11;
            if constexpr (Sched::GATHER) { if (last && has_next) { o00 = PG8_AOFF(nxt, 0, 0); o01 = PG8_AOFF(nxt, 0, 1); o10 = PG8_AOFF(nxt, 1, 0); o11 = PG8_AOFF(nxt, 1, 1); } }
            PG8_LDB(B0, 0, 0); PG8_LDB(B1, 0, 1); PG8_SCHED; PG8_LDA(At, 0, 0); PG8_STAGE2(PG8_SA(1, 1), a1, ca10, ca11);
            PG8_WAIT_V(8); PG8_WAIT_L(0); PG8_BAR; PG8_MMA(0, 0, At, B0); PG8_MMA(0, 1, At, B1); PG8_BAR; PG8_SCHED;
            PG8_LDA(At, 0, 1); PG8_STAGEB(PG8_SB(0, 0), b2); PG8_STAGEB(PG8_SB(0, 1), b2 + hstepB); PG8_STAGE2(PG8_SA(0, 0), a2, o00, o01);
            PG8_WAIT_V(8); PG8_WAIT_L(0); PG8_BAR; PG8_MMA(1, 0, At, B0); PG8_MMA(1, 1, At, B1); PG8_BAR; PG8_SCHED;
            PG8_LDB(B0, 1, 0); PG8_LDB(B1, 1, 1); PG8_SCHED; PG8_LDA(At, 1, 0); PG8_STAGE2(PG8_SA(0, 1), a2, o10, o11);
            PG8_WAIT_V(8); PG8_WAIT_L(0); PG8_BAR; PG8_MMA(0, 0, At, B0); PG8_MMA(0, 1, At, B1); PG8_BAR; PG8_SCHED;
            PG8_LDA(At, 1, 1); PG8_STAGEB(PG8_SB(1, 0), b3); PG8_STAGEB(PG8_SB(1, 1), b3 + hstepB); PG8_STAGE2(PG8_SA(1, 0), a3, o00, o01);
            PG8_WAIT_V(8); PG8_WAIT_L(0); PG8_BAR; PG8_MMA(1, 0, At, B0); PG8_MMA(1, 1, At, B1); PG8_BAR; PG8_SCHED;
            if constexpr (Sched::GATHER) { if (last) { ca00 = o00; ca01 = o01; ca10 = o10; ca11 = o11; } }
        }
        if constexpr (ALIGN_EPI) { if (wr == 0) PG8_BAR; }
        if constexpr (F8) asm volatile("s_nop 15\n\ts_nop 15" ::: "memory");
        E(acc, cur, wr, wc, fr, fq);
        if (!has_next) break;
        bool zero_acc = true;
        if constexpr (Epi::CHAIN) zero_acc = E.resets(cur);
        if (zero_acc)
#pragma unroll
        for (int a = 0; a < 2; ++a)
#pragma unroll
            for (int b = 0; b < 2; ++b)
#pragma unroll
                for (int m = 0; m < 4; ++m)
#pragma unroll
                    for (int n = 0; n < 2; ++n) acc[a][b][m][n] = (f32x4){0.f, 0.f, 0.f, 0.f};
        cur = nxt; cA = nA; cB = nB; ++ui;
        if constexpr (ALIGN_EPI) { if (wr == 1) PG8_BAR; }
    }
    PG8_WAIT_V(0);
    if constexpr (!ALIGN_EPI) { if (wr == 0) PG8_BAR; }
    PG8_BAR;
#undef PG8_SA
#undef PG8_SB
#undef PG8_STAGE2
#undef PG8_STAGEB
#undef PG8_AOFF
#undef PG8_ABASE
#undef PG8_LDA
#undef PG8_LDB
#undef PG8_MMA
#undef PG8_WAIT_V
#undef PG8_WAIT_L
#undef PG8_BAR
#undef PG8_SCHED
}
}

__device__ __forceinline__ unsigned pk2(float lo, float hi) { return (unsigned)f2bf(lo) | ((unsigned)f2bf(hi) << 16); }

__device__ __forceinline__ void p0_transpose_item(const float* W, int K, int N, bf16_t* WT, int ldk, int koff, int mode, LAS float* scr, int item, int lane) {
    const int nblk = N / 32, kb = item / nblk, nb = item % nblk, k0 = 64 * kb, n0 = 32 * nb;
    float tv[32];
#pragma unroll
    for (int i = 0; i < 32; ++i) { const int kk = 2 * i + (lane >> 5); tv[i] = W[(size_t)(k0 + kk) * N + n0 + (lane & 31)]; }
#pragma unroll
    for (int i = 0; i < 32; ++i) { const int kk = 2 * i + (lane >> 5); scr[kk * 33 + (lane & 31)] = tv[i]; }
    asm volatile("s_waitcnt lgkmcnt(0)" ::: "memory");
    int r0 = n0;
    if (mode == 1) { const int dff = N >> 1, hf = n0 >= dff ? 1 : 0, c = n0 - hf * dff; r0 = (c >> 7) * 256 + hf * 128 + (c & 127); }
    const int c8 = lane & 7;
#pragma unroll
    for (int j = 0; j < 4; ++j) { const int n = (lane >> 3) + 8 * j; const LAS float* s = scr + (8 * c8) * 33 + n;
        u32x4 o; o.x = pk2(s[0 * 33], s[1 * 33]); o.y = pk2(s[2 * 33], s[3 * 33]); o.z = pk2(s[4 * 33], s[5 * 33]); o.w = pk2(s[6 * 33], s[7 * 33]);
        *(u32x4*)(WT + (size_t)(r0 + n) * ldk + koff + k0 + 8 * c8) = o; }
    asm volatile("s_waitcnt lgkmcnt(0)" ::: "memory");
}

__device__ __forceinline__ void p0_transpose_item_f8(const float* W, int K, int N, unsigned char* WT8, int ldk, int mode, float sc, LAS float* scr, int item, int lane) {
    const int nblk = N / 32, kb = item / nblk, nb = item % nblk, k0 = 64 * kb, n0 = 32 * nb;
    float tv[32];
#pragma unroll
    for (int i = 0; i < 32; ++i) { const int kk = 2 * i + (lane >> 5); tv[i] = W[(size_t)(k0 + kk) * N + n0 + (lane & 31)]; }
#pragma unroll
    for (int i = 0; i < 32; ++i) { const int kk = 2 * i + (lane >> 5); scr[kk * 33 + (lane & 31)] = tv[i] * sc; }
    asm volatile("s_waitcnt lgkmcnt(0)" ::: "memory");
    int r0 = n0;
    if (mode == 1) { const int dff = N >> 1, hf = n0 >= dff ? 1 : 0, c = n0 - hf * dff; r0 = (c >> 7) * 256 + hf * 128 + (c & 127); }
    const int c8 = lane & 7;
#pragma unroll
    for (int j = 0; j < 4; ++j) { const int n = (lane >> 3) + 8 * j; const LAS float* s = scr + (8 * c8) * 33 + n;
        u32x2 o; o.x = pg8::pk4_fp8(pg8::sat8(s[0 * 33]), pg8::sat8(s[1 * 33]), pg8::sat8(s[2 * 33]), pg8::sat8(s[3 * 33])); o.y = pg8::pk4_fp8(pg8::sat8(s[4 * 33]), pg8::sat8(s[5 * 33]), pg8::sat8(s[6 * 33]), pg8::sat8(s[7 * 33]));
        *(u32x2*)(WT8 + (size_t)(r0 + n) * ldk + k0 + 8 * c8) = o; }
    asm volatile("s_waitcnt lgkmcnt(0)" ::: "memory");
}

struct Args {
    const float* in[25]; float* out; unsigned char* ws;
    int ph_lo, ph_hi;
};

template <bool O8>
__device__ __forceinline__ void rms_row(const float* __restrict__ xrow, const float* __restrict__ g, bf16_t* __restrict__ orow, unsigned char* __restrict__ o8row, int lane) {
    const f32x4* p = (const f32x4*)xrow;
    f32x4 v[4]; float ss = 0.f;
#pragma unroll
    for (int j = 0; j < 4; ++j) { v[j] = p[lane + 64 * j]; ss += (v[j].x * v[j].x + v[j].y * v[j].y) + (v[j].z * v[j].z + v[j].w * v[j].w); }
    ss = wave_sum(ss);
    const float r = rsqrtf(ss * (1.0f / D) + EPS);
    u32x2* op = (u32x2*)orow;
#pragma unroll
    for (int j = 0; j < 4; ++j) { const f32x4 gg = ((const f32x4*)g)[lane + 64 * j]; const float y0 = v[j].x * r * gg.x, y1 = v[j].y * r * gg.y, y2 = v[j].z * r * gg.z, y3 = v[j].w * r * gg.w;
        u32x2 w; w.x = pk2(y0, y1); w.y = pk2(y2, y3); op[lane + 64 * j] = w;
        if constexpr (O8) ((unsigned*)o8row)[lane + 64 * j] = pg8::pk4_fp8(pg8::sat8(y0 * pg8::F8S_HN), pg8::sat8(y1 * pg8::F8S_HN), pg8::sat8(y2 * pg8::F8S_HN), pg8::sat8(y3 * pg8::F8S_HN)); }
}


template <bool O8>
__device__ __forceinline__ void rms_rows4(const float* __restrict__ x, int row, int st, const float* __restrict__ g, bf16_t* __restrict__ o, unsigned char* __restrict__ o8, int lane) {
    f32x4 v[4][4];
#pragma unroll
    for (int i = 0; i < 4; ++i)
#pragma unroll
        for (int j = 0; j < 4; ++j) v[i][j] = ((const f32x4*)(x + (size_t)(row + i * st) * D))[lane + 64 * j];
    f32x4 gg[4];
#pragma unroll
    for (int j = 0; j < 4; ++j) gg[j] = ((const f32x4*)g)[lane + 64 * j];
    float ss[4];
#pragma unroll
    for (int i = 0; i < 4; ++i) { ss[i] = 0.f;
#pragma unroll
        for (int j = 0; j < 4; ++j) ss[i] += (v[i][j].x * v[i][j].x + v[i][j].y * v[i][j].y) + (v[i][j].z * v[i][j].z + v[i][j].w * v[i][j].w); }
#pragma unroll
    for (int i = 0; i < 4; ++i) ss[i] = wave_sum(ss[i]);
    float eps_ = EPS; asm volatile("" : "+v"(eps_));
#pragma unroll
    for (int i = 0; i < 4; ++i) { const float r = rsqrtf(ss[i] * (1.0f / D) + eps_); u32x2* op = (u32x2*)(o + (size_t)(row + i * st) * D);
#pragma unroll
        for (int j = 0; j < 4; ++j) { const float y0 = v[i][j].x * r * gg[j].x, y1 = v[i][j].y * r * gg[j].y, y2 = v[i][j].z * r * gg[j].z, y3 = v[i][j].w * r * gg[j].w;
            u32x2 w; w.x = pk2(y0, y1); w.y = pk2(y2, y3); op[lane + 64 * j] = w;
            if constexpr (O8) ((unsigned*)(o8 + (size_t)(row + i * st) * D))[lane + 64 * j] = pg8::pk4_fp8(pg8::sat8(y0 * pg8::F8S_HN), pg8::sat8(y1 * pg8::F8S_HN), pg8::sat8(y2 * pg8::F8S_HN), pg8::sat8(y3 * pg8::F8S_HN)); } }
}

__device__ __forceinline__ void bf8_to_f32(const u32x4 a, float (&v)[8]) {
    v[0] = __uint_as_float(a.x << 16); v[1] = __uint_as_float(a.x & 0xffff0000u); v[2] = __uint_as_float(a.y << 16); v[3] = __uint_as_float(a.y & 0xffff0000u);
    v[4] = __uint_as_float(a.z << 16); v[5] = __uint_as_float(a.z & 0xffff0000u); v[6] = __uint_as_float(a.w << 16); v[7] = __uint_as_float(a.w & 0xffff0000u);
}
template <bool O8>
__device__ __forceinline__ void rms_row_bf(const bf16_t* __restrict__ xrow, const float* __restrict__ g, bf16_t* __restrict__ orow, unsigned char* __restrict__ o8row, int lane) {
    float v[2][8]; float ss = 0.f;
#pragma unroll
    for (int j = 0; j < 2; ++j) { bf8_to_f32(((const u32x4*)xrow)[lane + 64 * j], v[j]);
#pragma unroll
        for (int e = 0; e < 8; ++e) ss += v[j][e] * v[j][e]; }
    ss = wave_sum(ss);
    const float r = rsqrtf(ss * (1.0f / D) + EPS);
#pragma unroll
    for (int j = 0; j < 2; ++j) { const f32x4 ga = ((const f32x4*)g)[2 * (lane + 64 * j)], gb = ((const f32x4*)g)[2 * (lane + 64 * j) + 1];
        const float y0 = v[j][0] * r * ga.x, y1 = v[j][1] * r * ga.y, y2 = v[j][2] * r * ga.z, y3 = v[j][3] * r * ga.w, y4 = v[j][4] * r * gb.x, y5 = v[j][5] * r * gb.y, y6 = v[j][6] * r * gb.z, y7 = v[j][7] * r * gb.w;
        u32x4 w; w.x = pk2(y0, y1); w.y = pk2(y2, y3); w.z = pk2(y4, y5); w.w = pk2(y6, y7);
        ((u32x4*)orow)[lane + 64 * j] = w;
        if constexpr (O8) { u32x2 w8; w8.x = pg8::pk4_fp8(pg8::sat8(y0 * pg8::F8S_HN), pg8::sat8(y1 * pg8::F8S_HN), pg8::sat8(y2 * pg8::F8S_HN), pg8::sat8(y3 * pg8::F8S_HN)); w8.y = pg8::pk4_fp8(pg8::sat8(y4 * pg8::F8S_HN), pg8::sat8(y5 * pg8::F8S_HN), pg8::sat8(y6 * pg8::F8S_HN), pg8::sat8(y7 * pg8::F8S_HN)); ((u32x2*)o8row)[lane + 64 * j] = w8; } }
}
template <bool O8>
__device__ __forceinline__ void rms_rows4_bf(const bf16_t* __restrict__ x, int row, int st, const float* __restrict__ g, bf16_t* __restrict__ o, unsigned char* __restrict__ o8, int lane) {
    u32x4 raw[4][2];
#pragma unroll
    for (int i = 0; i < 4; ++i)
#pragma unroll
        for (int j = 0; j < 2; ++j) raw[i][j] = ((const u32x4*)(x + (size_t)(row + i * st) * D))[lane + 64 * j];
    f32x4 gg[2][2];
#pragma unroll
    for (int j = 0; j < 2; ++j) { gg[j][0] = ((const f32x4*)g)[2 * (lane + 64 * j)]; gg[j][1] = ((const f32x4*)g)[2 * (lane + 64 * j) + 1]; }
    float eps_ = EPS; asm volatile("" : "+v"(eps_));
#pragma unroll
    for (int i = 0; i < 4; ++i) { float v[2][8]; float ss = 0.f;
#pragma unroll
        for (int j = 0; j < 2; ++j) { bf8_to_f32(raw[i][j], v[j]);
#pragma unroll
            for (int e = 0; e < 8; ++e) ss += v[j][e] * v[j][e]; }
        ss = wave_sum(ss);
        const float r = rsqrtf(ss * (1.0f / D) + eps_);
#pragma unroll
        for (int j = 0; j < 2; ++j) { const f32x4 ga = gg[j][0], gb = gg[j][1];
            const float y0 = v[j][0] * r * ga.x, y1 = v[j][1] * r * ga.y, y2 = v[j][2] * r * ga.z, y3 = v[j][3] * r * ga.w, y4 = v[j][4] * r * gb.x, y5 = v[j][5] * r * gb.y, y6 = v[j][6] * r * gb.z, y7 = v[j][7] * r * gb.w;
            u32x4 w; w.x = pk2(y0, y1); w.y = pk2(y2, y3); w.z = pk2(y4, y5); w.w = pk2(y6, y7);
            ((u32x4*)(o + (size_t)(row + i * st) * D))[lane + 64 * j] = w;
            if constexpr (O8) { u32x2 w8; w8.x = pg8::pk4_fp8(pg8::sat8(y0 * pg8::F8S_HN), pg8::sat8(y1 * pg8::F8S_HN), pg8::sat8(y2 * pg8::F8S_HN), pg8::sat8(y3 * pg8::F8S_HN)); w8.y = pg8::pk4_fp8(pg8::sat8(y4 * pg8::F8S_HN), pg8::sat8(y5 * pg8::F8S_HN), pg8::sat8(y6 * pg8::F8S_HN), pg8::sat8(y7 * pg8::F8S_HN)); ((u32x2*)(o8 + (size_t)(row + i * st) * D))[lane + 64 * j] = w8; } } }
}

__device__ __forceinline__ void qknorm_row(bf16_t* __restrict__ Z, int t, const float* __restrict__ qg, const float* __restrict__ kg, int lane) {
    bf16_t* p = Z + (size_t)t * ZP + OFF_ATTN + lane * 16;
    const u32x4 a = *(const u32x4*)p, b = *(const u32x4*)(p + 8);
    float v[16];
    v[0] = __uint_as_float(a.x << 16); v[1] = __uint_as_float(a.x & 0xffff0000u); v[2] = __uint_as_float(a.y << 16); v[3] = __uint_as_float(a.y & 0xffff0000u);
    v[4] = __uint_as_float(a.z << 16); v[5] = __uint_as_float(a.z & 0xffff0000u); v[6] = __uint_as_float(a.w << 16); v[7] = __uint_as_float(a.w & 0xffff0000u);
    v[8] = __uint_as_float(b.x << 16); v[9] = __uint_as_float(b.x & 0xffff0000u); v[10] = __uint_as_float(b.y << 16); v[11] = __uint_as_float(b.y & 0xffff0000u);
    v[12] = __uint_as_float(b.z << 16); v[13] = __uint_as_float(b.z & 0xffff0000u); v[14] = __uint_as_float(b.w << 16); v[15] = __uint_as_float(b.w & 0xffff0000u);
    float ss = 0.f;
#pragma unroll
    for (int i = 0; i < 16; ++i) ss += v[i] * v[i];
    ss = quad_sum(ss);
    const float r = rsqrtf(ss * (1.0f / 64.0f) + EPS);
    const float* g = (lane < 32 ? qg : kg) + (lane & 3) * 16;
    unsigned o[8];
#pragma unroll
    for (int i = 0; i < 8; ++i) o[i] = pk2(v[2 * i] * r * g[2 * i], v[2 * i + 1] * r * g[2 * i + 1]);
    *(u32x4*)p = (u32x4){o[0], o[1], o[2], o[3]}; *(u32x4*)(p + 8) = (u32x4){o[4], o[5], o[6], o[7]};
}

__device__ __forceinline__ void conv_row(const bf16_t* __restrict__ Z, int t, const float* __restrict__ cw, bf16_t* __restrict__ Y, int lane) {
    const int s = t & (SEQ - 1), c = lane * 4;
    float y0 = 0.f, y1 = 0.f, y2 = 0.f, y3 = 0.f;
#pragma unroll
    for (int j = 0; j < 3; ++j) {
        if (s - 2 + j >= 0) { const bf16_t* zr = Z + (size_t)(t - 2 + j) * ZP + OFF_CONV;
            const u32x2 cg = *(const u32x2*)(zr + 256 + c), hh = *(const u32x2*)(zr + 512 + c); const f32x4 w = *(const f32x4*)(cw + j * 256 + c);
            y0 += w.x * __uint_as_float(cg.x << 16) * __uint_as_float(hh.x << 16); y1 += w.y * __uint_as_float(cg.x & 0xffff0000u) * __uint_as_float(hh.x & 0xffff0000u);
            y2 += w.z * __uint_as_float(cg.y << 16) * __uint_as_float(hh.y << 16); y3 += w.w * __uint_as_float(cg.y & 0xffff0000u) * __uint_as_float(hh.y & 0xffff0000u); }
    }
    const u32x2 bg = *(const u32x2*)(Z + (size_t)t * ZP + OFF_CONV + c);
    u32x2 o; o.x = pk2(__uint_as_float(bg.x << 16) * y0, __uint_as_float(bg.x & 0xffff0000u) * y1); o.y = pk2(__uint_as_float(bg.y << 16) * y2, __uint_as_float(bg.y & 0xffff0000u) * y3);
    *(u32x2*)(Y + (size_t)t * YW + 256 + c) = o;
}


__device__ __forceinline__ void qknorm_rows4(bf16_t* __restrict__ Z, int t, int st, const float* __restrict__ qg, const float* __restrict__ kg, int lane) {
    u32x4 a[4], b[4];
#pragma unroll
    for (int i = 0; i < 4; ++i) { const bf16_t* p = Z + (size_t)(t + i * st) * ZP + OFF_ATTN + lane * 16; a[i] = *(const u32x4*)p; b[i] = *(const u32x4*)(p + 8); }
    const float* g = (lane < 32 ? qg : kg) + (lane & 3) * 16;
    const f32x4 g0 = *(const f32x4*)g, g1 = *(const f32x4*)(g + 4), g2 = *(const f32x4*)(g + 8), g3 = *(const f32x4*)(g + 12);
#pragma unroll
    for (int i = 0; i < 4; ++i) {
        float v[16];
        v[0] = __uint_as_float(a[i].x << 16); v[1] = __uint_as_float(a[i].x & 0xffff0000u); v[2] = __uint_as_float(a[i].y << 16); v[3] = __uint_as_float(a[i].y & 0xffff0000u);
        v[4] = __uint_as_float(a[i].z << 16); v[5] = __uint_as_float(a[i].z & 0xffff0000u); v[6] = __uint_as_float(a[i].w << 16); v[7] = __uint_as_float(a[i].w & 0xffff0000u);
        v[8] = __uint_as_float(b[i].x << 16); v[9] = __uint_as_float(b[i].x & 0xffff0000u); v[10] = __uint_as_float(b[i].y << 16); v[11] = __uint_as_float(b[i].y & 0xffff0000u);
        v[12] = __uint_as_float(b[i].z << 16); v[13] = __uint_as_float(b[i].z & 0xffff0000u); v[14] = __uint_as_float(b[i].w << 16); v[15] = __uint_as_float(b[i].w & 0xffff0000u);
        float ss = 0.f;
#pragma unroll
        for (int e = 0; e < 16; ++e) ss += v[e] * v[e];
        ss = quad_sum(ss);
        const float r = rsqrtf(ss * (1.0f / 64.0f) + EPS);
        u32x4 o0, o1;
        o0.x = pk2(v[0] * r * g0.x, v[1] * r * g0.y); o0.y = pk2(v[2] * r * g0.z, v[3] * r * g0.w); o0.z = pk2(v[4] * r * g1.x, v[5] * r * g1.y); o0.w = pk2(v[6] * r * g1.z, v[7] * r * g1.w);
        o1.x = pk2(v[8] * r * g2.x, v[9] * r * g2.y); o1.y = pk2(v[10] * r * g2.z, v[11] * r * g2.w); o1.z = pk2(v[12] * r * g3.x, v[13] * r * g3.y); o1.w = pk2(v[14] * r * g3.z, v[15] * r * g3.w);
        bf16_t* p = Z + (size_t)(t + i * st) * ZP + OFF_ATTN + lane * 16;
        *(u32x4*)p = o0; *(u32x4*)(p + 8) = o1;
    }
}
__device__ __forceinline__ void conv_rows4(const bf16_t* __restrict__ Z, int t, int st, const float* __restrict__ cw, bf16_t* __restrict__ Y, int lane) {
    const int c = lane * 4;
    u32x2 cg[4][3], hh[4][3], bg[4];
#pragma unroll
    for (int i = 0; i < 4; ++i) { const int tt = t + i * st, s = tt & (SEQ - 1);
#pragma unroll
        for (int j = 0; j < 3; ++j) { const int back = (s - 2 + j >= 0) ? (2 - j) : 0;
            const bf16_t* zr = Z + (size_t)(tt - back) * ZP + OFF_CONV; cg[i][j] = *(const u32x2*)(zr + 256 + c); hh[i][j] = *(const u32x2*)(zr + 512 + c); }
        bg[i] = *(const u32x2*)(Z + (size_t)tt * ZP + OFF_CONV + c); }
    f32x4 w[3];
#pragma unroll
    for (int j = 0; j < 3; ++j) w[j] = *(const f32x4*)(cw + j * 256 + c);
#pragma unroll
    for (int i = 0; i < 4; ++i) { const int tt = t + i * st, s = tt & (SEQ - 1);
        float y0 = 0.f, y1 = 0.f, y2 = 0.f, y3 = 0.f;
#pragma unroll
        for (int j = 0; j < 3; ++j) { const float mk = (s - 2 + j >= 0) ? 1.0f : 0.0f;
            y0 += mk * w[j].x * __uint_as_float(cg[i][j].x << 16) * __uint_as_float(hh[i][j].x << 16); y1 += mk * w[j].y * __uint_as_float(cg[i][j].x & 0xffff0000u) * __uint_as_float(hh[i][j].x & 0xffff0000u);
            y2 += mk * w[j].z * __uint_as_float(cg[i][j].y << 16) * __uint_as_float(hh[i][j].y << 16); y3 += mk * w[j].w * __uint_as_float(cg[i][j].y & 0xffff0000u) * __uint_as_float(hh[i][j].y & 0xffff0000u); }
        u32x2 o; o.x = pk2(__uint_as_float(bg[i].x << 16) * y0, __uint_as_float(bg[i].x & 0xffff0000u) * y1); o.y = pk2(__uint_as_float(bg[i].y << 16) * y2, __uint_as_float(bg[i].y & 0xffff0000u) * y3);
        *(u32x2*)(Y + (size_t)tt * YW + 256 + c) = o; }
}

__device__ __forceinline__ unsigned offb_(unsigned row, unsigned ch) { return 256u * row + 16u * (ch ^ (((row & 3u) << 2) | ((row >> 2) & 3u))); }
typedef float f32x16_t __attribute__((ext_vector_type(16)));
typedef short s16x4_t __attribute__((ext_vector_type(4)));
__device__ __forceinline__ s16x4_t vtr_(const LAS unsigned char* p) { return __builtin_bit_cast(s16x4_t, __builtin_amdgcn_ds_read_tr16_b64_v4i16((LAS s16x4_t*)p)); }
__device__ __forceinline__ unsigned cvtpk_(float lo, float hi) { unsigned r; asm volatile("v_cvt_pk_bf16_f32 %0, %1, %2" : "=v"(r) : "v"(lo), "v"(hi)); return r; }
__device__ __forceinline__ void sgu_seg_mfma(const bf16_t* __restrict__ Z, const float* __restrict__ lng, const bf16_t* __restrict__ wsb  , const float* __restrict__ sb,
                                             bf16_t* __restrict__ Y, LAS unsigned char* L, int seg, int tid) {
    const int lane = tid & 63, w = __builtin_amdgcn_readfirstlane(tid >> 6), t0 = seg * 128;
    {
        const f32x4 gg = *(const f32x4*)(lng + 4 * lane);
        u32x2 raw[16];
#pragma unroll
        for (int i = 0; i < 16; ++i) raw[i] = *(const u32x2*)(Z + (size_t)(t0 + w * 16 + i) * ZP + OFF_SGU + 256 + 4 * lane);
#pragma unroll
        for (int i = 0; i < 16; ++i) {
            const float x0 = __uint_as_float(raw[i].x << 16), x1 = __uint_as_float(raw[i].x & 0xffff0000u), x2 = __uint_as_float(raw[i].y << 16), x3 = __uint_as_float(raw[i].y & 0xffff0000u);
            const float s = wave_sum((x0 + x1) + (x2 + x3));
            const float mu = s * (1.0f / 256.0f);
            const float d0 = x0 - mu, d1 = x1 - mu, d2 = x2 - mu, d3 = x3 - mu;
            const float q = wave_sum((d0 * d0 + d1 * d1) + (d2 * d2 + d3 * d3));
            const float rs = rsqrtf(q * (1.0f / 256.0f) + EPS);
            u32x2 o; o.x = cvtpk_(d0 * rs * gg.x, d1 * rs * gg.y); o.y = cvtpk_(d2 * rs * gg.z, d3 * rs * gg.w);
            const unsigned row = (unsigned)(w * 16 + i), ch = (unsigned)(4 * lane);
            *(LAS u32x2*)(L + (ch >> 7) * 32768u + offb_(row, (ch & 127u) >> 3) + ((ch & 4u) ? 8u : 0u)) = o;
        }
    }
    __syncthreads();
    const int r = lane & 31, hh = lane >> 5, ct = w >> 2;
    const unsigned blk = (lane >> 4) & 1, qq = (lane & 15) >> 2, pp = lane & 3;
#pragma unroll
    for (int g = 0; g < 4; ++g) {
        const int pt = (w + g) & 3;
        const unsigned c = (unsigned)((g & 1) * 2 + ct);
        const LAS unsigned char* img = L + (g >> 1) * 32768;
        const unsigned va0 = offb_(8u * hh + qq, 4u * c + 2u * blk + (pp >> 1)) + 8u * (pp & 1), va1 = offb_(8u * hh + 4u + qq, 4u * c + 2u * blk + (pp >> 1)) + 8u * (pp & 1);
        const bf16_t* wrow = wsb + ((size_t)g * 128 + 32 * pt + r) * 128 + 8 * hh;
        f32x16_t acc;
#pragma unroll
        for (int i = 0; i < 16; ++i) acc[i] = 0.f;
        const int nks = 2 * (pt + 1);
        for (int ks = 0; ks < nks; ++ks) {
            const s16x4_t lo = vtr_(img + va0 + ks * 4096), hi = vtr_(img + va1 + ks * 4096);
            const bf16x8 a = {lo[0], lo[1], lo[2], lo[3], hi[0], hi[1], hi[2], hi[3]};
            const bf16x8 bw = *(const bf16x8*)(wrow + 16 * ks);
            acc = __builtin_amdgcn_mfma_f32_32x32x16_bf16(a, bw, acc, 0, 0, 0);
        }
        const int p = 32 * pt + r;
        const float bias = sb[g * 128 + p];
        const bf16_t* up = Z + (size_t)(t0 + p) * ZP + OFF_SGU + g * 64 + 32 * ct + 4 * hh;
        bf16_t* yp = Y + (size_t)(t0 + p) * YW + 512 + g * 64 + 32 * ct + 4 * hh;
        u32x2 uvv[4];
#pragma unroll
        for (int gq = 0; gq < 4; ++gq) uvv[gq] = *(const u32x2*)(up + 8 * gq);
        asm volatile("" ::: "memory");
#pragma unroll
        for (int gq = 0; gq < 4; ++gq) { const u32x2 uv = uvv[gq];
            u32x2 o; o.x = cvtpk_(__uint_as_float(uv.x << 16) * (acc[4 * gq + 0] + bias), __uint_as_float(uv.x & 0xffff0000u) * (acc[4 * gq + 1] + bias));
            o.y = cvtpk_(__uint_as_float(uv.y << 16) * (acc[4 * gq + 2] + bias), __uint_as_float(uv.y & 0xffff0000u) * (acc[4 * gq + 3] + bias));
            *(u32x2*)(yp + 8 * gq) = o; }
    }
    __syncthreads();
}

__device__ __forceinline__ void pool_unit_mfma(const bf16_t* __restrict__ Z, const bf16_t* __restrict__ pwt  , const float* __restrict__ ps, bf16_t* __restrict__ Y, int unit, int lane) {
    const int g = unit & 3, tt = unit >> 2, r = lane & 31, hh = lane >> 5;
    const int t = tt * 32 + r, s = t & (SEQ - 1), win = 2 << g;
    const int cnt = (s + 1) < win ? (s + 1) : win;
    const float icnt = 1.0f / (float)cnt;
    f32x16_t acc0, acc1;
#pragma unroll
    for (int i = 0; i < 16; ++i) { acc0[i] = 0.f; acc1[i] = 0.f; }
#pragma unroll
    for (int ks = 0; ks < 4; ++ks) {
        const bf16_t* zp = Z + (size_t)t * ZP + OFF_POOL + g * 64 + 16 * ks + 8 * hh;
        float sm[8];
#pragma unroll
        for (int e = 0; e < 8; ++e) sm[e] = 0.f;
        u32x4 self = {0u, 0u, 0u, 0u};
        for (int d = 0; d < win; ++d) {
            if (d < cnt) { const u32x4 v = *(const u32x4*)(zp - (size_t)d * ZP); if (d == 0) self = v;
                sm[0] += __uint_as_float(v.x << 16); sm[1] += __uint_as_float(v.x & 0xffff0000u); sm[2] += __uint_as_float(v.y << 16); sm[3] += __uint_as_float(v.y & 0xffff0000u);
                sm[4] += __uint_as_float(v.z << 16); sm[5] += __uint_as_float(v.z & 0xffff0000u); sm[6] += __uint_as_float(v.w << 16); sm[7] += __uint_as_float(v.w & 0xffff0000u); }
        }
        u32x4 pb;
        pb.x = cvtpk_(sm[0] * icnt - __uint_as_float(self.x << 16), sm[1] * icnt - __uint_as_float(self.x & 0xffff0000u));
        pb.y = cvtpk_(sm[2] * icnt - __uint_as_float(self.y << 16), sm[3] * icnt - __uint_as_float(self.y & 0xffff0000u));
        pb.z = cvtpk_(sm[4] * icnt - __uint_as_float(self.z << 16), sm[5] * icnt - __uint_as_float(self.z & 0xffff0000u));
        pb.w = cvtpk_(sm[6] * icnt - __uint_as_float(self.w << 16), sm[7] * icnt - __uint_as_float(self.w & 0xffff0000u));
        const bf16x8 bp = __builtin_bit_cast(bf16x8, pb);
        const bf16x8 a0 = *(const bf16x8*)(pwt + ((size_t)g * 64 + r) * 64 + 16 * ks + 8 * hh);
        const bf16x8 a1 = *(const bf16x8*)(pwt + ((size_t)g * 64 + 32 + r) * 64 + 16 * ks + 8 * hh);
        acc0 = __builtin_amdgcn_mfma_f32_32x32x16_bf16(a0, bp, acc0, 0, 0, 0);
        acc1 = __builtin_amdgcn_mfma_f32_32x32x16_bf16(a1, bp, acc1, 0, 0, 0);
    }
    bf16_t* yp = Y + (size_t)t * YW + g * 64 + 4 * hh;
    f32x4 sc0[4], sc1[4];
#pragma unroll
    for (int gq = 0; gq < 4; ++gq) { sc0[gq] = *(const f32x4*)(ps + g * 64 + 8 * gq + 4 * hh); sc1[gq] = *(const f32x4*)(ps + g * 64 + 32 + 8 * gq + 4 * hh); }
    asm volatile("" ::: "memory");
#pragma unroll
    for (int gq = 0; gq < 4; ++gq) {
        const f32x4 s0 = sc0[gq], s1 = sc1[gq];
        u32x2 o; o.x = cvtpk_(acc0[4 * gq + 0] * s0.x, acc0[4 * gq + 1] * s0.y); o.y = cvtpk_(acc0[4 * gq + 2] * s0.z, acc0[4 * gq + 3] * s0.w); *(u32x2*)(yp + 8 * gq) = o;
        o.x = cvtpk_(acc1[4 * gq + 0] * s1.x, acc1[4 * gq + 1] * s1.y); o.y = cvtpk_(acc1[4 * gq + 2] * s1.z, acc1[4 * gq + 3] * s1.w); *(u32x2*)(yp + 32 + 8 * gq) = o;
    }
}

__device__ __forceinline__ void router_row(const float* __restrict__ hrow, const float* __restrict__ g, const float* __restrict__ rw, bf16_t* __restrict__ orow, int& e0o, int& e1o, float& w0o, float& w1o, int lane) {
    const f32x4* p = (const f32x4*)hrow;
    f32x4 v[4]; float ss = 0.f;
#pragma unroll
    for (int j = 0; j < 4; ++j) { v[j] = p[lane + 64 * j]; ss += (v[j].x * v[j].x + v[j].y * v[j].y) + (v[j].z * v[j].z + v[j].w * v[j].w); }
    ss = wave_sum(ss);
    const float r = rsqrtf(ss * (1.0f / D) + EPS);
    float lg[8];
#pragma unroll
    for (int e = 0; e < 8; ++e) lg[e] = 0.f;
    u32x2* op = (u32x2*)orow;
#pragma unroll
    for (int j = 0; j < 4; ++j) {
        const int k = (lane + 64 * j) * 4; const f32x4 gg = *(const f32x4*)(g + k);
        const float x0 = v[j].x * r * gg.x, x1 = v[j].y * r * gg.y, x2 = v[j].z * r * gg.z, x3 = v[j].w * r * gg.w;
        u32x2 w; w.x = pk2(x0, x1); w.y = pk2(x2, x3); op[lane + 64 * j] = w;
        const f32x4* rp = (const f32x4*)(rw + (size_t)k * 8);
#pragma unroll
        for (int q = 0; q < 4; ++q) { const float xx = q == 0 ? x0 : (q == 1 ? x1 : (q == 2 ? x2 : x3)); const f32x4 ra = rp[q * 2], rb = rp[q * 2 + 1];
            lg[0] = fmaf(xx, ra.x, lg[0]); lg[1] = fmaf(xx, ra.y, lg[1]); lg[2] = fmaf(xx, ra.z, lg[2]); lg[3] = fmaf(xx, ra.w, lg[3]);
            lg[4] = fmaf(xx, rb.x, lg[4]); lg[5] = fmaf(xx, rb.y, lg[5]); lg[6] = fmaf(xx, rb.z, lg[6]); lg[7] = fmaf(xx, rb.w, lg[7]); }
    }
#pragma unroll
    for (int e = 0; e < 8; ++e) lg[e] = wave_sum(lg[e]);
    int i0 = 0; float v0 = lg[0];
#pragma unroll
    for (int e = 1; e < 8; ++e) if (lg[e] > v0) { v0 = lg[e]; i0 = e; }
    int i1 = -1; float v1 = -3e38f;
#pragma unroll
    for (int e = 0; e < 8; ++e) if (e != i0 && lg[e] > v1) { v1 = lg[e]; i1 = e; }
    const float e1 = __expf(v1 - v0);
    e0o = i0; e1o = i1; w0o = 1.0f / (1.0f + e1); w1o = e1 / (1.0f + e1);
}


namespace fa {
typedef float f32x16 __attribute__((ext_vector_type(16)));
typedef short s16x4 __attribute__((ext_vector_type(4)));
typedef short v4i16_t __attribute__((ext_vector_type(4)));
constexpr int TAB_OFF = 131072;
constexpr int TABN = 328;
constexpr float C2 = 0.125f * 1.4426950408889634f;
constexpr float LOG2E = 1.4426950408889634f;
__device__ __forceinline__ unsigned off_b(unsigned row, unsigned ch) { return 256u * row + 16u * (ch ^ (((row & 3u) << 2) | ((row >> 2) & 3u))); }
__device__ __forceinline__ s16x4 vtr(const LAS unsigned char* p) { return __builtin_bit_cast(s16x4, __builtin_amdgcn_ds_read_tr16_b64_v4i16((LAS v4i16_t*)p)); }
__device__ __forceinline__ float max3f(float a, float b, float c) { float r; asm("v_max3_f32 %0, %1, %2, %3" : "=v"(r) : "v"(a), "v"(b), "v"(c)); return r; }
__device__ __forceinline__ float max2f(float a, float b) { float r; asm("v_max_f32_e32 %0, %1, %2" : "=v"(r) : "v"(a), "v"(b)); return r; }
__device__ __forceinline__ unsigned cvtpk(float lo, float hi) { unsigned r; asm volatile("v_cvt_pk_bf16_f32 %0, %1, %2" : "=v"(r) : "v"(lo), "v"(hi)); return r; }

__device__ __forceinline__ void attn_phase(LAS unsigned char* lds, const bf16_t* __restrict__ Z, const float* __restrict__ relb, const float* __restrict__ dl, const float* __restrict__ sg,
                                           float lam_init, bf16_t* __restrict__ Y, int G, int bx, int wave_) {
    int tid = wave_ * 64 + lane_id(); asm volatile("" : "+v"(tid));
    const int lane = tid & 63, w = __builtin_amdgcn_readfirstlane(tid >> 6), m = w >> 2, r32 = w & 3, r = lane & 31, hh = lane >> 5;
    const float l1 = wave_sum(dl[lane] * dl[64 + lane]), l2 = wave_sum(dl[128 + lane] * dl[192 + lane]);
    const float lam = __expf(l1) - __expf(l2) + lam_init;
    LAS float* TAB = (LAS float*)(lds + TAB_OFF);
    unsigned goff[2];
#pragma unroll
    for (int i = 0; i < 2; ++i) { const unsigned pos = (unsigned)w * 1024u + (unsigned)i * 8192u + (unsigned)lane * 16u, row = pos >> 8, p = (pos >> 4) & 15u;
        const unsigned ch = p ^ (((row & 3u) << 2) | ((row >> 2) & 3u)); goff[i] = row * (unsigned)(ZP * 2) + ch * 16u; }
    unsigned kaddr[4];
#pragma unroll
    for (int s = 0; s < 4; ++s) kaddr[s] = off_b((unsigned)r, (unsigned)(m * 8 + 2 * s + hh));
    unsigned vaddr[4][2];
    { const unsigned blk = (lane >> 4) & 1, q = (lane & 15) >> 2, p = lane & 3;
#pragma unroll
      for (int c = 0; c < 4; ++c)
#pragma unroll
          for (int t = 0; t < 2; ++t) vaddr[c][t] = off_b(8u * t + 4u * hh + q, 4u * c + 2u * blk + (p >> 1)) + 8u * (p & 1); }

    const int vcu = (G % 8 == 0) ? (bx % 8) * (G / 8) + bx / 8 : bx;
    int tab_h = -1;
    for (int ui = 0;; ++ui) {
        const int pidx = vcu + G * (ui >> 1);
        if (pidx >= 512) break;
        const int j8 = pidx & 7, h = (pidx >> 3) & 3, b = pidx >> 5;
        const int qb = (ui & 1) ? 15 - j8 : j8;
        const int q0 = qb * 128, nkt = 2 * qb + 2, qs = q0 + 32 * r32;
        const int my_nkt = r32 < 2 ? nkt - 1 : nkt;
        const char* zb = (const char*)Z + (size_t)(b * SEQ) * ZP * 2;
        const char* kbase = zb + (OFF_ATTN + 512 + h * 128) * 2;
        const char* vbase = zb + (OFF_ATTN + 1024 + h * 128) * 2;
        __syncthreads();
        if (h != tab_h) {
            for (int idx = tid; idx < 2 * 4 * TABN; idx += 512) { const int mm = idx / (4 * TABN), c = (idx / TABN) & 3, y = idx % TABN; TAB[idx] = relb[rel_bucket(y - c - 256) * 8 + h * 2 + mm] * LOG2E; }
            tab_h = h;
        }
        const float b15p = relb[15 * 8 + h * 2 + m] * LOG2E;
        bf16x8 Qf[4];
        { const char* qp = zb + ((size_t)(qs + r) * ZP + OFF_ATTN + h * 128 + m * 64 + 8 * hh) * 2;
#pragma unroll
          for (int s = 0; s < 4; ++s) Qf[s] = *(const bf16x8*)(qp + s * 32); }
        asm volatile("s_waitcnt vmcnt(0)" ::: "memory");
#define FA_LOAD_TILE(kt_, buf_) do { const size_t to_ = (size_t)(kt_) * 64 * ZP * 2; LAS unsigned char* lb_ = lds + (buf_) * 32768 + w * 1024; \
        __builtin_amdgcn_global_load_lds((const unsigned*)(kbase + to_ + goff[0]), (LAS unsigned*)(lb_), 16, 0, 0); \
        __builtin_amdgcn_global_load_lds((const unsigned*)(kbase + to_ + goff[1]), (LAS unsigned*)(lb_ + 8192), 16, 0, 0); \
        __builtin_amdgcn_global_load_lds((const unsigned*)(vbase + to_ + goff[0]), (LAS unsigned*)(lb_ + 16384), 16, 0, 0); \
        __builtin_amdgcn_global_load_lds((const unsigned*)(vbase + to_ + goff[1]), (LAS unsigned*)(lb_ + 16384 + 8192), 16, 0, 0); } while (0)
        FA_LOAD_TILE(0, 0); FA_LOAD_TILE(1, 1);
        f32x16 O[4];
#pragma unroll
        for (int c = 0; c < 4; ++c)
#pragma unroll
            for (int i = 0; i < 16; ++i) O[c][i] = 0.f;
        float mref = 0.f, lsum = 0.f;
        const int sq = qs + r, sqa = sq >> 2, sqc = sq & 3;
        const LAS float* tabl = TAB + (m * 4 + sqc) * TABN + 256 - 4 * sqa + 4 * hh;
        f32x16 S0, S1;
#pragma unroll
        for (int i = 0; i < 16; ++i) { S0[i] = 0.f; S1[i] = 0.f; }
        bf16x8 P[4];
#pragma unroll
        for (int i = 0; i < 4; ++i) P[i] = (bf16x8){0, 0, 0, 0, 0, 0, 0, 0};
        constexpr float THR = 8.0f;
        for (int t = 0; t <= nkt; ++t) {
            if (t < nkt) { if (t + 1 < nkt) asm volatile("s_waitcnt vmcnt(4) lgkmcnt(0)\n\ts_barrier" ::: "memory"); else asm volatile("s_waitcnt vmcnt(0) lgkmcnt(0)\n\ts_barrier" ::: "memory"); }
            else asm volatile("s_waitcnt lgkmcnt(0)\n\ts_barrier" ::: "memory");
            if (t + 2 < nkt) FA_LOAD_TILE(t + 2, (t + 2) & 3);
            const bool do_qk = t < my_nkt, do_pv = t >= 1 && (t - 1) < my_nkt;
            float alpha = 1.f, sub = 0.f; bool moved = false;
            if (do_qk) {
                const LAS unsigned char* Kb = lds + (t & 3) * 32768;
                bf16x8 kf[8];
#pragma unroll
                for (int s_ = 0; s_ < 4; ++s_) { kf[2 * s_] = *(const LAS bf16x8*)(Kb + kaddr[s_]); kf[2 * s_ + 1] = *(const LAS bf16x8*)(Kb + kaddr[s_] + 8192); }
#pragma unroll
                for (int i = 0; i < 16; ++i) { S0[i] = 0.f; S1[i] = 0.f; }
                __builtin_amdgcn_sched_barrier(0);
#pragma unroll
                for (int s_ = 0; s_ < 4; ++s_) { S0 = __builtin_amdgcn_mfma_f32_32x32x16_bf16(kf[2 * s_], Qf[s_], S0, 0, 0, 0); S1 = __builtin_amdgcn_mfma_f32_32x32x16_bf16(kf[2 * s_ + 1], Qf[s_], S1, 0, 0, 0); }
                __builtin_amdgcn_sched_barrier(0);
                const bool nearb = (64 * t + 63 - qs) > -91;
                if (nearb) {
                    const LAS float* tb = tabl + 64 * t;
#pragma unroll
                    for (int g = 0; g < 4; ++g) { const f32x4 b0 = *(const LAS f32x4*)(tb + 8 * g), b1 = *(const LAS f32x4*)(tb + 32 + 8 * g);
#pragma unroll
                        for (int e = 0; e < 4; ++e) { S0[4 * g + e] += b0[e]; S1[4 * g + e] += b1[e]; } }
                }
                float mx = max3f(S0[0], S1[0], S0[1]);
                mx = max3f(mx, S1[1], S0[2]);
#pragma unroll
                for (int i = 2; i < 15; ++i) mx = max3f(mx, S1[i], S0[i + 1]);
                mx = max2f(mx, S1[15]);
                mx = max_xor32(mx);
                if (!nearb) mx += b15p;
                if (!__all(mx <= mref + THR)) {
                    const float mn = fmaxf(mref, mx);
                    alpha = __builtin_amdgcn_exp2f(mref - mn); lsum *= alpha; mref = mn; moved = true;
                }
                sub = nearb ? mref : (mref - b15p);
            }
#define FA_PV_STEP(FILL) do { const LAS unsigned char* Vb = lds + ((t + 3) & 3) * 32768 + 16384; s16x4 vlo[2][4], vhi[2][4]; \
                _Pragma("unroll") for (int c = 0; c < 4; ++c) { vlo[0][c] = vtr(Vb + vaddr[c][0]); vhi[0][c] = vtr(Vb + vaddr[c][1]); } \
                _Pragma("unroll") for (int ks = 0; ks < 4; ++ks) { \
                    if (ks < 3) { _Pragma("unroll") for (int c = 0; c < 4; ++c) { vlo[(ks + 1) & 1][c] = vtr(Vb + vaddr[c][0] + (ks + 1) * 4096); vhi[(ks + 1) & 1][c] = vtr(Vb + vaddr[c][1] + (ks + 1) * 4096); } } \
                    __builtin_amdgcn_sched_barrier(0); \
                    _Pragma("unroll") for (int c = 0; c < 4; ++c) { const s16x4 lo = vlo[ks & 1][c], hi = vhi[ks & 1][c]; \
                        const bf16x8 a = {lo[0], lo[1], lo[2], lo[3], hi[0], hi[1], hi[2], hi[3]}; \
                        O[c] = __builtin_amdgcn_mfma_f32_32x32x16_bf16(a, P[ks], O[c], 0, 0, 0); \
                        if (FILL) { const int j = ks * 4 + c; float e0 = __builtin_amdgcn_exp2f(S0[j] - sub), e1 = __builtin_amdgcn_exp2f(S1[j] - sub); \
                            asm volatile("" : "+v"(e0), "+v"(e1)); S0[j] = e0; S1[j] = e1; lsum += e0 + e1; } \
                        __builtin_amdgcn_sched_barrier(0); } } } while (0)
            if (do_pv) {
                if (!do_qk) sub = 1e30f;
                FA_PV_STEP(true);
                if (moved) {
#pragma unroll
                    for (int c = 0; c < 4; ++c)
#pragma unroll
                        for (int i = 0; i < 16; ++i) O[c][i] *= alpha;
                }
            } else if (do_qk) {
#pragma unroll
                for (int j = 0; j < 16; ++j) { const float e0 = __builtin_amdgcn_exp2f(S0[j] - sub), e1 = __builtin_amdgcn_exp2f(S1[j] - sub); S0[j] = e0; S1[j] = e1; lsum += e0 + e1; }
            }
#undef FA_PV_STEP
            if (do_qk) {
#pragma unroll
                for (int s2 = 0; s2 < 2; ++s2) {
                    u32x4 a, c4;
                    a.x = cvtpk(S0[8 * s2 + 0], S0[8 * s2 + 1]); a.y = cvtpk(S0[8 * s2 + 2], S0[8 * s2 + 3]); a.z = cvtpk(S0[8 * s2 + 4], S0[8 * s2 + 5]); a.w = cvtpk(S0[8 * s2 + 6], S0[8 * s2 + 7]);
                    c4.x = cvtpk(S1[8 * s2 + 0], S1[8 * s2 + 1]); c4.y = cvtpk(S1[8 * s2 + 2], S1[8 * s2 + 3]); c4.z = cvtpk(S1[8 * s2 + 4], S1[8 * s2 + 5]); c4.w = cvtpk(S1[8 * s2 + 6], S1[8 * s2 + 7]);
                    P[s2] = __builtin_bit_cast(bf16x8, a); P[2 + s2] = __builtin_bit_cast(bf16x8, c4);
                }
            }
        }
#undef FA_LOAD_TILE
        lsum = sum_xor32(lsum);
        const float inv = m == 0 ? 1.0f / lsum : lam / lsum;
        asm volatile("s_waitcnt lgkmcnt(0)\n\ts_barrier" ::: "memory");
        LAS float* EX = (LAS float*)lds + (size_t)r32 * 4096 + lane;
        if (m == 1) {
#pragma unroll
            for (int c = 0; c < 4; ++c)
#pragma unroll
                for (int i = 0; i < 16; ++i) EX[(c * 16 + i) * 64] = O[c][i] * inv;
        }
        asm volatile("s_waitcnt lgkmcnt(0)\n\ts_barrier" ::: "memory");
        if (m == 0) {
            float ss = 0.f;
#pragma unroll
            for (int c = 0; c < 4; ++c)
#pragma unroll
                for (int i = 0; i < 16; ++i) { const float o = O[c][i] * inv - EX[(c * 16 + i) * 64]; O[c][i] = o; ss += o * o; }
            ss = sum_xor32(ss);
            const float rn = rsqrtf(ss * (1.0f / 128.0f) + EPS) * (1.0f - lam_init);
            bf16_t* yp = Y + (size_t)(b * SEQ + qs + r) * YW + 768 + h * 128 + 4 * hh;
            f32x4 sgv[4][4];
#pragma unroll
            for (int c = 0; c < 4; ++c)
#pragma unroll
                for (int g = 0; g < 4; ++g) sgv[c][g] = *(const f32x4*)(sg + 32 * c + 8 * g + 4 * hh);
            asm volatile("" ::: "memory");
#pragma unroll
            for (int c = 0; c < 4; ++c)
#pragma unroll
                for (int g = 0; g < 4; ++g) { const f32x4 gg = sgv[c][g];
                    u32x2 o; o.x = cvtpk(O[c][4 * g + 0] * rn * gg.x, O[c][4 * g + 1] * rn * gg.y); o.y = cvtpk(O[c][4 * g + 2] * rn * gg.z, O[c][4 * g + 3] * rn * gg.w);
                    *(u32x2*)(yp + 32 * c + 8 * g) = o; }
        }
    }
    __syncthreads();
}
}


__device__ __forceinline__ void router_rows4(const bf16_t* __restrict__ h, int t, const float* __restrict__ g, const f32x4 (&RW)[4][4][2], unsigned char* __restrict__ XNo,
                                             int* __restrict__ tok_e, float* __restrict__ tok_w, LAS int* hist, int lane) {
    f32x4 v[4][4];
#pragma unroll
    for (int i = 0; i < 4; ++i)
#pragma unroll
        for (int j = 0; j < 4; ++j) { const u32x2 h2 = ((const u32x2*)(h + (size_t)(t + i) * D))[lane + 64 * j];
            v[i][j] = (f32x4){__uint_as_float(h2.x << 16), __uint_as_float(h2.x & 0xffff0000u), __uint_as_float(h2.y << 16), __uint_as_float(h2.y & 0xffff0000u)}; }
    f32x4 gg[4];
#pragma unroll
    for (int j = 0; j < 4; ++j) gg[j] = ((const f32x4*)g)[lane + 64 * j];
#pragma unroll
    for (int i = 0; i < 4; ++i) {
        float ss = 0.f;
#pragma unroll
        for (int j = 0; j < 4; ++j) ss += (v[i][j].x * v[i][j].x + v[i][j].y * v[i][j].y) + (v[i][j].z * v[i][j].z + v[i][j].w * v[i][j].w);
        ss = wave_sum(ss);
        const float r = rsqrtf(ss * (1.0f / D) + EPS);
        float lg[8];
#pragma unroll
        for (int e = 0; e < 8; ++e) lg[e] = 0.f;
        unsigned* op = (unsigned*)(XNo + (size_t)(t + i) * D);
#pragma unroll
        for (int j = 0; j < 4; ++j) {
            const float x0 = v[i][j].x * r * gg[j].x, x1 = v[i][j].y * r * gg[j].y, x2 = v[i][j].z * r * gg[j].z, x3 = v[i][j].w * r * gg[j].w;
            op[lane + 64 * j] = pg8::pk4_fp8(pg8::sat8(x0 * pg8::F8S_HN), pg8::sat8(x1 * pg8::F8S_HN), pg8::sat8(x2 * pg8::F8S_HN), pg8::sat8(x3 * pg8::F8S_HN));
#pragma unroll
            for (int q = 0; q < 4; ++q) { const float xx = q == 0 ? x0 : (q == 1 ? x1 : (q == 2 ? x2 : x3)); const f32x4 ra = RW[j][q][0], rb = RW[j][q][1];
                lg[0] = fmaf(xx, ra.x, lg[0]); lg[1] = fmaf(xx, ra.y, lg[1]); lg[2] = fmaf(xx, ra.z, lg[2]); lg[3] = fmaf(xx, ra.w, lg[3]);
                lg[4] = fmaf(xx, rb.x, lg[4]); lg[5] = fmaf(xx, rb.y, lg[5]); lg[6] = fmaf(xx, rb.z, lg[6]); lg[7] = fmaf(xx, rb.w, lg[7]); }
        }
#pragma unroll
        for (int e = 0; e < 8; ++e) lg[e] = wave_sum(lg[e]);
        int i0 = 0; float v0 = lg[0];
#pragma unroll
        for (int e = 1; e < 8; ++e) if (lg[e] > v0) { v0 = lg[e]; i0 = e; }
        int i1 = -1; float v1 = -3e38f;
#pragma unroll
        for (int e = 0; e < 8; ++e) if (e != i0 && lg[e] > v1) { v1 = lg[e]; i1 = e; }
        const float e1 = __expf(v1 - v0);
        if (lane == 0) { tok_e[2 * (t + i)] = i0; tok_e[2 * (t + i) + 1] = i1; tok_w[2 * (t + i)] = 1.0f / (1.0f + e1); tok_w[2 * (t + i) + 1] = e1 / (1.0f + e1);
            __hip_atomic_fetch_add(&hist[i0], 1, __ATOMIC_RELAXED, __HIP_MEMORY_SCOPE_WORKGROUP); __hip_atomic_fetch_add(&hist[8 + i1], 1, __ATOMIC_RELAXED, __HIP_MEMORY_SCOPE_WORKGROUP); }
    }
}

__device__ __forceinline__ unsigned long long karg_u64(int i) {
    const __attribute__((address_space(4))) unsigned long long* ka = (const __attribute__((address_space(4))) unsigned long long*)__builtin_amdgcn_kernarg_segment_ptr();
    asm volatile("" : "+s"(ka));
    return ka[i];
}
#define AIN(i) ((const float*)karg_u64(i))
#define AOUT ((float*)karg_u64(25))
#define AWS ((unsigned char*)karg_u64(26))
__global__ void __launch_bounds__(NWAVES * 64, 2) mega(Args args) {
    extern __shared__ __attribute__((aligned(16))) unsigned char lds_raw[];
    LAS unsigned char* lds = (LAS unsigned char*)lds_raw;
    volatile LAS unsigned* MISC = (volatile LAS unsigned*)(lds + MISC_OFF);
    const int tid0 = threadIdx.x, wave = __builtin_amdgcn_readfirstlane(tid0 >> 6);
    const int G = gridDim.x, bx = blockIdx.x;
    const int gw = bx * NWAVES + wave, NGW = G * NWAVES;
#define PHASE_TID int tid = wave * 64 + lane_id(); asm volatile("" : "+v"(tid)); const int lane = tid & 63; (void)lane
    for (int u = tid0; u < (LDS_BYTES - MISC_OFF) / 4; u += NWAVES * 64) ((LAS unsigned*)(lds + MISC_OFF))[u] = 0u;
    __syncthreads();
    XcdBarrier bar = xcd_barrier_post((unsigned*)(AWS + WS_CTL) + CW_BAR, MISC + 8, wave);
#define IN(k) true
#define SEAM(k) do { if (IN(k) && IN((k) + 1)) xcd_barrier(bar); } while (0)
#ifndef PROBE_REP
#define PROBE_REP 0
#endif
#define REPFOR(bit) _Pragma("unroll") for (int rep_ = 0; rep_ < 1 + ((PROBE_REP >> (bit)) & 1); ++rep_)
#define REPBAR do { if (rep_) xcd_barrier(bar); } while (0)

#define P_x AIN(0)
#define P_out AOUT
#define P_ws AWS
#define P_Wb ((bf16_t*)(AWS + WS_W))
#define P_XN ((bf16_t*)(AWS + WS_XN))
#define P_Z ((bf16_t*)(AWS + WS_Z))
#define P_Y ((bf16_t*)(AWS + WS_Y))
#define P_HS ((bf16_t*)(AWS + WS_HS))
#define P_cnts ((int*)(AWS + WS_CNT))
#define P_tok_e ((int*)(AWS + WS_TOKE))
#define P_tok_w ((float*)(AWS + WS_TOKW))
#define P_slot_tok ((int*)(AWS + WS_SLOTT))
#define P_slot_w ((float*)(AWS + WS_SLOTW))
#define P_gbases (P_cnts + 256 * 16)

    if (IN(0)) REPFOR(0) {
        REPBAR; PHASE_TID;
        LAS float* scr = (LAS float*)(lds + wave * 16384);
        constexpr int I_IN = (1024 / 64) * (7168 / 32), I_BR = (256 / 64) * (1024 / 32), I_BA = (512 / 64) * (1024 / 32), I_OUT = (1024 / 64) * (1024 / 32);
        constexpr int I_FGU = (1024 / 64) * (5632 / 32), I_FDN = (2816 / 64) * (1024 / 32), I_MGU = (1024 / 64) * (7168 / 32), I_MDN = (3584 / 64) * (1024 / 32);
        constexpr int I_L = I_IN + 3 * I_BR + I_BA + I_OUT;
        constexpr int NITEMS = 2 * I_L + I_FGU + I_FDN + 8 * I_MGU + 8 * I_MDN;
        for (int it = gw; it < NITEMS; it += NGW) {
            int r = it;
            if (r < 2 * I_L) {
                const int layer = r / I_L; r -= layer * I_L;
                if (r < I_IN) {
                    if (32 * (r % (7168 / 32)) >= ZP) p0_transpose_item_f8(AIN(3) + (size_t)layer * 1024 * 7168, 1024, 7168, (unsigned char*)P_Wb + WOFF_IN8 + (size_t)layer * 7168 * 1024, 1024, 0, pg8::F8S_WGU, scr, r, lane);
                    else p0_transpose_item(AIN(3) + (size_t)layer * 1024 * 7168, 1024, 7168, (bf16_t*)((char*)P_Wb + WOFF_IN) + (size_t)layer * 7168 * 1024, 1024, 0, 0, scr, r, lane);
                    continue; } r -= I_IN;
                bf16_t* wm = (bf16_t*)((char*)P_Wb + WOFF_MRG) + (size_t)layer * 1024 * 1280;
                if (r < I_BR) { p0_transpose_item(AIN(14) + (size_t)layer * 256 * 1024, 256, 1024, wm, 1280, 0, 0, scr, r, lane); continue; } r -= I_BR;
                if (r < I_BR) { p0_transpose_item(AIN(15) + (size_t)layer * 256 * 1024, 256, 1024, wm, 1280, 256, 0, scr, r, lane); continue; } r -= I_BR;
                if (r < I_BR) { p0_transpose_item(AIN(16) + (size_t)layer * 256 * 1024, 256, 1024, wm, 1280, 512, 0, scr, r, lane); continue; } r -= I_BR;
                if (r < I_BA) { p0_transpose_item(AIN(17) + (size_t)layer * 512 * 1024, 512, 1024, wm, 1280, 768, 0, scr, r, lane); continue; } r -= I_BA;
                p0_transpose_item(AIN(18) + (size_t)layer * 1024 * 1024, 1024, 1024, (bf16_t*)((char*)P_Wb + WOFF_OUT) + (size_t)layer * 1024 * 1024, 1024, 0, 0, scr, r, lane); continue;
            }
            r -= 2 * I_L;
            if (r < I_FGU) { p0_transpose_item(AIN(20), 1024, 5632, (bf16_t*)((char*)P_Wb + WOFF_FGU), 1024, 0, 1, scr, r, lane); continue; } r -= I_FGU;
            if (r < I_FDN) { p0_transpose_item_f8(AIN(21), 2816, 1024, (unsigned char*)P_Wb + WOFF_FDN, 2816, 0, pg8::F8S_WDN, scr, r, lane); continue; } r -= I_FDN;
            if (r < 8 * I_MGU) { const int e = r / I_MGU; r -= e * I_MGU; p0_transpose_item_f8(AIN(23) + (size_t)e * 1024 * 7168, 1024, 7168, (unsigned char*)P_Wb + WOFF_MGU + (size_t)e * 7168 * 1024, 1024, 1, pg8::F8S_WGU, scr, r, lane); continue; } r -= 8 * I_MGU;
            { const int e = r / I_MDN; r -= e * I_MDN; p0_transpose_item_f8(AIN(24) + (size_t)e * 3584 * 1024, 3584, 1024, (unsigned char*)P_Wb + WOFF_MDN + (size_t)e * 1024 * 3584, 3584, 0, pg8::F8S_WDN, scr, r, lane); }
        }
        for (int i = bx * 512 + tid; i < 2 * 4 * 128 * 128; i += G * 512) { const int q = i & 127, p_ = (i >> 7) & 127; ((bf16_t*)((char*)P_Wb + WOFF_SGU))[i] = q <= p_ ? f2bf(AIN(8)[i]) : (bf16_t)0; }
        for (int i = bx * 512 + tid; i < 2 * 4 * 64 * 64; i += G * 512) { const int c = i & 63, d = (i >> 6) & 63, lg = i >> 12; ((bf16_t*)((char*)P_Wb + WOFF_POOL))[i] = f2bf(AIN(4)[((size_t)lg * 64 + c) * 64 + d]); }
        {
            const float* g1 = AIN(2); unsigned char* xn8 = (unsigned char*)P_Wb + WOFF_XN8;
            for (int m = gw; m + 3 * NGW < T; m += 4 * NGW) rms_rows4<true>(P_x, m, NGW, g1, P_XN, xn8, lane);
            for (int m = gw + (((T - gw + NGW - 1) / NGW) & ~3) * NGW; m < T; m += NGW) rms_row<true>(P_x + (size_t)m * D, g1, P_XN + (size_t)m * D, xn8 + (size_t)m * D, lane);
        }
    }
    SEAM(0);

#pragma unroll
    for (int layer = 0; layer < 2; ++layer) {
        const int pb = 1 + layer * 16;
        const float lam_init = layer == 0 ? 0.2f : 0.35550906f;

        if (layer != 0) {
            if (IN(pb + 0)) REPFOR(1) { REPBAR; PHASE_TID; const float* g1 = AIN(2) + layer * D;
                unsigned char* xn8 = (unsigned char*)P_Wb + WOFF_XN8;
                for (int m = gw; m + 3 * NGW < T; m += 4 * NGW) rms_rows4_bf<true>(P_HS, m, NGW, g1, P_XN, xn8, lane);
                for (int m = gw + (((T - gw + NGW - 1) / NGW) & ~3) * NGW; m < T; m += NGW) rms_row_bf<true>(P_HS + (size_t)m * D, g1, P_XN + (size_t)m * D, xn8 + (size_t)m * D, lane); }
            SEAM(pb + 0);
        }
        if (IN(pb + 1)) REPFOR(2) {
            REPBAR;
            {
                pg8::Gemm g{(const char*)P_Wb + WOFF_XN8, D / 2, D / 2}; pg8::SchedPlainOff S{T / 256, (INC - ZP) / 256, ZP / 256, G, bx, D / 128, (const char*)P_Wb + WOFF_IN8 + (size_t)layer * 7168 * 1024};
                pg8::EpiZ<true> E{P_Z, (bf16_t*)(P_ws + WS_G), AIN(10) + layer * 64, AIN(11) + layer * 64, (LAS float*)(lds + pg8::STAGE_BYTES)};
                pg8::gemm_phase<pg8::EpiZ<true>, pg8::SchedPlainOff, true, true>(lds, g, S, E, wave);
            }
            {
                pg8::Gemm g{(const char*)P_XN, D, D}; pg8::SchedPlain S{T / 256, ZP / 256, G, bx, D / 64, (const char*)P_Wb + WOFF_IN + (size_t)layer * 7168 * 1024 * 2};
                pg8::EpiZ<false> E{P_Z, (bf16_t*)(P_ws + WS_G), AIN(10) + layer * 64, AIN(11) + layer * 64, (LAS float*)(lds + pg8::STAGE_BYTES)};
                pg8::gemm_phase<pg8::EpiZ<false>, pg8::SchedPlain, true>(lds, g, S, E, wave);
            }
        }
        SEAM(pb + 1);
        if (IN(pb + 2)) {
            PHASE_TID;
            const float* cw = AIN(6) + layer * 768;
            REPFOR(3) { REPBAR;
            for (int t = gw; t + 3 * NGW < T; t += 4 * NGW) conv_rows4(P_Z, t, NGW, cw, P_Y, lane);
            for (int t = gw + (((T - gw + NGW - 1) / NGW) & ~3) * NGW; t < T; t += NGW) conv_row(P_Z, t, cw, P_Y, lane);
            for (int u = gw; u < (T / 32) * 4; u += NGW) pool_unit_mfma(P_Z, (const bf16_t*)((const char*)P_Wb + WOFF_POOL) + (size_t)layer * 16384, AIN(5) + layer * 256, P_Y, u, lane);
            for (int it = bx; it < T / 128; it += G) sgu_seg_mfma(P_Z, AIN(7) + layer * 256, (const bf16_t*)((const char*)P_Wb + WOFF_SGU) + (size_t)layer * 65536, AIN(9) + layer * 512, P_Y, lds, it, tid);
            }
        }
        if (IN(pb + 3)) REPFOR(4) {
            REPBAR;
            fa::attn_phase(lds, P_Z, AIN(1), AIN(12) + layer * 256, AIN(13) + layer * 128, lam_init, P_Y, G, bx, wave);
        }
        SEAM(pb + 3);
        if (IN(pb + 4)) REPFOR(5) {
            REPBAR;
            __syncthreads();
            pg8::Gemm g{(const char*)P_Y, YW, YW}; pg8::SchedMerge S{T / 256, D / 256, G, bx, (const char*)P_Wb + WOFF_MRG + (size_t)layer * 1024 * 1280 * 2};
            pg8::EpiMerge E{(const bf16_t*)(P_ws + WS_G), P_XN};
            pg8::gemm_phase<pg8::EpiMerge, pg8::SchedMerge, true>(lds, g, S, E, wave);
        }
        SEAM(pb + 4);
        if (IN(pb + 5)) {
            pg8::Gemm g{(const char*)P_XN, D, D}; pg8::SchedPlain S{T / 256, D / 256, G, bx, D / 64, (const char*)P_Wb + WOFF_OUT + (size_t)layer * 1024 * 1024 * 2};
            if (layer == 0) { pg8::EpiResid<false, true> E{P_x, P_HS}; pg8::gemm_phase<pg8::EpiResid<false, true>, pg8::SchedPlain, true>(lds, g, S, E, wave); }
            else { pg8::EpiResid<true, true> E{P_HS, P_HS}; pg8::gemm_phase<pg8::EpiResid<true, true>, pg8::SchedPlain, true>(lds, g, S, E, wave); }
        }
        SEAM(pb + 5);
        if (layer == 0) {
            if (IN(pb + 6)) REPFOR(7) { REPBAR; PHASE_TID; const float* g2 = AIN(19); for (int m = gw; m + 3 * NGW < T; m += 4 * NGW) rms_rows4_bf<false>(P_HS, m, NGW, g2, P_XN, nullptr, lane);
                for (int m = gw + (((T - gw + NGW - 1) / NGW) & ~3) * NGW; m < T; m += NGW) rms_row_bf<false>(P_HS + (size_t)m * D, g2, P_XN + (size_t)m * D, nullptr, lane); }
            SEAM(pb + 6);
            if (IN(pb + 7)) REPFOR(8) {
                REPBAR;
                pg8::Gemm g{(const char*)P_XN, D, D}; pg8::SchedPlain S{T / 256, 2 * DFF / 256, G, bx, D / 64, (const char*)P_Wb + WOFF_FGU};
                pg8::EpiSwi8<false> E{(unsigned char*)P_Z, DFF};
                pg8::gemm_phase<pg8::EpiSwi8<false>, pg8::SchedPlain, true>(lds, g, S, E, wave);
            }
            SEAM(pb + 7);
            if (IN(pb + 8)) {
                pg8::Gemm g{(const char*)P_Z, DFF / 2, DFF / 2}; pg8::SchedPlainRev S{T / 256, D / 256, G, bx, DFF / 128, (const char*)P_Wb + WOFF_FDN};
                pg8::EpiResid<true, true, true> E{P_HS, P_HS};
                pg8::gemm_phase<pg8::EpiResid<true, true, true>, pg8::SchedPlainRev, true, true>(lds, g, S, E, wave);
            }
            SEAM(pb + 8);
        } else {
            if (IN(pb + 6)) REPFOR(7) {
                REPBAR; PHASE_TID;
                const float* g2 = AIN(19) + D; const float* rw = AIN(22);
                LAS int* hist = (LAS int*)lds;
                f32x4 RW[4][4][2];
#pragma unroll
                for (int j = 0; j < 4; ++j)
#pragma unroll
                    for (int q = 0; q < 4; ++q) { const f32x4* rp = (const f32x4*)(rw + (size_t)((lane + 64 * j) * 4 + q) * 8); RW[j][q][0] = rp[0]; RW[j][q][1] = rp[1]; }
                for (int ch = bx; ch < 256; ch += G) {
                    if (tid < 16) hist[tid] = 0;
                    __syncthreads();
#pragma unroll 1
                    for (int i = 0; i < 16; i += 4) router_rows4(P_HS, ch * 128 + wave * 16 + i, g2, RW, (unsigned char*)P_XN, P_tok_e, P_tok_w, hist, lane);
                    __syncthreads();
                    if (tid < 16) P_cnts[ch * 16 + tid] = hist[tid];
                    __syncthreads();
                }
            }
            SEAM(pb + 6);
            if (IN(pb + 7)) REPFOR(9) {
                REPBAR; PHASE_TID;
                LAS int* C = (LAS int*)lds;
                LAS int* PT = C + 4096;
                LAS int* TOT = PT + 1024; LAS int* BASE = TOT + 16; LAS int* PRE = BASE + 32; LAS int* W0C = PRE + 16;
                for (int i = tid; i < 4096; i += 512) C[i] = P_cnts[i];
                __syncthreads();
                { const int g = tid & 15, part = tid >> 4; int s_ = 0;
#pragma unroll
                  for (int c = 0; c < 8; ++c) s_ += C[(part * 8 + c) * 16 + g];
                  PT[part * 16 + g] = s_; }
                __syncthreads();
                if (tid < 16) { int s_ = 0; for (int q = 0; q < 32; ++q) s_ += PT[q * 16 + tid]; TOT[tid] = s_; }
                __syncthreads();
                if (tid == 0) { int b_ = 0; for (int g = 0; g < 16; ++g) { BASE[g] = b_; b_ += (TOT[g] + 255) & ~255; } BASE[16] = b_; }
                __syncthreads();
                if (bx == 0 && tid < 17) P_gbases[tid] = BASE[tid];
                for (int g = bx; g < 16; g += G) { for (int s_ = BASE[g] + TOT[g] + tid; s_ < BASE[g + 1]; s_ += 512) { P_slot_tok[s_] = -1; P_slot_w[s_] = 0.f; } }
                for (int ch = bx; ch < 256; ch += G) {
                    { const int g = tid & 15, part = tid >> 4; int s_ = 0;
#pragma unroll
                      for (int c = 0; c < 8; ++c) { const int cc = part * 8 + c; s_ += cc < ch ? C[cc * 16 + g] : 0; }
                      PT[512 + part * 16 + g] = s_; }
                    __syncthreads();
                    if (tid < 16) { int s_ = 0; for (int q = 0; q < 32; ++q) s_ += PT[512 + q * 16 + tid]; PRE[tid] = s_; }
                    int e0 = 0, e1 = 0, p0 = 0, p1 = 0;
                    if (tid < 128) { const int t = ch * 128 + tid; e0 = P_tok_e[2 * t]; e1 = 8 + P_tok_e[2 * t + 1];
#pragma unroll
                        for (int g = 0; g < 8; ++g) {
                            const unsigned long long m0 = __ballot(e0 == g), m1 = __ballot(e1 == 8 + g);
                            const int b0 = (int)__builtin_amdgcn_mbcnt_hi((unsigned)(m0 >> 32), __builtin_amdgcn_mbcnt_lo((unsigned)m0, 0u)), b1 = (int)__builtin_amdgcn_mbcnt_hi((unsigned)(m1 >> 32), __builtin_amdgcn_mbcnt_lo((unsigned)m1, 0u));
                            if (e0 == g) p0 = b0;
                            if (e1 == 8 + g) p1 = b1;
                            if (tid == 0) { W0C[g] = __popcll(m0); W0C[8 + g] = __popcll(m1); }
                        } }
                    __syncthreads();
                    if (tid < 128) { const int t = ch * 128 + tid;
                        if (tid >= 64) { p0 += W0C[e0]; p1 += W0C[e1]; }
                        const int s0 = BASE[e0] + PRE[e0] + p0, s1 = BASE[e1] + PRE[e1] + p1;
                        P_slot_tok[s0] = t; P_slot_w[s0] = P_tok_w[2 * t] * (1.0f / (pg8::F8S_ACT * pg8::F8S_WDN)); P_slot_tok[s1] = t; P_slot_w[s1] = P_tok_w[2 * t + 1] * (1.0f / (pg8::F8S_ACT * pg8::F8S_WDN)); }
                    __syncthreads();
                }
            }
            SEAM(pb + 7);
            LAS int* tg = (LAS int*)(lds + TG_OFF);
            if (IN(pb + 8) || IN(pb + 9) || IN(pb + 10) || IN(pb + 11)) {
                PHASE_TID;
                if (tid < 288) { const int r = tid * 256; int g = 0; int gb[16];
#pragma unroll
                    for (int q = 0; q < 16; ++q) gb[q] = P_gbases[q];
#pragma unroll
                    for (int q = 1; q < 16; ++q) if (r >= gb[q]) g = q;
                    tg[tid] = g; }
                __syncthreads();
            }
            if (IN(pb + 8)) REPFOR(10) {
                REPBAR;
                const int nT = __builtin_amdgcn_readfirstlane(P_gbases[16] >> 8);
                pg8::Gemm g{(const char*)P_XN, D / 2, D / 2}; pg8::SchedMoe1 S{nT, G, bx, (const char*)P_Wb + WOFF_MGU, P_slot_tok, tg};
                pg8::EpiSwi8<true> E{(unsigned char*)P_Z, DFE};
                pg8::gemm_phase<pg8::EpiSwi8<true>, pg8::SchedMoe1, true, true>(lds, g, S, E, wave);
            }
            SEAM(pb + 8);
            if (IN(pb + 9)) {
                const int t0 = 0, nT = 128;
                pg8::Gemm g{(const char*)P_Z, DFE / 2, DFE / 2}; pg8::SchedMoe2 S{t0, nT, G, bx, (const char*)P_Wb + WOFF_MDN, tg};
                pg8::EpiMoeDown<true> E{P_slot_tok, P_slot_w, P_out, P_HS};
                pg8::gemm_phase<pg8::EpiMoeDown<true>, pg8::SchedMoe2, true, true>(lds, g, S, E, wave);
            }
            SEAM(pb + 9);
            if (IN(pb + 10)) {
                const int t0 = __builtin_amdgcn_readfirstlane(P_gbases[8] >> 8), nT = 128;
                {
                    PHASE_TID; const int t2 = __builtin_amdgcn_readfirstlane(P_gbases[16] >> 8);
                    for (int s_ = (t0 + 128) * 256 + gw; s_ < t2 * 256; s_ += NGW) { const int tok = __builtin_amdgcn_readfirstlane(P_slot_tok[s_]);
                        if (tok >= 0) {
#pragma unroll
                            for (int j = 0; j < 4; ++j) { const u32x2 h2 = ((const u32x2*)(P_HS + (size_t)tok * D))[lane + 64 * j];
                                ((f32x4*)(P_out + (size_t)tok * D))[lane + 64 * j] = (f32x4){__uint_as_float(h2.x << 16), __uint_as_float(h2.x & 0xffff0000u), __uint_as_float(h2.y << 16), __uint_as_float(h2.y & 0xffff0000u)}; } } }
                }
                pg8::Gemm g{(const char*)P_Z, DFE / 2, DFE / 2}; pg8::SchedMoe2 S{t0, nT, G, bx, (const char*)P_Wb + WOFF_MDN, tg};
                pg8::EpiMoeDown<false> E{P_slot_tok, P_slot_w, P_out, P_HS};
                pg8::gemm_phase<pg8::EpiMoeDown<false>, pg8::SchedMoe2, true, true>(lds, g, S, E, wave);
            }
            SEAM(pb + 10);
            if (IN(pb + 11)) {
                const int t1 = __builtin_amdgcn_readfirstlane(P_gbases[8] >> 8), s0 = t1 - 128, s1 = __builtin_amdgcn_readfirstlane(P_gbases[16] >> 8) - t1 - 128;
                pg8::Gemm g{(const char*)P_Z, DFE / 2, DFE / 2}; pg8::SchedMoe3 S{s0, s1, t1, G, bx, (const char*)P_Wb + WOFF_MDN, tg};
                pg8::EpiMoeDownAtomic E{P_slot_tok, P_slot_w, P_out};
                pg8::gemm_phase<pg8::EpiMoeDownAtomic, pg8::SchedMoe3, true, true>(lds, g, S, E, wave);
            }
        }
    }
#undef IN
#undef SEAM
#undef REPFOR
#undef REPBAR
#undef PHASE_TID
}

static void launch_mega(const Args& base, int lo, int hi, int grid, unsigned char* ws, hipStream_t stream) {
    Args a = base; a.ph_lo = lo; a.ph_hi = hi;
    (void)hipMemsetAsync(ws + WS_CTL, 0, CTL_ZERO_BYTES, stream);
    hipLaunchKernelGGL(mega, dim3(grid), dim3(NWAVES * 64), LDS_BYTES, stream, a);
}

extern "C" void kernel_launch(void* const* d_in, const int* in_sizes, int n_in, void* d_out, int out_size, void* d_ws, size_t ws_size, hipStream_t stream) {
    float* out = (float*)d_out;
    unsigned char* ws = (unsigned char*)d_ws;

    static int grid = 0;
    if (grid == 0) {
        if (n_in != 25 || ws_size < WS_END) { fprintf(stderr, "kernel_launch: n_in %d ws %zu (need %zu)\n", n_in, ws_size, (size_t)WS_END); grid = -1; return; }
        int dev = 0, cus = 0, per_cu = 0;
        if (hipGetDevice(&dev) != hipSuccess || hipDeviceGetAttribute(&cus, hipDeviceAttributeMultiprocessorCount, dev) != hipSuccess) { grid = -1; return; }
        if (hipFuncSetAttribute((const void*)mega, hipFuncAttributeMaxDynamicSharedMemorySize, LDS_BYTES) != hipSuccess) { fprintf(stderr, "hipFuncSetAttribute failed\n"); grid = -1; return; }
        if (hipOccupancyMaxActiveBlocksPerMultiprocessor(&per_cu, (const void*)mega, NWAVES * 64, LDS_BYTES) != hipSuccess || per_cu < 1) { fprintf(stderr, "occupancy query: %d\n", per_cu); }
        (void)hipGetLastError();
        grid = cus;
    }
    if (grid < 0) return;
    Args base{};
    for (int i = 0; i < 25; ++i) base.in[i] = (const float*)d_in[i];
    base.out = out; base.ws = ws;

    launch_mega(base, 0, 29, grid, ws, stream);
}
```

```cpp
#include <hip/hip_runtime.h>
#include <stdint.h>
#include <stdio.h>

typedef unsigned short bf16_t;
constexpr int T = 32768, D = 1024, SEQ = 2048;
constexpr int INC = 7168;
constexpr int ZP = 3072;
constexpr int OFF_POOL = 0, OFF_CONV = 256, OFF_SGU = 1024, OFF_ATTN = 1536, OFF_GATE = 3072;
constexpr int DFF = 2816, DFE = 3584, NE = 8;
constexpr int YW = 1280;
constexpr float EPS = 1e-6f;

__device__ __forceinline__ float bf2f(bf16_t v) { return __uint_as_float((unsigned)v << 16); }
__device__ __forceinline__ bf16_t f2bf(float f) { unsigned u = __float_as_uint(f); return (bf16_t)((u + 0x7fffu + ((u >> 16) & 1u)) >> 16); }
template <int CTRL> __device__ __forceinline__ float dpp_(float x) { return __builtin_bit_cast(float, __builtin_amdgcn_mov_dpp(__builtin_bit_cast(int, x), CTRL, 0xf, 0xf, true)); }
__device__ __forceinline__ float sum_xor16(float x) { auto s_ = __builtin_amdgcn_permlane16_swap(__float_as_uint(x), __float_as_uint(x), false, false); return __uint_as_float(s_[0]) + __uint_as_float(s_[1]); }
__device__ __forceinline__ float sum_xor32(float x) { auto s_ = __builtin_amdgcn_permlane32_swap(__float_as_uint(x), __float_as_uint(x), false, false); return __uint_as_float(s_[0]) + __uint_as_float(s_[1]); }
__device__ __forceinline__ float max_xor16(float x) { auto s_ = __builtin_amdgcn_permlane16_swap(__float_as_uint(x), __float_as_uint(x), false, false); return fmaxf(__uint_as_float(s_[0]), __uint_as_float(s_[1])); }
__device__ __forceinline__ float max_xor32(float x) { auto s_ = __builtin_amdgcn_permlane32_swap(__float_as_uint(x), __float_as_uint(x), false, false); return fmaxf(__uint_as_float(s_[0]), __uint_as_float(s_[1])); }
__device__ __forceinline__ float quad_sum(float v) { v += dpp_<0xB1>(v); v += dpp_<0x4E>(v); return v; }
__device__ __forceinline__ float wave_sum(float v) {
    v += dpp_<0xB1>(v); v += dpp_<0x4E>(v); v += dpp_<0x141>(v); v += dpp_<0x128>(v);
    return sum_xor32(sum_xor16(v));
}
__device__ __forceinline__ float wave_max(float v) {
    v = fmaxf(v, dpp_<0xB1>(v)); v = fmaxf(v, dpp_<0x4E>(v)); v = fmaxf(v, dpp_<0x141>(v)); v = fmaxf(v, dpp_<0x128>(v));
    return max_xor32(max_xor16(v));
}

__device__ __forceinline__ int rel_bucket(int rel) {
    const int n = rel < 0 ? -rel : rel; int v;
    if (n < 8) v = n; else if (n < 12) v = 8; else if (n < 16) v = 9; else if (n < 23) v = 10; else if (n < 32) v = 11; else if (n < 46) v = 12; else if (n < 64) v = 13; else if (n < 91) v = 14; else v = 15;
    return (rel > 0 ? 16 : 0) + v;
}


#define GAS __attribute__((address_space(1)))
#define LAS __attribute__((address_space(3)))
typedef float f32x4 __attribute__((ext_vector_type(4)));
typedef float f32x2 __attribute__((ext_vector_type(2)));
typedef short bf16x8 __attribute__((ext_vector_type(8)));
typedef unsigned u32x4 __attribute__((ext_vector_type(4)));
typedef unsigned u32x2 __attribute__((ext_vector_type(2)));
typedef int i32x4 __attribute__((ext_vector_type(4)));
typedef int i32x8 __attribute__((ext_vector_type(8)));

constexpr int NWAVES = 8;
constexpr size_t MiB = 1u << 20;
constexpr size_t WS_CTL = 0, CTL_ZERO_BYTES = 64 * 1024;
constexpr size_t WS_CNT = 64 * 1024;
constexpr size_t WS_TOKE = 128 * 1024;
constexpr size_t WS_TOKW = WS_TOKE + 256 * 1024;
constexpr size_t WS_SLOTT = WS_TOKW + 256 * 1024;
constexpr size_t WS_SLOTW = WS_SLOTT + 320 * 1024;
constexpr size_t WS_W = 4 * MiB;
constexpr size_t WOFF_IN = 0;
constexpr size_t WOFF_MRG = WOFF_IN + 2ull * 7168 * 1024 * 2;
constexpr size_t WOFF_OUT = WOFF_MRG + 2ull * 1024 * 1280 * 2;
constexpr size_t WOFF_FGU = WOFF_OUT + 2ull * 1024 * 1024 * 2;
constexpr size_t WOFF_FDN = WOFF_FGU + 5632ull * 1024 * 2;
constexpr size_t WOFF_MGU = WOFF_FDN + 1024ull * 2816 * 2;
constexpr size_t WOFF_XN8 = WOFF_MGU + 56 * MiB;
constexpr size_t WOFF_IN8 = WOFF_MGU + 88 * MiB;
constexpr size_t WOFF_MDN = WOFF_MGU + 8ull * 7168 * 1024 * 2;
constexpr size_t WOFF_SGU = WOFF_MDN + 8ull * 1024 * 3584 * 2;
constexpr size_t WOFF_POOL = WOFF_SGU + 2ull * 4 * 128 * 128 * 2;
constexpr size_t W_BYTES = WOFF_POOL + 2ull * 4 * 64 * 64 * 2;
static_assert(W_BYTES <= 222 * MiB, "weights");
constexpr size_t WS_XN = WS_W + 222 * MiB;
constexpr size_t WS_Z = WS_XN + 64 * MiB;
constexpr size_t WS_G = WS_Z + 192 * MiB;
constexpr size_t WS_Y = WS_Z + 448 * MiB;
constexpr size_t WS_HS = WS_Y + 80 * MiB;
constexpr size_t WS_END = WS_HS + 64 * MiB;
constexpr int SLOT_CAP = 69632;

constexpr int CW_BAR = 1024;
constexpr int RING_BYTES = 131072;
constexpr int MISC_OFF = RING_BYTES + 12288;
constexpr int TG_OFF = MISC_OFF + 256;
constexpr int LDS_BYTES = 151552;

#define XB_TMO      128
#define XB_XCNT(j)  (256  + 64 * (j))
#define XB_XSUB(j)  (1280 + 64 * (j))
#define XB_XGEN(j)  (2304 + 64 * (j))
#define XB_TOP      3328
#define XB_TOPGEN   3392
#define XCD_BAR_WORDS 3456
#define XB_SPIN_CAP (1u << 22)
__device__ __forceinline__ unsigned xb_ld(unsigned* p)              { return __hip_atomic_load(p, __ATOMIC_RELAXED, __HIP_MEMORY_SCOPE_AGENT); }
__device__ __forceinline__ unsigned xb_add(unsigned* p, unsigned v) { return __hip_atomic_fetch_add(p, v, __ATOMIC_RELAXED, __HIP_MEMORY_SCOPE_AGENT); }
__device__ __forceinline__ unsigned xb_xcc_id() { return (unsigned)__builtin_amdgcn_s_getreg((3 << 11) | 20) & 0xFu; }
#define XB_SPIN(cond, bar) do { unsigned _sp = 0; while (cond) { __builtin_amdgcn_s_sleep(1); \
    if ((++_sp & 255u) == 0u) { if (xb_ld(&(bar)[XB_TMO])) break; if (_sp > XB_SPIN_CAP) { atomicAdd(&(bar)[XB_TMO], 1u); break; } } } } while (0)
__device__ __forceinline__ int lane_id() { unsigned m = ~0u; asm volatile("" : "+s"(m)); return (int)__builtin_amdgcn_mbcnt_hi(m, __builtin_amdgcn_mbcnt_lo(m, 0u)); }
struct XcdBarrier { unsigned* bar; unsigned x; volatile LAS unsigned* st; int wave; };
__device__ __forceinline__ XcdBarrier xcd_barrier_post(unsigned* bar, volatile LAS unsigned* st, int wave) {
    XcdBarrier b; b.bar = bar; b.x = xb_xcc_id(); b.st = st; b.wave = wave;
    if (threadIdx.x == 0) (void)xb_add(&bar[XB_XCNT(b.x)], 1u);
    return b;
}
__device__ __forceinline__ void xcd_barrier_complete(unsigned* bar, unsigned x, unsigned& nloc, unsigned& nx) {
    const unsigned G = gridDim.x * gridDim.y * gridDim.z;
    unsigned sum, cnt, mine, sp = 0u;
    for (;;) {
        sum = 0u; cnt = 0u; mine = 0u;
#pragma unroll
        for (unsigned j = 0; j < 16; ++j) { const unsigned c = xb_ld(&bar[XB_XCNT(j)]); sum += c; cnt += (c > 0u) ? 1u : 0u; mine = (j == x) ? c : mine; }
        if (sum == G) break;
        __builtin_amdgcn_s_sleep(1);
        if ((++sp & 255u) == 0u) { if (xb_ld(&bar[XB_TMO])) break; if (sp > XB_SPIN_CAP) { atomicAdd(&bar[XB_TMO], 1u); break; } }
    }
    nloc = mine > 0u ? mine : 1u; nx = cnt > 0u ? cnt : 1u;
}
__device__ __forceinline__ void xcd_barrier(const XcdBarrier& b) {
    asm volatile("s_waitcnt vmcnt(0)" ::: "memory");
    __syncthreads();
    if (b.wave == 0 && lane_id() == 0) {
        unsigned* bar = b.bar; unsigned bx_ = b.x;
        asm volatile("" : "+s"(bar), "+s"(bx_));
        __builtin_amdgcn_s_waitcnt(0);
        unsigned nloc = b.st[0], nx = b.st[1];
        if (nloc == 0u) { xcd_barrier_complete(bar, bx_, nloc, nx); b.st[0] = nloc; b.st[1] = nx; }
        const unsigned old = xb_add(&bar[XB_XSUB(bx_)], 1u);
        const unsigned gen = old / nloc;
        if (old + 1u == (gen + 1u) * nloc) {
            __builtin_amdgcn_fence(__ATOMIC_RELEASE, "agent");
            asm volatile("s_waitcnt vmcnt(0)" ::: "memory");
            const unsigned og = xb_add(&bar[XB_TOP], 1u);
            const unsigned tg = og / nx;
            if (og + 1u == (tg + 1u) * nx) xb_add(&bar[XB_TOPGEN], 1u);
            else XB_SPIN(xb_ld(&bar[XB_TOPGEN]) == tg, bar);
            __builtin_amdgcn_fence(__ATOMIC_ACQUIRE, "agent");
            xb_add(&bar[XB_XGEN(bx_)], 1u);
            asm volatile("s_waitcnt vmcnt(0)" ::: "memory");
        } else {
            XB_SPIN(xb_ld(&bar[XB_XGEN(bx_)]) == gen, bar);
            __builtin_amdgcn_fence(__ATOMIC_ACQUIRE, "agent");
            asm volatile("s_waitcnt vmcnt(0)" ::: "memory");
        }
    }
    __syncthreads();
}

namespace pg8 {
constexpr int BM = 256, BK = 64, HALF = 128, HTB = HALF * BK * 2, STAGE_BYTES = 8 * HTB, NXCD = 8;
#ifndef WGM_BIG
#define WGM_BIG 2
#endif
#ifndef WGM_SMALL
#define WGM_SMALL 4
#endif
__host__ __device__ __forceinline__ int lds_byte(int r, int c) { const int st = (r >> 4) * 2 + (c >> 5), rr = r & 15, cc = c & 31, ob = rr * 64 + cc * 2; return st * 1024 + (ob ^ (((ob >> 9) & 1) << 5)); }
__host__ __device__ __forceinline__ void stage_rc(int b, int& R, int& C) { const int st = b / 1024, sb = b % 1024, swz = sb ^ (((sb >> 9) & 1) << 5); R = (st >> 1) * 16 + swz / 64; C = (st & 1) * 32 + (swz % 64) / 2; }
__host__ __device__ __forceinline__ int perm32(int rho) { const int n = rho >> 4, i = rho & 15; return 8 * (i >> 2) + 4 * n + (i & 3); }

struct Unit { int pm, pn, kb, nt, idx; const char* B; };
struct Gemm { const char* A; int lda, ldb; };

__device__ __forceinline__ bool static_tile(int nM, int nN, int G, int c, int i, int& pm, int& pn) {
    const int WGM = nN > 4 ? WGM_BIG : WGM_SMALL;
    const int nwg = nM * nN; const long L = (long)i * G + c; if (L >= nwg) return false;
    int wgid = (int)L; { const int q = nwg / NXCD, r = nwg % NXCD, xcd = wgid % NXCD, off = wgid / NXCD; wgid = (xcd < r ? xcd * (q + 1) : r * (q + 1) + (xcd - r) * q) + off; }
    const int nig = WGM * nN, gid = wgid / nig, fm = gid * WGM, gsz = (nM - fm) < WGM ? (nM - fm) : WGM;
    pm = fm + ((wgid % nig) % gsz); pn = (wgid % nig) / gsz; return true;
}
struct SchedPlain {
    static constexpr bool GATHER = false;
    int nM, nN, G, c, nt; const char* B;
    __device__ __forceinline__ bool next(int i, Unit& u) const { if (!static_tile(nM, nN, G, c, i, u.pm, u.pn)) return false; u.kb = 0; u.nt = nt; u.B = B; return true; }
    __device__ __forceinline__ int arow(const Unit& u, int r) const { return u.pm * BM + r; }
};
struct SchedPlainRev {
    static constexpr bool GATHER = false;
    int nM, nN, G, c, nt; const char* B;
    __device__ __forceinline__ bool next(int i, Unit& u) const { if (!static_tile(nM, nN, G, c, i, u.pm, u.pn)) return false; u.pm = nM - 1 - u.pm; u.kb = 0; u.nt = nt; u.B = B; return true; }
    __device__ __forceinline__ int arow(const Unit& u, int r) const { return u.pm * BM + r; }
};
struct SchedPlainOff {
    static constexpr bool GATHER = false;
    int nM, nN, pn0, G, c, nt; const char* B;
    __device__ __forceinline__ bool next(int i, Unit& u) const { if (!static_tile(nM, nN, G, c, i, u.pm, u.pn)) return false; u.pn += pn0; u.kb = 0; u.nt = nt; u.B = B; return true; }
    __device__ __forceinline__ int arow(const Unit& u, int r) const { return u.pm * BM + r; }
};
struct SchedMerge {
    static constexpr bool GATHER = false;
    int nM, nN, G, c; const char* B;
    __device__ __forceinline__ bool next(int i, Unit& u) const { if (!static_tile(nM, nN, G, c, i >> 2, u.pm, u.pn)) return false; const int br = i & 3; u.kb = br * 512; u.nt = br == 3 ? 8 : 4; u.idx = i; u.B = B; return true; }
    __device__ __forceinline__ int arow(const Unit& u, int r) const { return u.pm * BM + r; }
};
struct SchedMoe1 {
    static constexpr bool GATHER = true;
    int nT, G, c; const char* B; const int* slot_tok; const LAS int* tg;
    __device__ __forceinline__ bool next(int i, Unit& u) const { if (!static_tile(nT, 28, G, c, i, u.pm, u.pn)) return false; u.kb = 0; u.nt = 8; u.B = B + (size_t)(__builtin_amdgcn_readfirstlane(tg[u.pm]) & 7) * (7168ull * 1024); return true; }
    __device__ __forceinline__ int arow(const Unit& u, int r) const { const int t = slot_tok[u.pm * BM + r]; return t < 0 ? 0 : t; }
};
struct SchedMoe2 {
    static constexpr bool GATHER = false;
    int t0, nT, G, c; const char* B; const LAS int* tg;
    __device__ __forceinline__ bool next(int i, Unit& u) const { if (!static_tile(nT, 4, G, c, i, u.pm, u.pn)) return false; u.pm = t0 + nT - 1 - u.pm; u.kb = 0; u.nt = 28; u.B = B + (size_t)(__builtin_amdgcn_readfirstlane(tg[u.pm]) & 7) * (1024ull * 3584); return true; }
    __device__ __forceinline__ int arow(const Unit& u, int r) const { return u.pm * BM + r; }
};

struct SchedMoe3 {
    static constexpr bool GATHER = false;
    int s0, s1, t1, G, c; const char* B; const LAS int* tg;
    __device__ __forceinline__ bool next(int i, Unit& u) const { const int L = i * G + c; if (L >= (s0 + s1) * 16) return false; const int kp = L & 3, st = L >> 4;
        u.pn = (L >> 2) & 3; u.pm = st < s0 ? 128 + st : t1 + 128 + (st - s0); u.kb = (kp < 2 ? kp * 8 : 16 + (kp - 2) * 6) * 128; u.nt = kp < 2 ? 8 : 6; u.B = B + (size_t)(__builtin_amdgcn_readfirstlane(tg[u.pm]) & 7) * (1024ull * 3584); return true; }
    __device__ __forceinline__ int arow(const Unit& u, int r) const { return u.pm * BM + r; }
};

__device__ __forceinline__ unsigned cvt_pk_bf16(float lo, float hi) { unsigned r; asm volatile("v_cvt_pk_bf16_f32 %0, %1, %2" : "=v"(r) : "v"(lo), "v"(hi)); return r; }
__device__ __forceinline__ f32x2 gelu_pk(f32x2 v) {
    const f32x2 av = __builtin_elementwise_abs(v), d = av * 0.2316418882f + 1.0f;
    f32x2 t; t.x = __builtin_amdgcn_rcpf(d.x); t.y = __builtin_amdgcn_rcpf(d.y);
    f32x2 q = t * 0.5307027145f + (-0.7265760135f); q = q * t + 0.7107068705f; q = q * t + (-0.142248368f); q = q * t + 0.127414796f; q = q * t;
    const f32x2 s = (v * v) * (-0.72134752044f);
    f32x2 e; e.x = __builtin_amdgcn_exp2f(s.x); e.y = __builtin_amdgcn_exp2f(s.y);
    const f32x2 m = v * (q * e), r = v - m;
    f32x2 o; o.x = v.x < 0.f ? m.x : r.x; o.y = v.y < 0.f ? m.y : r.y; return o;
}
__device__ __forceinline__ void swiglu8(const f32x4 G0, const f32x4 G1, const f32x4 U0, const f32x4 U1, float negl, float c2, f32x4& v0, f32x4& v1) {
    const f32x4 a0 = G0 * negl, a1 = G1 * negl;
    f32x4 e0, e1;
#pragma unroll
    for (int j = 0; j < 4; ++j) { e0[j] = __builtin_amdgcn_exp2f(a0[j]); e1[j] = __builtin_amdgcn_exp2f(a1[j]); }
    const f32x4 p0 = (G0 * U0) * c2, p1 = (G1 * U1) * c2;
    const f32x4 d0 = e0 + 1.0f, d1 = e1 + 1.0f;
    f32x4 r0, r1;
#pragma unroll
    for (int j = 0; j < 4; ++j) { r0[j] = __builtin_amdgcn_rcpf(d0[j]); r1[j] = __builtin_amdgcn_rcpf(d1[j]); }
    v0 = p0 * r0; v1 = p1 * r1;
}
__device__ __forceinline__ void sigm8(f32x4& v0, f32x4& v1, float negl) {
    const f32x4 a0 = v0 * negl, a1 = v1 * negl;
    f32x4 e0, e1;
#pragma unroll
    for (int j = 0; j < 4; ++j) { e0[j] = __builtin_amdgcn_exp2f(a0[j]); e1[j] = __builtin_amdgcn_exp2f(a1[j]); }
    const f32x4 d0 = e0 + 1.0f, d1 = e1 + 1.0f;
#pragma unroll
    for (int j = 0; j < 4; ++j) { v0[j] = __builtin_amdgcn_rcpf(d0[j]); v1[j] = __builtin_amdgcn_rcpf(d1[j]); }
}
__device__ __forceinline__ float sigm(float v) { return __builtin_amdgcn_rcpf(1.0f + __builtin_amdgcn_exp2f(-1.44269504089f * v)); }

template <bool IN8>
struct EpiZ {
    static constexpr bool PERM = true, CHAIN = false;
    bf16_t* Z; bf16_t* Gt; const float* qg; const float* kg; LAS float* X;
    __device__ __forceinline__ void operator()(const f32x4 (&acc)[2][2][4][2], const Unit& u, int wr, int wc, int fr, int fq) const {
        asm volatile("" : "+v"(fr), "+v"(fq));
        const int row0 = u.pm * BM + wr * 64 + fr, col0 = u.pn * BM + wc * 32 + 8 * fq;
        const int mode = (u.pn >= 12) ? 2 : ((u.pn == 4 || u.pn == 5) ? 1 : ((u.pn >= 6 && u.pn <= 9) ? 3 : 0));
        const unsigned toff = (unsigned)(((wr * 4 + wc) * 64 + fq * 16 + fr) * 16);
        const int gti = u.pn - 12;
        char* gbase = (char*)Gt + (size_t)(((gti >> 2) * 128 + u.pm) * 4 + (gti & 3)) * 131072 + toff;
        float rs[2][4][2];
#pragma unroll
        for (int ai = 0; ai < 2; ++ai)
#pragma unroll
            for (int m = 0; m < 4; ++m) { rs[ai][m][0] = 1.f; rs[ai][m][1] = 1.f; }
        f32x4 g0 = {1.f, 1.f, 1.f, 1.f}, g1 = {1.f, 1.f, 1.f, 1.f};
        if (mode == 3) {
#pragma unroll
            for (int ai = 0; ai < 2; ++ai)
#pragma unroll
                for (int m = 0; m < 4; ++m)
#pragma unroll
                    for (int bj = 0; bj < 2; ++bj) { const f32x4 v0 = acc[ai][bj][m][0], v1 = acc[ai][bj][m][1];
                        float ss = (v0[0] * v0[0] + v0[1] * v0[1]) + (v0[2] * v0[2] + v0[3] * v0[3]) + (v1[0] * v1[0] + v1[1] * v1[1]) + (v1[2] * v1[2] + v1[3] * v1[3]);
                        ss = sum_xor32(sum_xor16(ss));
                        if (fq == 0) X[((ai * 128 + wr * 64 + m * 16 + fr) * 2 + bj) * 4 + wc] = ss;
                        rs[ai][m][bj] = ss; }
            asm volatile("s_waitcnt lgkmcnt(0)\n\ts_barrier" ::: "memory");
#pragma unroll
            for (int ai = 0; ai < 2; ++ai)
#pragma unroll
                for (int m = 0; m < 4; ++m)
#pragma unroll
                    for (int bj = 0; bj < 2; ++bj) rs[ai][m][bj] = rsqrtf((rs[ai][m][bj] + X[((ai * 128 + wr * 64 + m * 16 + fr) * 2 + bj) * 4 + (wc ^ 1)]) * (1.0f / 64.0f) + EPS);
            const float* gp = (u.pn < 8 ? qg : kg) + 32 * (wc & 1) + 8 * fq;
            const float qs_ = u.pn < 8 ? 0.125f * 1.4426950408889634f : 1.0f;
            g0 = *(const f32x4*)gp * qs_; g1 = *(const f32x4*)(gp + 4) * qs_;
            asm volatile("s_waitcnt lgkmcnt(0)\n\ts_barrier" ::: "memory");
        }
#pragma unroll
        for (int ai = 0; ai < 2; ++ai)
#pragma unroll
            for (int m = 0; m < 4; ++m) { bf16_t* rowp = Z + (size_t)(row0 + ai * HALF + m * 16) * ZP + col0;
#pragma unroll
                for (int bj = 0; bj < 2; ++bj) { f32x4 v0 = acc[ai][bj][m][0], v1 = acc[ai][bj][m][1];
                    if (mode == 1) { f32x2 a = gelu_pk((f32x2){v0[0], v0[1]}), b = gelu_pk((f32x2){v0[2], v0[3]}), c = gelu_pk((f32x2){v1[0], v1[1]}), d = gelu_pk((f32x2){v1[2], v1[3]});
                        v0 = (f32x4){a.x, a.y, b.x, b.y}; v1 = (f32x4){c.x, c.y, d.x, d.y}; }
                    else if (mode == 2) sigm8(v0, v1, IN8 ? -1.44269504089f / 1024.0f : -1.44269504089f);
                    else if (mode == 3) { const float r = rs[ai][m][bj]; v0 = v0 * g0 * r; v1 = v1 * g1 * r; }
                    u32x4 w; w.x = cvt_pk_bf16(v0[0], v0[1]); w.y = cvt_pk_bf16(v0[2], v0[3]); w.z = cvt_pk_bf16(v1[0], v1[1]); w.w = cvt_pk_bf16(v1[2], v1[3]);
                    if (mode == 2) *(u32x4*)(gbase + ((ai * 4 + m) * 2 + bj) * 8192) = w; else *(u32x4*)(rowp + bj * HALF) = w; } }
    }
};
__device__ __forceinline__ float sat8(float v) { return __builtin_amdgcn_fmed3f(v, -448.f, 448.f); }
__device__ __forceinline__ unsigned pk4_fp8(float a, float b, float c, float d) { unsigned w = 0; w = __builtin_amdgcn_cvt_pk_fp8_f32(a, b, w, false); w = __builtin_amdgcn_cvt_pk_fp8_f32(c, d, w, true); return w; }
constexpr float F8S_HN = 16.f, F8S_WGU = 64.f, F8S_ACT = 4.f, F8S_WDN = 128.f;
template <bool IN8>
struct EpiSwi8 {
    static constexpr bool PERM = true, CHAIN = false;
    unsigned char* ACT; int ldc;
    __device__ __forceinline__ void operator()(const f32x4 (&acc)[2][2][4][2], const Unit& u, int wr, int wc, int fr, int fq) const {
        asm volatile("" : "+v"(fr), "+v"(fq));
        const int row0 = u.pm * BM + wr * 64 + fr, col0 = u.pn * HALF + wc * 32 + 8 * fq;
        constexpr float US = IN8 ? 1.0f / (F8S_HN * F8S_WGU) : 1.0f;
#pragma unroll
        for (int ai = 0; ai < 2; ++ai)
#pragma unroll
            for (int m = 0; m < 4; ++m) { unsigned char* rowp = ACT + (size_t)(row0 + ai * HALF + m * 16) * ldc + col0;
                f32x4 v0, v1;
                swiglu8(acc[ai][0][m][0], acc[ai][0][m][1], acc[ai][1][m][0], acc[ai][1][m][1], -1.44269504089f * US, US * US * F8S_ACT, v0, v1);
                u32x2 w; w.x = pk4_fp8(sat8(v0[0]), sat8(v0[1]), sat8(v0[2]), sat8(v0[3])); w.y = pk4_fp8(sat8(v1[0]), sat8(v1[1]), sat8(v1[2]), sat8(v1[3]));
                *(u32x2*)rowp = w; }
    }
};
struct EpiSwi {
    static constexpr bool PERM = true, CHAIN = false;
    bf16_t* ACT; int ldc;
    __device__ __forceinline__ void operator()(const f32x4 (&acc)[2][2][4][2], const Unit& u, int wr, int wc, int fr, int fq) const {
        asm volatile("" : "+v"(fr), "+v"(fq));
        const int row0 = u.pm * BM + wr * 64 + fr, col0 = u.pn * HALF + wc * 32 + 8 * fq;
#pragma unroll
        for (int ai = 0; ai < 2; ++ai)
#pragma unroll
            for (int m = 0; m < 4; ++m) { bf16_t* rowp = ACT + (size_t)(row0 + ai * HALF + m * 16) * ldc + col0;
                f32x4 v0, v1;
                swiglu8(acc[ai][0][m][0], acc[ai][0][m][1], acc[ai][1][m][0], acc[ai][1][m][1], -1.44269504089f, 1.0f, v0, v1);
                u32x4 w; w.x = cvt_pk_bf16(v0[0], v0[1]); w.y = cvt_pk_bf16(v0[2], v0[3]); w.z = cvt_pk_bf16(v1[0], v1[1]); w.w = cvt_pk_bf16(v1[2], v1[3]);
                *(u32x4*)rowp = w; }
    }
};
template <bool INBF, bool OUTBF, bool F8ACC = false>
struct EpiResid {
    static constexpr bool PERM = false, CHAIN = false;
    const void* hin; void* out;
    __device__ __forceinline__ void operator()(const f32x4 (&acc)[2][2][4][2], const Unit& u, int wr, int wc, int fr, int fq) const {
        asm volatile("" : "+v"(fr), "+v"(fq));
        const int row0 = u.pm * BM + wr * 64 + fr, col0 = u.pn * BM + wc * 32 + 4 * fq;
        if constexpr (INBF) {
            u32x2 hr[2][4][2][2];
#pragma unroll
            for (int ai = 0; ai < 2; ++ai)
#pragma unroll
                for (int m = 0; m < 4; ++m) { const size_t ro = (size_t)(row0 + ai * HALF + m * 16) * D + col0;
#pragma unroll
                    for (int bj = 0; bj < 2; ++bj)
#pragma unroll
                        for (int n = 0; n < 2; ++n) hr[ai][m][bj][n] = *(const u32x2*)((const bf16_t*)hin + ro + bj * HALF + n * 16); }
            asm volatile("" ::: "memory");
#pragma unroll
            for (int ai = 0; ai < 2; ++ai)
#pragma unroll
                for (int m = 0; m < 4; ++m) { const size_t ro = (size_t)(row0 + ai * HALF + m * 16) * D + col0;
#pragma unroll
                    for (int bj = 0; bj < 2; ++bj)
#pragma unroll
                        for (int n = 0; n < 2; ++n) { const u32x2 h2 = hr[ai][m][bj][n];
                            const f32x4 h = {__uint_as_float(h2.x << 16), __uint_as_float(h2.x & 0xffff0000u), __uint_as_float(h2.y << 16), __uint_as_float(h2.y & 0xffff0000u)};
                            const f32x4 v = F8ACC ? h + acc[ai][bj][m][n] * (1.0f / (F8S_ACT * F8S_WDN)) : h + acc[ai][bj][m][n];
                            if constexpr (OUTBF) { u32x2 hb; hb.x = cvt_pk_bf16(v[0], v[1]); hb.y = cvt_pk_bf16(v[2], v[3]); *(u32x2*)((bf16_t*)out + ro + bj * HALF + n * 16) = hb; }
                            else *(f32x4*)((float*)out + ro + bj * HALF + n * 16) = v; } }
            asm volatile("" ::: "memory");
        } else
#pragma unroll
        for (int ai = 0; ai < 2; ++ai) {
            f32x4 hv[4][2][2];
#pragma unroll
            for (int m = 0; m < 4; ++m) { const size_t ro = (size_t)(row0 + ai * HALF + m * 16) * D + col0;
#pragma unroll
                for (int bj = 0; bj < 2; ++bj)
#pragma unroll
                    for (int n = 0; n < 2; ++n) {
                        if constexpr (INBF) { const u32x2 h2 = *(const u32x2*)((const bf16_t*)hin + ro + bj * HALF + n * 16);
                            hv[m][bj][n] = (f32x4){__uint_as_float(h2.x << 16), __uint_as_float(h2.x & 0xffff0000u), __uint_as_float(h2.y << 16), __uint_as_float(h2.y & 0xffff0000u)}; }
                        else hv[m][bj][n] = *(const f32x4*)((const float*)hin + ro + bj * HALF + n * 16); } }
            asm volatile("" ::: "memory");
#pragma unroll
            for (int m = 0; m < 4; ++m) { const size_t ro = (size_t)(row0 + ai * HALF + m * 16) * D + col0;
#pragma unroll
                for (int bj = 0; bj < 2; ++bj)
#pragma unroll
                    for (int n = 0; n < 2; ++n) { const f32x4 v = F8ACC ? hv[m][bj][n] + acc[ai][bj][m][n] * (1.0f / (F8S_ACT * F8S_WDN)) : hv[m][bj][n] + acc[ai][bj][m][n];
                        if constexpr (OUTBF) { u32x2 hb; hb.x = cvt_pk_bf16(v[0], v[1]); hb.y = cvt_pk_bf16(v[2], v[3]); *(u32x2*)((bf16_t*)out + ro + bj * HALF + n * 16) = hb; }
                        else *(f32x4*)((float*)out + ro + bj * HALF + n * 16) = v; } }
            asm volatile("" ::: "memory");
        }
    }
};
template <bool FIRST>
struct EpiMoeDown {
    static constexpr bool PERM = false, CHAIN = false;
    const int* slot_tok; const float* slot_w; float* out; bf16_t* hs;
    __device__ __forceinline__ void operator()(const f32x4 (&acc)[2][2][4][2], const Unit& u, int wr, int wc, int fr, int fq) const {
        asm volatile("" : "+v"(fr), "+v"(fq));
        const int row0 = u.pm * BM + wr * 64 + fr, col0 = u.pn * BM + wc * 32 + 4 * fq;
        int tk[2][4]; float ww[2][4];
#pragma unroll
        for (int ai = 0; ai < 2; ++ai)
#pragma unroll
            for (int m = 0; m < 4; ++m) { const int slot = row0 + ai * HALF + m * 16; tk[ai][m] = slot_tok[slot]; ww[ai][m] = slot_w[slot]; }
#pragma unroll
        for (int ai = 0; ai < 2; ++ai) {
            u32x2 hr[4][2][2];
#pragma unroll
            for (int m = 0; m < 4; ++m) { const size_t ro = (size_t)(tk[ai][m] < 0 ? 0 : tk[ai][m]) * D + col0;
#pragma unroll
                for (int bj = 0; bj < 2; ++bj)
#pragma unroll
                    for (int n = 0; n < 2; ++n) hr[m][bj][n] = *(const u32x2*)(hs + ro + bj * HALF + n * 16); }
            asm volatile("" ::: "memory");
#pragma unroll
            for (int m = 0; m < 4; ++m) { if (tk[ai][m] >= 0) { const size_t ro = (size_t)tk[ai][m] * D + col0; const float w = ww[ai][m];
#pragma unroll
                for (int bj = 0; bj < 2; ++bj)
#pragma unroll
                    for (int n = 0; n < 2; ++n) { const u32x2 h2 = hr[m][bj][n];
                        const f32x4 h = {__uint_as_float(h2.x << 16), __uint_as_float(h2.x & 0xffff0000u), __uint_as_float(h2.y << 16), __uint_as_float(h2.y & 0xffff0000u)};
                        const f32x4 v = h + acc[ai][bj][m][n] * w;
                        if constexpr (FIRST) { u32x2 hb; hb.x = cvt_pk_bf16(v[0], v[1]); hb.y = cvt_pk_bf16(v[2], v[3]); *(u32x2*)(hs + ro + bj * HALF + n * 16) = hb; }
                        else *(f32x4*)(out + ro + bj * HALF + n * 16) = v; } } }
            asm volatile("" ::: "memory");
        }
    }
};
struct EpiMoeDownAtomic {
    static constexpr bool PERM = false, CHAIN = false;
    const int* slot_tok; const float* slot_w; float* out;
    __device__ __forceinline__ void operator()(const f32x4 (&acc)[2][2][4][2], const Unit& u, int wr, int wc, int fr, int fq) const {
        asm volatile("" : "+v"(fr), "+v"(fq));
        const int row0 = u.pm * BM + wr * 64 + fr, col0 = u.pn * BM + wc * 32 + 4 * fq;
#pragma unroll
        for (int ai = 0; ai < 2; ++ai)
#pragma unroll
            for (int m = 0; m < 4; ++m) { const int slot = row0 + ai * HALF + m * 16; const int tok = slot_tok[slot]; const float w = slot_w[slot];
                if (tok >= 0) { float* ro = out + (size_t)tok * D + col0;
#pragma unroll
                    for (int bj = 0; bj < 2; ++bj)
#pragma unroll
                        for (int n = 0; n < 2; ++n)
#pragma unroll
                            for (int e = 0; e < 4; ++e) __hip_atomic_fetch_add(ro + bj * HALF + n * 16 + e, acc[ai][bj][m][n][e] * w, __ATOMIC_RELAXED, __HIP_MEMORY_SCOPE_AGENT); } }
    }
};
struct EpiMerge {
    static constexpr bool PERM = true, CHAIN = true;
    const bf16_t* Gt; bf16_t* MG;
    __device__ __forceinline__ bool resets(const Unit& u) const { return (u.kb >> 9) == 3; }
    __device__ __forceinline__ void operator()(f32x4 (&acc)[2][2][4][2], const Unit& u, int wr, int wc, int fr, int fq) const {
        asm volatile("" : "+v"(fr), "+v"(fq));
        const unsigned toff = (unsigned)(((wr * 4 + wc) * 64 + fq * 16 + fr) * 16);
        const int br = u.kb >> 9;
        const unsigned moff = (unsigned)((wr * 64 + fr) * D + wc * 32 + 8 * fq) * 2u;
        const char* gt = (const char*)Gt + (size_t)((br * 128 + u.pm) * 4 + u.pn) * 131072 + toff;
        const size_t nxo = br != 3 ? (size_t)128 * 4 * 131072 : 0;
        char* mt = (char*)MG + ((size_t)u.pm * BM * D + u.pn * BM) * 2;
#pragma unroll
        for (int ai = 0; ai < 2; ++ai) {
            u32x4 gv[4][2], nv[4][2];
#pragma unroll
            for (int m = 0; m < 4; ++m)
#pragma unroll
                for (int bj = 0; bj < 2; ++bj) { const size_t o = (size_t)(((ai * 4 + m) * 2 + bj) * 8192);
                    gv[m][bj] = *(const u32x4*)(gt + o); nv[m][bj] = *(const u32x4*)(gt + o + nxo); }
#pragma unroll
            for (int m = 0; m < 4; ++m)
#pragma unroll
                for (int bj = 0; bj < 2; ++bj) {
                    const u32x4 g4 = gv[m][bj], n4 = nv[m][bj];
                    f32x4 ga = {__uint_as_float(g4.x << 16), __uint_as_float(g4.x & 0xffff0000u), __uint_as_float(g4.y << 16), __uint_as_float(g4.y & 0xffff0000u)};
                    f32x4 gb = {__uint_as_float(g4.z << 16), __uint_as_float(g4.z & 0xffff0000u), __uint_as_float(g4.w << 16), __uint_as_float(g4.w & 0xffff0000u)};
#pragma unroll
                    for (int e = 0; e < 4; ++e) { ga[e] = fmaxf(ga[e], 1e-20f); gb[e] = fmaxf(gb[e], 1e-20f); }
                    if (br != 3) {
                        const f32x4 na = {__uint_as_float(n4.x << 16), __uint_as_float(n4.x & 0xffff0000u), __uint_as_float(n4.y << 16), __uint_as_float(n4.y & 0xffff0000u)};
                        const f32x4 nb = {__uint_as_float(n4.z << 16), __uint_as_float(n4.z & 0xffff0000u), __uint_as_float(n4.w << 16), __uint_as_float(n4.w & 0xffff0000u)};
#pragma unroll
                        for (int e = 0; e < 4; ++e) { ga[e] *= __builtin_amdgcn_rcpf(fmaxf(na[e], 1e-20f)); gb[e] *= __builtin_amdgcn_rcpf(fmaxf(nb[e], 1e-20f)); }
                        acc[ai][bj][m][0] *= ga; acc[ai][bj][m][1] *= gb;
                    } else {
                        const f32x4 v0 = acc[ai][bj][m][0] * ga, v1 = acc[ai][bj][m][1] * gb;
                        u32x4 w; w.x = cvt_pk_bf16(v0[0], v0[1]); w.y = cvt_pk_bf16(v0[2], v0[3]); w.z = cvt_pk_bf16(v1[0], v1[1]); w.w = cvt_pk_bf16(v1[2], v1[3]);
                        *(u32x4*)(mt + (size_t)((ai * HALF + m * 16) * D + bj * HALF) * 2 + moff) = w; } }
            asm volatile("" ::: "memory");
        }
    }
};

template <class Sched> __device__ __forceinline__ unsigned a_off(const Sched& S, const Unit& u, int lda, int tid, int h, int i) {
    int R, C; stage_rc(tid * 16 + i * 8192, R, C);
    if constexpr (Sched::GATHER) return (unsigned)(S.arow(u, h * HALF + R) * lda + C) * 2u; else return (unsigned)((h * HALF + R) * lda + C) * 2u;
}
template <class Epi, class Sched, bool ALIGN_EPI, bool F8 = false>
__device__ __forceinline__ void gemm_phase(LAS unsigned char* lds, const Gemm g, const Sched& S, const Epi& E, int wave_) {
    int tid = wave_ * 64 + lane_id(); asm volatile("" : "+v"(tid));
    const int wid = __builtin_amdgcn_readfirstlane(tid >> 6), lane = tid & 63, wr = wid >> 2, wc = wid & 3, fr = lane & 15, fq = lane >> 4;
    unsigned voffB[2];
#pragma unroll
    for (int i = 0; i < 2; ++i) { int R, C; stage_rc(tid * 16 + i * 8192, R, C); const int Rb = Epi::PERM ? ((R & ~31) + perm32(R & 31)) : R; voffB[i] = (unsigned)(Rb * g.ldb + C) * 2u; }
    const size_t kstep = (size_t)(BK * 2);
    const size_t hstepB = (size_t)HALF * g.ldb * 2, tstepB = 2 * hstepB;
    const size_t tstepA = (size_t)BM * g.lda * 2;
    const unsigned ldsw = (unsigned)wid * 1024u;
    const int aoff = lds_byte(wr * 64 + fr, fq * 8), boff = lds_byte(wc * 32 + fr, fq * 8);
#define PG8_SA(b, h) (((b) * 2 + (h)) * HTB)
#define PG8_SB(b, h) ((4 + (b) * 2 + (h)) * HTB)
#define PG8_STAGE2(bufoff, gbase, v0_, v1_) do { \
        __builtin_amdgcn_global_load_lds((const unsigned*)((const char*)(gbase) + (v0_)), (LAS unsigned*)(lds + (bufoff) + ldsw), 16, 0, 0); \
        __builtin_amdgcn_global_load_lds((const unsigned*)((const char*)(gbase) + (v1_)), (LAS unsigned*)(lds + (bufoff) + ldsw + 8192), 16, 0, 0); } while (0)
#define PG8_STAGEB(bufoff, gbase) PG8_STAGE2(bufoff, gbase, voffB[0], voffB[1])
#define PG8_AOFF(u_, h_, i_) a_off<Sched>(S, u_, g.lda, tid, h_, i_)
#define PG8_ABASE(u_) (Sched::GATHER ? g.A + (u_).kb : g.A + (size_t)(u_).pm * tstepA + (u_).kb)
#define PG8_LDA(dst, b, h) do { _Pragma("unroll") for (int m = 0; m < 4; ++m) { \
        if constexpr (F8) { const i32x4 lo_ = *(const LAS i32x4*)(lds + PG8_SA(b, h) + aoff + m * 2048), hi_ = *(const LAS i32x4*)(lds + PG8_SA(b, h) + aoff + m * 2048 + 1024); dst##8[m] = __builtin_shufflevector(lo_, hi_, 0, 1, 2, 3, 4, 5, 6, 7); } \
        else { _Pragma("unroll") for (int k = 0; k < 2; ++k) dst[m][k] = *(const LAS bf16x8*)(lds + PG8_SA(b, h) + aoff + m * 2048 + k * 1024); } } } while (0)
#define PG8_LDB(dst, b, h) do { _Pragma("unroll") for (int n = 0; n < 2; ++n) { \
        if constexpr (F8) { const i32x4 lo_ = *(const LAS i32x4*)(lds + PG8_SB(b, h) + boff + n * 2048), hi_ = *(const LAS i32x4*)(lds + PG8_SB(b, h) + boff + n * 2048 + 1024); dst##8[n] = __builtin_shufflevector(lo_, hi_, 0, 1, 2, 3, 4, 5, 6, 7); } \
        else { _Pragma("unroll") for (int k = 0; k < 2; ++k) dst[n][k] = *(const LAS bf16x8*)(lds + PG8_SB(b, h) + boff + n * 2048 + k * 1024); } } } while (0)
#define PG8_MMA(ai, bj, At, Bt) do { __builtin_amdgcn_s_setprio(1); _Pragma("unroll") for (int m = 0; m < 4; ++m) _Pragma("unroll") for (int n = 0; n < 2; ++n) { \
        if constexpr (F8) asm volatile("v_mfma_f32_16x16x128_f8f6f4 %0, %1, %2, %0" : "+v"(acc[ai][bj][m][n]) : "v"(Bt##8[n]), "v"(At##8[m])); \
        else { _Pragma("unroll") for (int k = 0; k < 2; ++k) acc[ai][bj][m][n] = __builtin_amdgcn_mfma_f32_16x16x32_bf16(Bt[n][k], At[m][k], acc[ai][bj][m][n], 0, 0, 0); } } \
        __builtin_amdgcn_s_setprio(0); } while (0)
#define PG8_WAIT_V(n) asm volatile("s_waitcnt vmcnt(" #n ")" ::: "memory")
#define PG8_WAIT_L(n) asm volatile("s_waitcnt lgkmcnt(" #n ")" ::: "memory")
#define PG8_BAR __builtin_amdgcn_s_barrier()
#define PG8_SCHED __builtin_amdgcn_sched_barrier(0)
    Unit cur, nxt; int ui = 0;
    if (!S.next(0, cur)) return;
    f32x4 acc[2][2][4][2];
#pragma unroll
    for (int a = 0; a < 2; ++a)
#pragma unroll
        for (int b = 0; b < 2; ++b)
#pragma unroll
            for (int m = 0; m < 4; ++m)
#pragma unroll
                for (int n = 0; n < 2; ++n) acc[a][b][m][n] = (f32x4){0.f, 0.f, 0.f, 0.f};
    bf16x8 At[4][2], B0[2][2], B1[2][2];
    i32x8 At8[4], B08[2], B18[2];
    unsigned ca00 = PG8_AOFF(cur, 0, 0), ca01 = PG8_AOFF(cur, 0, 1), ca10 = PG8_AOFF(cur, 1, 0), ca11 = PG8_AOFF(cur, 1, 1);
    const char* cA = PG8_ABASE(cur);
    const char* cB = cur.B + (size_t)cur.pn * tstepB + cur.kb;
    {
        PG8_STAGEB(PG8_SB(0, 0), cB); PG8_STAGEB(PG8_SB(0, 1), cB + hstepB); PG8_STAGE2(PG8_SA(0, 0), cA, ca00, ca01); PG8_STAGE2(PG8_SA(0, 1), cA, ca10, ca11);
        if (wr == 1) PG8_BAR;
        PG8_WAIT_V(2); PG8_BAR;
        PG8_STAGEB(PG8_SB(1, 0), cB + kstep); PG8_STAGE2(PG8_SA(1, 0), cA + kstep, ca00, ca01); PG8_STAGEB(PG8_SB(1, 1), cB + hstepB + kstep);
        PG8_WAIT_V(6); PG8_BAR;
    }
    for (;;) {
        const bool has_next = S.next(ui + 1, nxt);
        const char* nA = cA; const char* nB = cB;
        if (has_next) { nA = PG8_ABASE(nxt); nB = nxt.B + (size_t)nxt.pn * tstepB + nxt.kb; }
        const int nt = cur.nt;
        for (int t = 0; t < nt; t += 2) {
            const bool last = (t == nt - 2);
            const char* a1 = cA + (size_t)(t + 1) * kstep;
            const char* a2 = last ? nA : cA + (size_t)(t + 2) * kstep; const char* b2 = last ? nB : cB + (size_t)(t + 2) * kstep;
            const char* a3 = a2 + kstep; const char* b3 = b2 + kstep;
            unsigned o00 = ca00, o01 = ca01, o10 = ca10, o11 = ca11;
            if constexpr (Sched::GATHER) { if (last && has_next) { o00 = PG8_AOFF(nxt, 0, 0); o01 = PG8_AOFF(nxt, 0, 1); o10 = PG8_AOFF(nxt, 1, 0); o11 = PG8_AOFF(nxt, 1, 1); } }
            PG8_LDB(B0, 0, 0); PG8_LDB(B1, 0, 1); PG8_SCHED; PG8_LDA(At, 0, 0); PG8_STAGE2(PG8_SA(1, 1), a1, ca10, ca11);
            PG8_WAIT_V(8); PG8_WAIT_L(0); PG8_BAR; PG8_MMA(0, 0, At, B0); PG8_MMA(0, 1, At, B1); PG8_BAR; PG8_SCHED;
            PG8_LDA(At, 0, 1); PG8_STAGEB(PG8_SB(0, 0), b2); PG8_STAGEB(PG8_SB(0, 1), b2 + hstepB); PG8_STAGE2(PG8_SA(0, 0), a2, o00, o01);
            PG8_WAIT_V(8); PG8_WAIT_L(0); PG8_BAR; PG8_MMA(1, 0, At, B0); PG8_MMA(1, 1, At, B1); PG8_BAR; PG8_SCHED;
            PG8_LDB(B0, 1, 0); PG8_LDB(B1, 1, 1); PG8_SCHED; PG8_LDA(At, 1, 0); PG8_STAGE2(PG8_SA(0, 1), a2, o10, o11);
            PG8_WAIT_V(8); PG8_WAIT_L(0); PG8_BAR; PG8_MMA(0, 0, At, B0); PG8_MMA(0, 1, At, B1); PG8_BAR; PG8_SCHED;
            PG8_LDA(At, 1, 1); PG8_STAGEB(PG8_SB(1, 0), b3); PG8_STAGEB(PG8_SB(1, 1), b3 + hstepB); PG8_STAGE2(PG8_SA(1, 0), a3, o00, o01);
            PG8_WAIT_V(8); PG8_WAIT_L(0); PG8_BAR; PG8_MMA(1, 0, At, B0); PG8_MMA(1, 1, At, B1); PG8_BAR; PG8_SCHED;
            if constexpr (Sched::GATHER) { if (last) { ca00 = o00; ca01 = o01; ca10 = o10; ca11 = o11; } }
        }
        if constexpr (ALIGN_EPI) { if (wr == 0) PG8_BAR; }
        if constexpr (F8) asm volatile("s_nop 15\n\ts_nop 15" ::: "memory");
        E(acc, cur, wr, wc, fr, fq);
        if (!has_next) break;
        bool zero_acc = true;
        if constexpr (Epi::CHAIN) zero_acc = E.resets(cur);
        if (zero_acc)
#pragma unroll
        for (int a = 0; a < 2; ++a)
#pragma unroll
            for (int b = 0; b < 2; ++b)
#pragma unroll
                for (int m = 0; m < 4; ++m)
#pragma unroll
                    for (int n = 0; n < 2; ++n) acc[a][b][m][n] = (f32x4){0.f, 0.f, 0.f, 0.f};
        cur = nxt; cA = nA; cB = nB; ++ui;
        if constexpr (ALIGN_EPI) { if (wr == 1) PG8_BAR; }
    }
    PG8_WAIT_V(0);
    if constexpr (!ALIGN_EPI) { if (wr == 0) PG8_BAR; }
    PG8_BAR;
#undef PG8_SA
#undef PG8_SB
#undef PG8_STAGE2
#undef PG8_STAGEB
#undef PG8_AOFF
#undef PG8_ABASE
#undef PG8_LDA
#undef PG8_LDB
#undef PG8_MMA
#undef PG8_WAIT_V
#undef PG8_WAIT_L
#undef PG8_BAR
#undef PG8_SCHED
}
}

__device__ __forceinline__ unsigned pk2(float lo, float hi) { return (unsigned)f2bf(lo) | ((unsigned)f2bf(hi) << 16); }

__device__ __forceinline__ void p0_transpose_item(const float* W, int K, int N, bf16_t* WT, int ldk, int koff, int mode, LAS float* scr, int item, int lane) {
    const int nblk = N / 32, kb = item / nblk, nb = item % nblk, k0 = 64 * kb, n0 = 32 * nb;
    float tv[32];
#pragma unroll
    for (int i = 0; i < 32; ++i) { const int kk = 2 * i + (lane >> 5); tv[i] = W[(size_t)(k0 + kk) * N + n0 + (lane & 31)]; }
#pragma unroll
    for (int i = 0; i < 32; ++i) { const int kk = 2 * i + (lane >> 5); scr[kk * 33 + (lane & 31)] = tv[i]; }
    asm volatile("s_waitcnt lgkmcnt(0)" ::: "memory");
    int r0 = n0;
    if (mode == 1) { const int dff = N >> 1, hf = n0 >= dff ? 1 : 0, c = n0 - hf * dff; r0 = (c >> 7) * 256 + hf * 128 + (c & 127); }
    const int c8 = lane & 7;
#pragma unroll
    for (int j = 0; j < 4; ++j) { const int n = (lane >> 3) + 8 * j; const LAS float* s = scr + (8 * c8) * 33 + n;
        u32x4 o; o.x = pk2(s[0 * 33], s[1 * 33]); o.y = pk2(s[2 * 33], s[3 * 33]); o.z = pk2(s[4 * 33], s[5 * 33]); o.w = pk2(s[6 * 33], s[7 * 33]);
        *(u32x4*)(WT + (size_t)(r0 + n) * ldk + koff + k0 + 8 * c8) = o; }
    asm volatile("s_waitcnt lgkmcnt(0)" ::: "memory");
}

__device__ __forceinline__ void p0_transpose_item_f8(const float* W, int K, int N, unsigned char* WT8, int ldk, int mode, float sc, LAS float* scr, int item, int lane) {
    const int nblk = N / 32, kb = item / nblk, nb = item % nblk, k0 = 64 * kb, n0 = 32 * nb;
    float tv[32];
#pragma unroll
    for (int i = 0; i < 32; ++i) { const int kk = 2 * i + (lane >> 5); tv[i] = W[(size_t)(k0 + kk) * N + n0 + (lane & 31)]; }
#pragma unroll
    for (int i = 0; i < 32; ++i) { const int kk = 2 * i + (lane >> 5); scr[kk * 33 + (lane & 31)] = tv[i] * sc; }
    asm volatile("s_waitcnt lgkmcnt(0)" ::: "memory");
    int r0 = n0;
    if (mode == 1) { const int dff = N >> 1, hf = n0 >= dff ? 1 : 0, c = n0 - hf * dff; r0 = (c >> 7) * 256 + hf * 128 + (c & 127); }
    const int c8 = lane & 7;
#pragma unroll
    for (int j = 0; j < 4; ++j) { const int n = (lane >> 3) + 8 * j; const LAS float* s = scr + (8 * c8) * 33 + n;
        u32x2 o; o.x = pg8::pk4_fp8(pg8::sat8(s[0 * 33]), pg8::sat8(s[1 * 33]), pg8::sat8(s[2 * 33]), pg8::sat8(s[3 * 33])); o.y = pg8::pk4_fp8(pg8::sat8(s[4 * 33]), pg8::sat8(s[5 * 33]), pg8::sat8(s[6 * 33]), pg8::sat8(s[7 * 33]));
        *(u32x2*)(WT8 + (size_t)(r0 + n) * ldk + k0 + 8 * c8) = o; }
    asm volatile("s_waitcnt lgkmcnt(0)" ::: "memory");
}

struct Args {
    const float* in[25]; float* out; unsigned char* ws;
    int ph_lo, ph_hi;
};

template <bool O8>
__device__ __forceinline__ void rms_row(const float* __restrict__ xrow, const float* __restrict__ g, bf16_t* __restrict__ orow, unsigned char* __restrict__ o8row, int lane) {
    const f32x4* p = (const f32x4*)xrow;
    f32x4 v[4]; float ss = 0.f;
#pragma unroll
    for (int j = 0; j < 4; ++j) { v[j] = p[lane + 64 * j]; ss += (v[j].x * v[j].x + v[j].y * v[j].y) + (v[j].z * v[j].z + v[j].w * v[j].w); }
    ss = wave_sum(ss);
    const float r = rsqrtf(ss * (1.0f / D) + EPS);
    u32x2* op = (u32x2*)orow;
#pragma unroll
    for (int j = 0; j < 4; ++j) { const f32x4 gg = ((const f32x4*)g)[lane + 64 * j]; const float y0 = v[j].x * r * gg.x, y1 = v[j].y * r * gg.y, y2 = v[j].z * r * gg.z, y3 = v[j].w * r * gg.w;
        u32x2 w; w.x = pk2(y0, y1); w.y = pk2(y2, y3); op[lane + 64 * j] = w;
        if constexpr (O8) ((unsigned*)o8row)[lane + 64 * j] = pg8::pk4_fp8(pg8::sat8(y0 * pg8::F8S_HN), pg8::sat8(y1 * pg8::F8S_HN), pg8::sat8(y2 * pg8::F8S_HN), pg8::sat8(y3 * pg8::F8S_HN)); }
}


template <bool O8>
__device__ __forceinline__ void rms_rows4(const float* __restrict__ x, int row, int st, const float* __restrict__ g, bf16_t* __restrict__ o, unsigned char* __restrict__ o8, int lane) {
    f32x4 v[4][4];
#pragma unroll
    for (int i = 0; i < 4; ++i)
#pragma unroll
        for (int j = 0; j < 4; ++j) v[i][j] = ((const f32x4*)(x + (size_t)(row + i * st) * D))[lane + 64 * j];
    f32x4 gg[4];
#pragma unroll
    for (int j = 0; j < 4; ++j) gg[j] = ((const f32x4*)g)[lane + 64 * j];
    float ss[4];
#pragma unroll
    for (int i = 0; i < 4; ++i) { ss[i] = 0.f;
#pragma unroll
        for (int j = 0; j < 4; ++j) ss[i] += (v[i][j].x * v[i][j].x + v[i][j].y * v[i][j].y) + (v[i][j].z * v[i][j].z + v[i][j].w * v[i][j].w); }
#pragma unroll
    for (int i = 0; i < 4; ++i) ss[i] = wave_sum(ss[i]);
    float eps_ = EPS; asm volatile("" : "+v"(eps_));
#pragma unroll
    for (int i = 0; i < 4; ++i) { const float r = rsqrtf(ss[i] * (1.0f / D) + eps_); u32x2* op = (u32x2*)(o + (size_t)(row + i * st) * D);
#pragma unroll
        for (int j = 0; j < 4; ++j) { const float y0 = v[i][j].x * r * gg[j].x, y1 = v[i][j].y * r * gg[j].y, y2 = v[i][j].z * r * gg[j].z, y3 = v[i][j].w * r * gg[j].w;
            u32x2 w; w.x = pk2(y0, y1); w.y = pk2(y2, y3); op[lane + 64 * j] = w;
            if constexpr (O8) ((unsigned*)(o8 + (size_t)(row + i * st) * D))[lane + 64 * j] = pg8::pk4_fp8(pg8::sat8(y0 * pg8::F8S_HN), pg8::sat8(y1 * pg8::F8S_HN), pg8::sat8(y2 * pg8::F8S_HN), pg8::sat8(y3 * pg8::F8S_HN)); } }
}

__device__ __forceinline__ void bf8_to_f32(const u32x4 a, float (&v)[8]) {
    v[0] = __uint_as_float(a.x << 16); v[1] = __uint_as_float(a.x & 0xffff0000u); v[2] = __uint_as_float(a.y << 16); v[3] = __uint_as_float(a.y & 0xffff0000u);
    v[4] = __uint_as_float(a.z << 16); v[5] = __uint_as_float(a.z & 0xffff0000u); v[6] = __uint_as_float(a.w << 16); v[7] = __uint_as_float(a.w & 0xffff0000u);
}
template <bool O8>
__device__ __forceinline__ void rms_row_bf(const bf16_t* __restrict__ xrow, const float* __restrict__ g, bf16_t* __restrict__ orow, unsigned char* __restrict__ o8row, int lane) {
    float v[2][8]; float ss = 0.f;
#pragma unroll
    for (int j = 0; j < 2; ++j) { bf8_to_f32(((const u32x4*)xrow)[lane + 64 * j], v[j]);
#pragma unroll
        for (int e = 0; e < 8; ++e) ss += v[j][e] * v[j][e]; }
    ss = wave_sum(ss);
    const float r = rsqrtf(ss * (1.0f / D) + EPS);
#pragma unroll
    for (int j = 0; j < 2; ++j) { const f32x4 ga = ((const f32x4*)g)[2 * (lane + 64 * j)], gb = ((const f32x4*)g)[2 * (lane + 64 * j) + 1];
        const float y0 = v[j][0] * r * ga.x, y1 = v[j][1] * r * ga.y, y2 = v[j][2] * r * ga.z, y3 = v[j][3] * r * ga.w, y4 = v[j][4] * r * gb.x, y5 = v[j][5] * r * gb.y, y6 = v[j][6] * r * gb.z, y7 = v[j][7] * r * gb.w;
        u32x4 w; w.x = pk2(y0, y1); w.y = pk2(y2, y3); w.z = pk2(y4, y5); w.w = pk2(y6, y7);
        ((u32x4*)orow)[lane + 64 * j] = w;
        if constexpr (O8) { u32x2 w8; w8.x = pg8::pk4_fp8(pg8::sat8(y0 * pg8::F8S_HN), pg8::sat8(y1 * pg8::F8S_HN), pg8::sat8(y2 * pg8::F8S_HN), pg8::sat8(y3 * pg8::F8S_HN)); w8.y = pg8::pk4_fp8(pg8::sat8(y4 * pg8::F8S_HN), pg8::sat8(y5 * pg8::F8S_HN), pg8::sat8(y6 * pg8::F8S_HN), pg8::sat8(y7 * pg8::F8S_HN)); ((u32x2*)o8row)[lane + 64 * j] = w8; } }
}
template <bool O8>
__device__ __forceinline__ void rms_rows4_bf(const bf16_t* __restrict__ x, int row, int st, const float* __restrict__ g, bf16_t* __restrict__ o, unsigned char* __restrict__ o8, int lane) {
    u32x4 raw[4][2];
#pragma unroll
    for (int i = 0; i < 4; ++i)
#pragma unroll
        for (int j = 0; j < 2; ++j) raw[i][j] = ((const u32x4*)(x + (size_t)(row + i * st) * D))[lane + 64 * j];
    f32x4 gg[2][2];
#pragma unroll
    for (int j = 0; j < 2; ++j) { gg[j][0] = ((const f32x4*)g)[2 * (lane + 64 * j)]; gg[j][1] = ((const f32x4*)g)[2 * (lane + 64 * j) + 1]; }
    float eps_ = EPS; asm volatile("" : "+v"(eps_));
#pragma unroll
    for (int i = 0; i < 4; ++i) { float v[2][8]; float ss = 0.f;
#pragma unroll
        for (int j = 0; j < 2; ++j) { bf8_to_f32(raw[i][j], v[j]);
#pragma unroll
            for (int e = 0; e < 8; ++e) ss += v[j][e] * v[j][e]; }
        ss = wave_sum(ss);
        const float r = rsqrtf(ss * (1.0f / D) + eps_);
#pragma unroll
        for (int j = 0; j < 2; ++j) { const f32x4 ga = gg[j][0], gb = gg[j][1];
            const float y0 = v[j][0] * r * ga.x, y1 = v[j][1] * r * ga.y, y2 = v[j][2] * r * ga.z, y3 = v[j][3] * r * ga.w, y4 = v[j][4] * r * gb.x, y5 = v[j][5] * r * gb.y, y6 = v[j][6] * r * gb.z, y7 = v[j][7] * r * gb.w;
            u32x4 w; w.x = pk2(y0, y1); w.y = pk2(y2, y3); w.z = pk2(y4, y5); w.w = pk2(y6, y7);
            ((u32x4*)(o + (size_t)(row + i * st) * D))[lane + 64 * j] = w;
            if constexpr (O8) { u32x2 w8; w8.x = pg8::pk4_fp8(pg8::sat8(y0 * pg8::F8S_HN), pg8::sat8(y1 * pg8::F8S_HN), pg8::sat8(y2 * pg8::F8S_HN), pg8::sat8(y3 * pg8::F8S_HN)); w8.y = pg8::pk4_fp8(pg8::sat8(y4 * pg8::F8S_HN), pg8::sat8(y5 * pg8::F8S_HN), pg8::sat8(y6 * pg8::F8S_HN), pg8::sat8(y7 * pg8::F8S_HN)); ((u32x2*)(o8 + (size_t)(row + i * st) * D))[lane + 64 * j] = w8; } } }
}

__device__ __forceinline__ void qknorm_row(bf16_t* __restrict__ Z, int t, const float* __restrict__ qg, const float* __restrict__ kg, int lane) {
    bf16_t* p = Z + (size_t)t * ZP + OFF_ATTN + lane * 16;
    const u32x4 a = *(const u32x4*)p, b = *(const u32x4*)(p + 8);
    float v[16];
    v[0] = __uint_as_float(a.x << 16); v[1] = __uint_as_float(a.x & 0xffff0000u); v[2] = __uint_as_float(a.y << 16); v[3] = __uint_as_float(a.y & 0xffff0000u);
    v[4] = __uint_as_float(a.z << 16); v[5] = __uint_as_float(a.z & 0xffff0000u); v[6] = __uint_as_float(a.w << 16); v[7] = __uint_as_float(a.w & 0xffff0000u);
    v[8] = __uint_as_float(b.x << 16); v[9] = __uint_as_float(b.x & 0xffff0000u); v[10] = __uint_as_float(b.y << 16); v[11] = __uint_as_float(b.y & 0xffff0000u);
    v[12] = __uint_as_float(b.z << 16); v[13] = __uint_as_float(b.z & 0xffff0000u); v[14] = __uint_as_float(b.w << 16); v[15] = __uint_as_float(b.w & 0xffff0000u);
    float ss = 0.f;
#pragma unroll
    for (int i = 0; i < 16; ++i) ss += v[i] * v[i];
    ss = quad_sum(ss);
    const float r = rsqrtf(ss * (1.0f / 64.0f) + EPS);
    const float* g = (lane < 32 ? qg : kg) + (lane & 3) * 16;
    unsigned o[8];
#pragma unroll
    for (int i = 0; i < 8; ++i) o[i] = pk2(v[2 * i] * r * g[2 * i], v[2 * i + 1] * r * g[2 * i + 1]);
    *(u32x4*)p = (u32x4){o[0], o[1], o[2], o[3]}; *(u32x4*)(p + 8) = (u32x4){o[4], o[5], o[6], o[7]};
}

__device__ __forceinline__ void conv_row(const bf16_t* __restrict__ Z, int t, const float* __restrict__ cw, bf16_t* __restrict__ Y, int lane) {
    const int s = t & (SEQ - 1), c = lane * 4;
    float y0 = 0.f, y1 = 0.f, y2 = 0.f, y3 = 0.f;
#pragma unroll
    for (int j = 0; j < 3; ++j) {
        if (s - 2 + j >= 0) { const bf16_t* zr = Z + (size_t)(t - 2 + j) * ZP + OFF_CONV;
            const u32x2 cg = *(const u32x2*)(zr + 256 + c), hh = *(const u32x2*)(zr + 512 + c); const f32x4 w = *(const f32x4*)(cw + j * 256 + c);
            y0 += w.x * __uint_as_float(cg.x << 16) * __uint_as_float(hh.x << 16); y1 += w.y * __uint_as_float(cg.x & 0xffff0000u) * __uint_as_float(hh.x & 0xffff0000u);
            y2 += w.z * __uint_as_float(cg.y << 16) * __uint_as_float(hh.y << 16); y3 += w.w * __uint_as_float(cg.y & 0xffff0000u) * __uint_as_float(hh.y & 0xffff0000u); }
    }
    const u32x2 bg = *(const u32x2*)(Z + (size_t)t * ZP + OFF_CONV + c);
    u32x2 o; o.x = pk2(__uint_as_float(bg.x << 16) * y0, __uint_as_float(bg.x & 0xffff0000u) * y1); o.y = pk2(__uint_as_float(bg.y << 16) * y2, __uint_as_float(bg.y & 0xffff0000u) * y3);
    *(u32x2*)(Y + (size_t)t * YW + 256 + c) = o;
}


__device__ __forceinline__ void qknorm_rows4(bf16_t* __restrict__ Z, int t, int st, const float* __restrict__ qg, const float* __restrict__ kg, int lane) {
    u32x4 a[4], b[4];
#pragma unroll
    for (int i = 0; i < 4; ++i) { const bf16_t* p = Z + (size_t)(t + i * st) * ZP + OFF_ATTN + lane * 16; a[i] = *(const u32x4*)p; b[i] = *(const u32x4*)(p + 8); }
    const float* g = (lane < 32 ? qg : kg) + (lane & 3) * 16;
    const f32x4 g0 = *(const f32x4*)g, g1 = *(const f32x4*)(g + 4), g2 = *(const f32x4*)(g + 8), g3 = *(const f32x4*)(g + 12);
#pragma unroll
    for (int i = 0; i < 4; ++i) {
        float v[16];
        v[0] = __uint_as_float(a[i].x << 16); v[1] = __uint_as_float(a[i].x & 0xffff0000u); v[2] = __uint_as_float(a[i].y << 16); v[3] = __uint_as_float(a[i].y & 0xffff0000u);
        v[4] = __uint_as_float(a[i].z << 16); v[5] = __uint_as_float(a[i].z & 0xffff0000u); v[6] = __uint_as_float(a[i].w << 16); v[7] = __uint_as_float(a[i].w & 0xffff0000u);
        v[8] = __uint_as_float(b[i].x << 16); v[9] = __uint_as_float(b[i].x & 0xffff0000u); v[10] = __uint_as_float(b[i].y << 16); v[11] = __uint_as_float(b[i].y & 0xffff0000u);
        v[12] = __uint_as_float(b[i].z << 16); v[13] = __uint_as_float(b[i].z & 0xffff0000u); v[14] = __uint_as_float(b[i].w << 16); v[15] = __uint_as_float(b[i].w & 0xffff0000u);
        float ss = 0.f;
#pragma unroll
        for (int e = 0; e < 16; ++e) ss += v[e] * v[e];
        ss = quad_sum(ss);
        const float r = rsqrtf(ss * (1.0f / 64.0f) + EPS);
        u32x4 o0, o1;
        o0.x = pk2(v[0] * r * g0.x, v[1] * r * g0.y); o0.y = pk2(v[2] * r * g0.z, v[3] * r * g0.w); o0.z = pk2(v[4] * r * g1.x, v[5] * r * g1.y); o0.w = pk2(v[6] * r * g1.z, v[7] * r * g1.w);
        o1.x = pk2(v[8] * r * g2.x, v[9] * r * g2.y); o1.y = pk2(v[10] * r * g2.z, v[11] * r * g2.w); o1.z = pk2(v[12] * r * g3.x, v[13] * r * g3.y); o1.w = pk2(v[14] * r * g3.z, v[15] * r * g3.w);
        bf16_t* p = Z + (size_t)(t + i * st) * ZP + OFF_ATTN + lane * 16;
        *(u32x4*)p = o0; *(u32x4*)(p + 8) = o1;
    }
}
__device__ __forceinline__ void conv_rows4(const bf16_t* __restrict__ Z, int t, int st, const float* __restrict__ cw, bf16_t* __restrict__ Y, int lane) {
    const int c = lane * 4;
    u32x2 cg[4][3], hh[4][3], bg[4];
#pragma unroll
    for (int i = 0; i < 4; ++i) { const int tt = t + i * st, s = tt & (SEQ - 1);
#pragma unroll
        for (int j = 0; j < 3; ++j) { const int back = (s - 2 + j >= 0) ? (2 - j) : 0;
            const bf16_t* zr = Z + (size_t)(tt - back) * ZP + OFF_CONV; cg[i][j] = *(const u32x2*)(zr + 256 + c); hh[i][j] = *(const u32x2*)(zr + 512 + c); }
        bg[i] = *(const u32x2*)(Z + (size_t)tt * ZP + OFF_CONV + c); }
    f32x4 w[3];
#pragma unroll
    for (int j = 0; j < 3; ++j) w[j] = *(const f32x4*)(cw + j * 256 + c);
#pragma unroll
    for (int i = 0; i < 4; ++i) { const int tt = t + i * st, s = tt & (SEQ - 1);
        float y0 = 0.f, y1 = 0.f, y2 = 0.f, y3 = 0.f;
#pragma unroll
        for (int j = 0; j < 3; ++j) { const float mk = (s - 2 + j >= 0) ? 1.0f : 0.0f;
            y0 += mk * w[j].x * __uint_as_float(cg[i][j].x << 16) * __uint_as_float(hh[i][j].x << 16); y1 += mk * w[j].y * __uint_as_float(cg[i][j].x & 0xffff0000u) * __uint_as_float(hh[i][j].x & 0xffff0000u);
            y2 += mk * w[j].z * __uint_as_float(cg[i][j].y << 16) * __uint_as_float(hh[i][j].y << 16); y3 += mk * w[j].w * __uint_as_float(cg[i][j].y & 0xffff0000u) * __uint_as_float(hh[i][j].y & 0xffff0000u); }
        u32x2 o; o.x = pk2(__uint_as_float(bg[i].x << 16) * y0, __uint_as_float(bg[i].x & 0xffff0000u) * y1); o.y = pk2(__uint_as_float(bg[i].y << 16) * y2, __uint_as_float(bg[i].y & 0xffff0000u) * y3);
        *(u32x2*)(Y + (size_t)tt * YW + 256 + c) = o; }
}

__device__ __forceinline__ unsigned offb_(unsigned row, unsigned ch) { return 256u * row + 16u * (ch ^ (((row & 3u) << 2) | ((row >> 2) & 3u))); }
typedef float f32x16_t __attribute__((ext_vector_type(16)));
typedef short s16x4_t __attribute__((ext_vector_type(4)));
__device__ __forceinline__ s16x4_t vtr_(const LAS unsigned char* p) { return __builtin_bit_cast(s16x4_t, __builtin_amdgcn_ds_read_tr16_b64_v4i16((LAS s16x4_t*)p)); }
__device__ __forceinline__ unsigned cvtpk_(float lo, float hi) { unsigned r; asm volatile("v_cvt_pk_bf16_f32 %0, %1, %2" : "=v"(r) : "v"(lo), "v"(hi)); return r; }
__device__ __forceinline__ void sgu_seg_mfma(const bf16_t* __restrict__ Z, const float* __restrict__ lng, const bf16_t* __restrict__ wsb  , const float* __restrict__ sb,
                                             bf16_t* __restrict__ Y, LAS unsigned char* L, int seg, int tid) {
    const int lane = tid & 63, w = __builtin_amdgcn_readfirstlane(tid >> 6), t0 = seg * 128;
    {
        const f32x4 gg = *(const f32x4*)(lng + 4 * lane);
        u32x2 raw[16];
#pragma unroll
        for (int i = 0; i < 16; ++i) raw[i] = *(const u32x2*)(Z + (size_t)(t0 + w * 16 + i) * ZP + OFF_SGU + 256 + 4 * lane);
#pragma unroll
        for (int i = 0; i < 16; ++i) {
            const float x0 = __uint_as_float(raw[i].x << 16), x1 = __uint_as_float(raw[i].x & 0xffff0000u), x2 = __uint_as_float(raw[i].y << 16), x3 = __uint_as_float(raw[i].y & 0xffff0000u);
            const float s = wave_sum((x0 + x1) + (x2 + x3));
            const float mu = s * (1.0f / 256.0f);
            const float d0 = x0 - mu, d1 = x1 - mu, d2 = x2 - mu, d3 = x3 - mu;
            const float q = wave_sum((d0 * d0 + d1 * d1) + (d2 * d2 + d3 * d3));
            const float rs = rsqrtf(q * (1.0f / 256.0f) + EPS);
            u32x2 o; o.x = cvtpk_(d0 * rs * gg.x, d1 * rs * gg.y); o.y = cvtpk_(d2 * rs * gg.z, d3 * rs * gg.w);
            const unsigned row = (unsigned)(w * 16 + i), ch = (unsigned)(4 * lane);
            *(LAS u32x2*)(L + (ch >> 7) * 32768u + offb_(row, (ch & 127u) >> 3) + ((ch & 4u) ? 8u : 0u)) = o;
        }
    }
    __syncthreads();
    const int r = lane & 31, hh = lane >> 5, ct = w >> 2;
    const unsigned blk = (lane >> 4) & 1, qq = (lane & 15) >> 2, pp = lane & 3;
#pragma unroll
    for (int g = 0; g < 4; ++g) {
        const int pt = (w + g) & 3;
        const unsigned c = (unsigned)((g & 1) * 2 + ct);
        const LAS unsigned char* img = L + (g >> 1) * 32768;
        const unsigned va0 = offb_(8u * hh + qq, 4u * c + 2u * blk + (pp >> 1)) + 8u * (pp & 1), va1 = offb_(8u * hh + 4u + qq, 4u * c + 2u * blk + (pp >> 1)) + 8u * (pp & 1);
        const bf16_t* wrow = wsb + ((size_t)g * 128 + 32 * pt + r) * 128 + 8 * hh;
        f32x16_t acc;
#pragma unroll
        for (int i = 0; i < 16; ++i) acc[i] = 0.f;
        const int nks = 2 * (pt + 1);
        for (int ks = 0; ks < nks; ++ks) {
            const s16x4_t lo = vtr_(img + va0 + ks * 4096), hi = vtr_(img + va1 + ks * 4096);
            const bf16x8 a = {lo[0], lo[1], lo[2], lo[3], hi[0], hi[1], hi[2], hi[3]};
            const bf16x8 bw = *(const bf16x8*)(wrow + 16 * ks);
            acc = __builtin_amdgcn_mfma_f32_32x32x16_bf16(a, bw, acc, 0, 0, 0);
        }
        const int p = 32 * pt + r;
        const float bias = sb[g * 128 + p];
        const bf16_t* up = Z + (size_t)(t0 + p) * ZP + OFF_SGU + g * 64 + 32 * ct + 4 * hh;
        bf16_t* yp = Y + (size_t)(t0 + p) * YW + 512 + g * 64 + 32 * ct + 4 * hh;
        u32x2 uvv[4];
#pragma unroll
        for (int gq = 0; gq < 4; ++gq) uvv[gq] = *(const u32x2*)(up + 8 * gq);
        asm volatile("" ::: "memory");
#pragma unroll
        for (int gq = 0; gq < 4; ++gq) { const u32x2 uv = uvv[gq];
            u32x2 o; o.x = cvtpk_(__uint_as_float(uv.x << 16) * (acc[4 * gq + 0] + bias), __uint_as_float(uv.x & 0xffff0000u) * (acc[4 * gq + 1] + bias));
            o.y = cvtpk_(__uint_as_float(uv.y << 16) * (acc[4 * gq + 2] + bias), __uint_as_float(uv.y & 0xffff0000u) * (acc[4 * gq + 3] + bias));
            *(u32x2*)(yp + 8 * gq) = o; }
    }
    __syncthreads();
}

__device__ __forceinline__ void pool_unit_mfma(const bf16_t* __restrict__ Z, const bf16_t* __restrict__ pwt  , const float* __restrict__ ps, bf16_t* __restrict__ Y, int unit, int lane) {
    const int g = unit & 3, tt = unit >> 2, r = lane & 31, hh = lane >> 5;
    const int t = tt * 32 + r, s = t & (SEQ - 1), win = 2 << g;
    const int cnt = (s + 1) < win ? (s + 1) : win;
    const float icnt = 1.0f / (float)cnt;
    f32x16_t acc0, acc1;
#pragma unroll
    for (int i = 0; i < 16; ++i) { acc0[i] = 0.f; acc1[i] = 0.f; }
#pragma unroll
    for (int ks = 0; ks < 4; ++ks) {
        const bf16_t* zp = Z + (size_t)t * ZP + OFF_POOL + g * 64 + 16 * ks + 8 * hh;
        float sm[8];
#pragma unroll
        for (int e = 0; e < 8; ++e) sm[e] = 0.f;
        u32x4 self = {0u, 0u, 0u, 0u};
        for (int d = 0; d < win; ++d) {
            if (d < cnt) { const u32x4 v = *(const u32x4*)(zp - (size_t)d * ZP); if (d == 0) self = v;
                sm[0] += __uint_as_float(v.x << 16); sm[1] += __uint_as_float(v.x & 0xffff0000u); sm[2] += __uint_as_float(v.y << 16); sm[3] += __uint_as_float(v.y & 0xffff0000u);
                sm[4] += __uint_as_float(v.z << 16); sm[5] += __uint_as_float(v.z & 0xffff0000u); sm[6] += __uint_as_float(v.w << 16); sm[7] += __uint_as_float(v.w & 0xffff0000u); }
        }
        u32x4 pb;
        pb.x = cvtpk_(sm[0] * icnt - __uint_as_float(self.x << 16), sm[1] * icnt - __uint_as_float(self.x & 0xffff0000u));
        pb.y = cvtpk_(sm[2] * icnt - __uint_as_float(self.y << 16), sm[3] * icnt - __uint_as_float(self.y & 0xffff0000u));
        pb.z = cvtpk_(sm[4] * icnt - __uint_as_float(self.z << 16), sm[5] * icnt - __uint_as_float(self.z & 0xffff0000u));
        pb.w = cvtpk_(sm[6] * icnt - __uint_as_float(self.w << 16), sm[7] * icnt - __uint_as_float(self.w & 0xffff0000u));
        const bf16x8 bp = __builtin_bit_cast(bf16x8, pb);
        const bf16x8 a0 = *(const bf16x8*)(pwt + ((size_t)g * 64 + r) * 64 + 16 * ks + 8 * hh);
        const bf16x8 a1 = *(const bf16x8*)(pwt + ((size_t)g * 64 + 32 + r) * 64 + 16 * ks + 8 * hh);
        acc0 = __builtin_amdgcn_mfma_f32_32x32x16_bf16(a0, bp, acc0, 0, 0, 0);
        acc1 = __builtin_amdgcn_mfma_f32_32x32x16_bf16(a1, bp, acc1, 0, 0, 0);
    }
    bf16_t* yp = Y + (size_t)t * YW + g * 64 + 4 * hh;
    f32x4 sc0[4], sc1[4];
#pragma unroll
    for (int gq = 0; gq < 4; ++gq) { sc0[gq] = *(const f32x4*)(ps + g * 64 + 8 * gq + 4 * hh); sc1[gq] = *(const f32x4*)(ps + g * 64 + 32 + 8 * gq + 4 * hh); }
    asm volatile("" ::: "memory");
#pragma unroll
    for (int gq = 0; gq < 4; ++gq) {
        const f32x4 s0 = sc0[gq], s1 = sc1[gq];
        u32x2 o; o.x = cvtpk_(acc0[4 * gq + 0] * s0.x, acc0[4 * gq + 1] * s0.y); o.y = cvtpk_(acc0[4 * gq + 2] * s0.z, acc0[4 * gq + 3] * s0.w); *(u32x2*)(yp + 8 * gq) = o;
        o.x = cvtpk_(acc1[4 * gq + 0] * s1.x, acc1[4 * gq + 1] * s1.y); o.y = cvtpk_(acc1[4 * gq + 2] * s1.z, acc1[4 * gq + 3] * s1.w); *(u32x2*)(yp + 32 + 8 * gq) = o;
    }
}

__device__ __forceinline__ void router_row(const float* __restrict__ hrow, const float* __restrict__ g, const float* __restrict__ rw, bf16_t* __restrict__ orow, int& e0o, int& e1o, float& w0o, float& w1o, int lane) {
    const f32x4* p = (const f32x4*)hrow;
    f32x4 v[4]; float ss = 0.f;
#pragma unroll
    for (int j = 0; j < 4; ++j) { v[j] = p[lane + 64 * j]; ss += (v[j].x * v[j].x + v[j].y * v[j].y) + (v[j].z * v[j].z + v[j].w * v[j].w); }
    ss = wave_sum(ss);
    const float r = rsqrtf(ss * (1.0f / D) + EPS);
    float lg[8];
#pragma unroll
    for (int e = 0; e < 8; ++e) lg[e] = 0.f;
    u32x2* op = (u32x2*)orow;
#pragma unroll
    for (int j = 0; j < 4; ++j) {
        const int k = (lane + 64 * j) * 4; const f32x4 gg = *(const f32x4*)(g + k);
        const float x0 = v[j].x * r * gg.x, x1 = v[j].y * r * gg.y, x2 = v[j].z * r * gg.z, x3 = v[j].w * r * gg.w;
        u32x2 w; w.x = pk2(x0, x1); w.y = pk2(x2, x3); op[lane + 64 * j] = w;
        const f32x4* rp = (const f32x4*)(rw + (size_t)k * 8);
#pragma unroll
        for (int q = 0; q < 4; ++q) { const float xx = q == 0 ? x0 : (q == 1 ? x1 : (q == 2 ? x2 : x3)); const f32x4 ra = rp[q * 2], rb = rp[q * 2 + 1];
            lg[0] = fmaf(xx, ra.x, lg[0]); lg[1] = fmaf(xx, ra.y, lg[1]); lg[2] = fmaf(xx, ra.z, lg[2]); lg[3] = fmaf(xx, ra.w, lg[3]);
            lg[4] = fmaf(xx, rb.x, lg[4]); lg[5] = fmaf(xx, rb.y, lg[5]); lg[6] = fmaf(xx, rb.z, lg[6]); lg[7] = fmaf(xx, rb.w, lg[7]); }
    }
#pragma unroll
    for (int e = 0; e < 8; ++e) lg[e] = wave_sum(lg[e]);
    int i0 = 0; float v0 = lg[0];
#pragma unroll
    for (int e = 1; e < 8; ++e) if (lg[e] > v0) { v0 = lg[e]; i0 = e; }
    int i1 = -1; float v1 = -3e38f;
#pragma unroll
    for (int e = 0; e < 8; ++e) if (e != i0 && lg[e] > v1) { v1 = lg[e]; i1 = e; }
    const float e1 = __expf(v1 - v0);
    e0o = i0; e1o = i1; w0o = 1.0f / (1.0f + e1); w1o = e1 / (1.0f + e1);
}


namespace fa {
typedef float f32x16 __attribute__((ext_vector_type(16)));
typedef short s16x4 __attribute__((ext_vector_type(4)));
typedef short v4i16_t __attribute__((ext_vector_type(4)));
constexpr int TAB_OFF = 131072;
constexpr int TABN = 328;
constexpr float C2 = 0.125f * 1.4426950408889634f;
constexpr float LOG2E = 1.4426950408889634f;
__device__ __forceinline__ unsigned off_b(unsigned row, unsigned ch) { return 256u * row + 16u * (ch ^ (((row & 3u) << 2) | ((row >> 2) & 3u))); }
__device__ __forceinline__ s16x4 vtr(const LAS unsigned char* p) { return __builtin_bit_cast(s16x4, __builtin_amdgcn_ds_read_tr16_b64_v4i16((LAS v4i16_t*)p)); }
__device__ __forceinline__ float max3f(float a, float b, float c) { float r; asm("v_max3_f32 %0, %1, %2, %3" : "=v"(r) : "v"(a), "v"(b), "v"(c)); return r; }
__device__ __forceinline__ float max2f(float a, float b) { float r; asm("v_max_f32_e32 %0, %1, %2" : "=v"(r) : "v"(a), "v"(b)); return r; }
__device__ __forceinline__ unsigned cvtpk(float lo, float hi) { unsigned r; asm volatile("v_cvt_pk_bf16_f32 %0, %1, %2" : "=v"(r) : "v"(lo), "v"(hi)); return r; }

__device__ __forceinline__ void attn_phase(LAS unsigned char* lds, const bf16_t* __restrict__ Z, const float* __restrict__ relb, const float* __restrict__ dl, const float* __restrict__ sg,
                                           float lam_init, bf16_t* __restrict__ Y, int G, int bx, int wave_) {
    int tid = wave_ * 64 + lane_id(); asm volatile("" : "+v"(tid));
    const int lane = tid & 63, w = __builtin_amdgcn_readfirstlane(tid >> 6), m = w >> 2, r32 = w & 3, r = lane & 31, hh = lane >> 5;
    const float l1 = wave_sum(dl[lane] * dl[64 + lane]), l2 = wave_sum(dl[128 + lane] * dl[192 + lane]);
    const float lam = __expf(l1) - __expf(l2) + lam_init;
    LAS float* TAB = (LAS float*)(lds + TAB_OFF);
    unsigned goff[2];
#pragma unroll
    for (int i = 0; i < 2; ++i) { const unsigned pos = (unsigned)w * 1024u + (unsigned)i * 8192u + (unsigned)lane * 16u, row = pos >> 8, p = (pos >> 4) & 15u;
        const unsigned ch = p ^ (((row & 3u) << 2) | ((row >> 2) & 3u)); goff[i] = row * (unsigned)(ZP * 2) + ch * 16u; }
    unsigned kaddr[4];
#pragma unroll
    for (int s = 0; s < 4; ++s) kaddr[s] = off_b((unsigned)r, (unsigned)(m * 8 + 2 * s + hh));
    unsigned vaddr[4][2];
    { const unsigned blk = (lane >> 4) & 1, q = (lane & 15) >> 2, p = lane & 3;
#pragma unroll
      for (int c = 0; c < 4; ++c)
#pragma unroll
          for (int t = 0; t < 2; ++t) vaddr[c][t] = off_b(8u * t + 4u * hh + q, 4u * c + 2u * blk + (p >> 1)) + 8u * (p & 1); }

    const int vcu = (G % 8 == 0) ? (bx % 8) * (G / 8) + bx / 8 : bx;
    int tab_h = -1;
    for (int ui = 0;; ++ui) {
        const int pidx = vcu + G * (ui >> 1);
        if (pidx >= 512) break;
        const int j8 = pidx & 7, h = (pidx >> 3) & 3, b = pidx >> 5;
        const int qb = (ui & 1) ? 15 - j8 : j8;
        const int q0 = qb * 128, nkt = 2 * qb + 2, qs = q0 + 32 * r32;
        const int my_nkt = r32 < 2 ? nkt - 1 : nkt;
        const char* zb = (const char*)Z + (size_t)(b * SEQ) * ZP * 2;
        const char* kbase = zb + (OFF_ATTN + 512 + h * 128) * 2;
        const char* vbase = zb + (OFF_ATTN + 1024 + h * 128) * 2;
        __syncthreads();
        if (h != tab_h) {
            for (int idx = tid; idx < 2 * 4 * TABN; idx += 512) { const int mm = idx / (4 * TABN), c = (idx / TABN) & 3, y = idx % TABN; TAB[idx] = relb[rel_bucket(y - c - 256) * 8 + h * 2 + mm] * LOG2E; }
            tab_h = h;
        }
        const float b15p = relb[15 * 8 + h * 2 + m] * LOG2E;
        bf16x8 Qf[4];
        { const char* qp = zb + ((size_t)(qs + r) * ZP + OFF_ATTN + h * 128 + m * 64 + 8 * hh) * 2;
#pragma unroll
          for (int s = 0; s < 4; ++s) Qf[s] = *(const bf16x8*)(qp + s * 32); }
        asm volatile("s_waitcnt vmcnt(0)" ::: "memory");
#define FA_LOAD_TILE(kt_, buf_) do { const size_t to_ = (size_t)(kt_) * 64 * ZP * 2; LAS unsigned char* lb_ = lds + (buf_) * 32768 + w * 1024; \
        __builtin_amdgcn_global_load_lds((const unsigned*)(kbase + to_ + goff[0]), (LAS unsigned*)(lb_), 16, 0, 0); \
        __builtin_amdgcn_global_load_lds((const unsigned*)(kbase + to_ + goff[1]), (LAS unsigned*)(lb_ + 8192), 16, 0, 0); \
        __builtin_amdgcn_global_load_lds((const unsigned*)(vbase + to_ + goff[0]), (LAS unsigned*)(lb_ + 16384), 16, 0, 0); \
        __builtin_amdgcn_global_load_lds((const unsigned*)(vbase + to_ + goff[1]), (LAS unsigned*)(lb_ + 16384 + 8192), 16, 0, 0); } while (0)
        FA_LOAD_TILE(0, 0); FA_LOAD_TILE(1, 1);
        f32x16 O[4];
#pragma unroll
        for (int c = 0; c < 4; ++c)
#pragma unroll
            for (int i = 0; i < 16; ++i) O[c][i] = 0.f;
        float mref = 0.f, lsum = 0.f;
        const int sq = qs + r, sqa = sq >> 2, sqc = sq & 3;
        const LAS float* tabl = TAB + (m * 4 + sqc) * TABN + 256 - 4 * sqa + 4 * hh;
        f32x16 S0, S1;
#pragma unroll
        for (int i = 0; i < 16; ++i) { S0[i] = 0.f; S1[i] = 0.f; }
        bf16x8 P[4];
#pragma unroll
        for (int i = 0; i < 4; ++i) P[i] = (bf16x8){0, 0, 0, 0, 0, 0, 0, 0};
        constexpr float THR = 8.0f;
        for (int t = 0; t <= nkt; ++t) {
            if (t < nkt) { if (t + 1 < nkt) asm volatile("s_waitcnt vmcnt(4) lgkmcnt(0)\n\ts_barrier" ::: "memory"); else asm volatile("s_waitcnt vmcnt(0) lgkmcnt(0)\n\ts_barrier" ::: "memory"); }
            else asm volatile("s_waitcnt lgkmcnt(0)\n\ts_barrier" ::: "memory");
            if (t + 2 < nkt) FA_LOAD_TILE(t + 2, (t + 2) & 3);
            const bool do_qk = t < my_nkt, do_pv = t >= 1 && (t - 1) < my_nkt;
            float alpha = 1.f, sub = 0.f; bool moved = false;
            if (do_qk) {
                const LAS unsigned char* Kb = lds + (t & 3) * 32768;
                bf16x8 kf[8];
#pragma unroll
                for (int s_ = 0; s_ < 4; ++s_) { kf[2 * s_] = *(const LAS bf16x8*)(Kb + kaddr[s_]); kf[2 * s_ + 1] = *(const LAS bf16x8*)(Kb + kaddr[s_] + 8192); }
#pragma unroll
                for (int i = 0; i < 16; ++i) { S0[i] = 0.f; S1[i] = 0.f; }
                __builtin_amdgcn_sched_barrier(0);
#pragma unroll
                for (int s_ = 0; s_ < 4; ++s_) { S0 = __builtin_amdgcn_mfma_f32_32x32x16_bf16(kf[2 * s_], Qf[s_], S0, 0, 0, 0); S1 = __builtin_amdgcn_mfma_f32_32x32x16_bf16(kf[2 * s_ + 1], Qf[s_], S1, 0, 0, 0); }
                __builtin_amdgcn_sched_barrier(0);
                const bool nearb = (64 * t + 63 - qs) > -91;
                if (nearb) {
                    const LAS float* tb = tabl + 64 * t;
#pragma unroll
                    for (int g = 0; g < 4; ++g) { const f32x4 b0 = *(const LAS f32x4*)(tb + 8 * g), b1 = *(const LAS f32x4*)(tb + 32 + 8 * g);
#pragma unroll
                        for (int e = 0; e < 4; ++e) { S0[4 * g + e] += b0[e]; S1[4 * g + e] += b1[e]; } }
                }
                float mx = max3f(S0[0], S1[0], S0[1]);
                mx = max3f(mx, S1[1], S0[2]);
#pragma unroll
                for (int i = 2; i < 15; ++i) mx = max3f(mx, S1[i], S0[i + 1]);
                mx = max2f(mx, S1[15]);
                mx = max_xor32(mx);
                if (!nearb) mx += b15p;
                if (!__all(mx <= mref + THR)) {
                    const float mn = fmaxf(mref, mx);
                    alpha = __builtin_amdgcn_exp2f(mref - mn); lsum *= alpha; mref = mn; moved = true;
                }
                sub = nearb ? mref : (mref - b15p);
            }
#define FA_PV_STEP(FILL) do { const LAS unsigned char* Vb = lds + ((t + 3) & 3) * 32768 + 16384; s16x4 vlo[2][4], vhi[2][4]; \
                _Pragma("unroll") for (int c = 0; c < 4; ++c) { vlo[0][c] = vtr(Vb + vaddr[c][0]); vhi[0][c] = vtr(Vb + vaddr[c][1]); } \
                _Pragma("unroll") for (int ks = 0; ks < 4; ++ks) { \
                    if (ks < 3) { _Pragma("unroll") for (int c = 0; c < 4; ++c) { vlo[(ks + 1) & 1][c] = vtr(Vb + vaddr[c][0] + (ks + 1) * 4096); vhi[(ks + 1) & 1][c] = vtr(Vb + vaddr[c][1] + (ks + 1) * 4096); } } \
                    __builtin_amdgcn_sched_barrier(0); \
                    _Pragma("unroll") for (int c = 0; c < 4; ++c) { const s16x4 lo = vlo[ks & 1][c], hi = vhi[ks & 1][c]; \
                        const bf16x8 a = {lo[0], lo[1], lo[2], lo[3], hi[0], hi[1], hi[2], hi[3]}; \
                        O[c] = __builtin_amdgcn_mfma_f32_32x32x16_bf16(a, P[ks], O[c], 0, 0, 0); \
                        if (FILL) { const int j = ks * 4 + c; float e0 = __builtin_amdgcn_exp2f(S0[j] - sub), e1 = __builtin_amdgcn_exp2f(S1[j] - sub); \
                            asm volatile("" : "+v"(e0), "+v"(e1)); S0[j] = e0; S1[j] = e1; lsum += e0 + e1; } \
                        __builtin_amdgcn_sched_barrier(0); } } } while (0)
            if (do_pv) {
                if (!do_qk) sub = 1e30f;
                FA_PV_STEP(true);
                if (moved) {
#pragma unroll
                    for (int c = 0; c < 4; ++c)
#pragma unroll
                        for (int i = 0; i < 16; ++i) O[c][i] *= alpha;
                }
            } else if (do_qk) {
#pragma unroll
                for (int j = 0; j < 16; ++j) { const float e0 = __builtin_amdgcn_exp2f(S0[j] - sub), e1 = __builtin_amdgcn_exp2f(S1[j] - sub); S0[j] = e0; S1[j] = e1; lsum += e0 + e1; }
            }
#undef FA_PV_STEP
            if (do_qk) {
#pragma unroll
                for (int s2 = 0; s2 < 2; ++s2) {
                    u32x4 a, c4;
                    a.x = cvtpk(S0[8 * s2 + 0], S0[8 * s2 + 1]); a.y = cvtpk(S0[8 * s2 + 2], S0[8 * s2 + 3]); a.z = cvtpk(S0[8 * s2 + 4], S0[8 * s2 + 5]); a.w = cvtpk(S0[8 * s2 + 6], S0[8 * s2 + 7]);
                    c4.x = cvtpk(S1[8 * s2 + 0], S1[8 * s2 + 1]); c4.y = cvtpk(S1[8 * s2 + 2], S1[8 * s2 + 3]); c4.z = cvtpk(S1[8 * s2 + 4], S1[8 * s2 + 5]); c4.w = cvtpk(S1[8 * s2 + 6], S1[8 * s2 + 7]);
                    P[s2] = __builtin_bit_cast(bf16x8, a); P[2 + s2] = __builtin_bit_cast(bf16x8, c4);
                }
            }
        }
#undef FA_LOAD_TILE
        lsum = sum_xor32(lsum);
        const float inv = m == 0 ? 1.0f / lsum : lam / lsum;
        asm volatile("s_waitcnt lgkmcnt(0)\n\ts_barrier" ::: "memory");
        LAS float* EX = (LAS float*)lds + (size_t)r32 * 4096 + lane;
        if (m == 1) {
#pragma unroll
            for (int c = 0; c < 4; ++c)
#pragma unroll
                for (int i = 0; i < 16; ++i) EX[(c * 16 + i) * 64] = O[c][i] * inv;
        }
        asm volatile("s_waitcnt lgkmcnt(0)\n\ts_barrier" ::: "memory");
        if (m == 0) {
            float ss = 0.f;
#pragma unroll
            for (int c = 0; c < 4; ++c)
#pragma unroll
                for (int i = 0; i < 16; ++i) { const float o = O[c][i] * inv - EX[(c * 16 + i) * 64]; O[c][i] = o; ss += o * o; }
            ss = sum_xor32(ss);
            const float rn = rsqrtf(ss * (1.0f / 128.0f) + EPS) * (1.0f - lam_init);
            bf16_t* yp = Y + (size_t)(b * SEQ + qs + r) * YW + 768 + h * 128 + 4 * hh;
            f32x4 sgv[4][4];
#pragma unroll
            for (int c = 0; c < 4; ++c)
#pragma unroll
                for (int g = 0; g < 4; ++g) sgv[c][g] = *(const f32x4*)(sg + 32 * c + 8 * g + 4 * hh);
            asm volatile("" ::: "memory");
#pragma unroll
            for (int c = 0; c < 4; ++c)
#pragma unroll
                for (int g = 0; g < 4; ++g) { const f32x4 gg = sgv[c][g];
                    u32x2 o; o.x = cvtpk(O[c][4 * g + 0] * rn * gg.x, O[c][4 * g + 1] * rn * gg.y); o.y = cvtpk(O[c][4 * g + 2] * rn * gg.z, O[c][4 * g + 3] * rn * gg.w);
                    *(u32x2*)(yp + 32 * c + 8 * g) = o; }
        }
    }
    __syncthreads();
}
}


__device__ __forceinline__ void router_rows4(const bf16_t* __restrict__ h, int t, const float* __restrict__ g, const f32x4 (&RW)[4][4][2], unsigned char* __restrict__ XNo,
                                             int* __restrict__ tok_e, float* __restrict__ tok_w, LAS int* hist, int lane) {
    f32x4 v[4][4];
#pragma unroll
    for (int i = 0; i < 4; ++i)
#pragma unroll
        for (int j = 0; j < 4; ++j) { const u32x2 h2 = ((const u32x2*)(h + (size_t)(t + i) * D))[lane + 64 * j];
            v[i][j] = (f32x4){__uint_as_float(h2.x << 16), __uint_as_float(h2.x & 0xffff0000u), __uint_as_float(h2.y << 16), __uint_as_float(h2.y & 0xffff0000u)}; }
    f32x4 gg[4];
#pragma unroll
    for (int j = 0; j < 4; ++j) gg[j] = ((const f32x4*)g)[lane + 64 * j];
#pragma unroll
    for (int i = 0; i < 4; ++i) {
        float ss = 0.f;
#pragma unroll
        for (int j = 0; j < 4; ++j) ss += (v[i][j].x * v[i][j].x + v[i][j].y * v[i][j].y) + (v[i][j].z * v[i][j].z + v[i][j].w * v[i][j].w);
        ss = wave_sum(ss);
        const float r = rsqrtf(ss * (1.0f / D) + EPS);
        float lg[8];
#pragma unroll
        for (int e = 0; e < 8; ++e) lg[e] = 0.f;
        unsigned* op = (unsigned*)(XNo + (size_t)(t + i) * D);
#pragma unroll
        for (int j = 0; j < 4; ++j) {
            const float x0 = v[i][j].x * r * gg[j].x, x1 = v[i][j].y * r * gg[j].y, x2 = v[i][j].z * r * gg[j].z, x3 = v[i][j].w * r * gg[j].w;
            op[lane + 64 * j] = pg8::pk4_fp8(pg8::sat8(x0 * pg8::F8S_HN), pg8::sat8(x1 * pg8::F8S_HN), pg8::sat8(x2 * pg8::F8S_HN), pg8::sat8(x3 * pg8::F8S_HN));
#pragma unroll
            for (int q = 0; q < 4; ++q) { const float xx = q == 0 ? x0 : (q == 1 ? x1 : (q == 2 ? x2 : x3)); const f32x4 ra = RW[j][q][0], rb = RW[j][q][1];
                lg[0] = fmaf(xx, ra.x, lg[0]); lg[1] = fmaf(xx, ra.y, lg[1]); lg[2] = fmaf(xx, ra.z, lg[2]); lg[3] = fmaf(xx, ra.w, lg[3]);
                lg[4] = fmaf(xx, rb.x, lg[4]); lg[5] = fmaf(xx, rb.y, lg[5]); lg[6] = fmaf(xx, rb.z, lg[6]); lg[7] = fmaf(xx, rb.w, lg[7]); }
        }
#pragma unroll
        for (int e = 0; e < 8; ++e) lg[e] = wave_sum(lg[e]);
        int i0 = 0; float v0 = lg[0];
#pragma unroll
        for (int e = 1; e < 8; ++e) if (lg[e] > v0) { v0 = lg[e]; i0 = e; }
        int i1 = -1; float v1 = -3e38f;
#pragma unroll
        for (int e = 0; e < 8; ++e) if (e != i0 && lg[e] > v1) { v1 = lg[e]; i1 = e; }
        const float e1 = __expf(v1 - v0);
        if (lane == 0) { tok_e[2 * (t + i)] = i0; tok_e[2 * (t + i) + 1] = i1; tok_w[2 * (t + i)] = 1.0f / (1.0f + e1); tok_w[2 * (t + i) + 1] = e1 / (1.0f + e1);
            __hip_atomic_fetch_add(&hist[i0], 1, __ATOMIC_RELAXED, __HIP_MEMORY_SCOPE_WORKGROUP); __hip_atomic_fetch_add(&hist[8 + i1], 1, __ATOMIC_RELAXED, __HIP_MEMORY_SCOPE_WORKGROUP); }
    }
}

__device__ __forceinline__ unsigned long long karg_u64(int i) {
    const __attribute__((address_space(4))) unsigned long long* ka = (const __attribute__((address_space(4))) unsigned long long*)__builtin_amdgcn_kernarg_segment_ptr();
    asm volatile("" : "+s"(ka));
    return ka[i];
}
#define AIN(i) ((const float*)karg_u64(i))
#define AOUT ((float*)karg_u64(25))
#define AWS ((unsigned char*)karg_u64(26))
__global__ void __launch_bounds__(NWAVES * 64, 2) mega(Args args) {
    extern __shared__ __attribute__((aligned(16))) unsigned char lds_raw[];
    LAS unsigned char* lds = (LAS unsigned char*)lds_raw;
    volatile LAS unsigned* MISC = (volatile LAS unsigned*)(lds + MISC_OFF);
    const int tid0 = threadIdx.x, wave = __builtin_amdgcn_readfirstlane(tid0 >> 6);
    const int G = gridDim.x, bx = blockIdx.x;
    const int gw = bx * NWAVES + wave, NGW = G * NWAVES;
#define PHASE_TID int tid = wave * 64 + lane_id(); asm volatile("" : "+v"(tid)); const int lane = tid & 63; (void)lane
    for (int u = tid0; u < (LDS_BYTES - MISC_OFF) / 4; u += NWAVES * 64) ((LAS unsigned*)(lds + MISC_OFF))[u] = 0u;
    __syncthreads();
    XcdBarrier bar = xcd_barrier_post((unsigned*)(AWS + WS_CTL) + CW_BAR, MISC + 8, wave);
#define IN(k) true
#define SEAM(k) do { if (IN(k) && IN((k) + 1)) xcd_barrier(bar); } while (0)
#ifndef PROBE_REP
#define PROBE_REP 0
#endif
#define REPFOR(bit) _Pragma("unroll") for (int rep_ = 0; rep_ < 1 + ((PROBE_REP >> (bit)) & 1); ++rep_)
#define REPBAR do { if (rep_) xcd_barrier(bar); } while (0)

#define P_x AIN(0)
#define P_out AOUT
#define P_ws AWS
#define P_Wb ((bf16_t*)(AWS + WS_W))
#define P_XN ((bf16_t*)(AWS + WS_XN))
#define P_Z ((bf16_t*)(AWS + WS_Z))
#define P_Y ((bf16_t*)(AWS + WS_Y))
#define P_HS ((bf16_t*)(AWS + WS_HS))
#define P_cnts ((int*)(AWS + WS_CNT))
#define P_tok_e ((int*)(AWS + WS_TOKE))
#define P_tok_w ((float*)(AWS + WS_TOKW))
#define P_slot_tok ((int*)(AWS + WS_SLOTT))
#define P_slot_w ((float*)(AWS + WS_SLOTW))
#define P_gbases (P_cnts + 256 * 16)

    if (IN(0)) REPFOR(0) {
        REPBAR; PHASE_TID;
        LAS float* scr = (LAS float*)(lds + wave * 16384);
        constexpr int I_IN = (1024 / 64) * (7168 / 32), I_BR = (256 / 64) * (1024 / 32), I_BA = (512 / 64) * (1024 / 32), I_OUT = (1024 / 64) * (1024 / 32);
        constexpr int I_FGU = (1024 / 64) * (5632 / 32), I_FDN = (2816 / 64) * (1024 / 32), I_MGU = (1024 / 64) * (7168 / 32), I_MDN = (3584 / 64) * (1024 / 32);
        constexpr int I_L = I_IN + 3 * I_BR + I_BA + I_OUT;
        constexpr int NITEMS = 2 * I_L + I_FGU + I_FDN + 8 * I_MGU + 8 * I_MDN;
        for (int it = gw; it < NITEMS; it += NGW) {
            int r = it;
            if (r < 2 * I_L) {
                const int layer = r / I_L; r -= layer * I_L;
                if (r < I_IN) {
                    if (32 * (r % (7168 / 32)) >= ZP) p0_transpose_item_f8(AIN(3) + (size_t)layer * 1024 * 7168, 1024, 7168, (unsigned char*)P_Wb + WOFF_IN8 + (size_t)layer * 7168 * 1024, 1024, 0, pg8::F8S_WGU, scr, r, lane);
                    else p0_transpose_item(AIN(3) + (size_t)layer * 1024 * 7168, 1024, 7168, (bf16_t*)((char*)P_Wb + WOFF_IN) + (size_t)layer * 7168 * 1024, 1024, 0, 0, scr, r, lane);
                    continue; } r -= I_IN;
                bf16_t* wm = (bf16_t*)((char*)P_Wb + WOFF_MRG) + (size_t)layer * 1024 * 1280;
                if (r < I_BR) { p0_transpose_item(AIN(14) + (size_t)layer * 256 * 1024, 256, 1024, wm, 1280, 0, 0, scr, r, lane); continue; } r -= I_BR;
                if (r < I_BR) { p0_transpose_item(AIN(15) + (size_t)layer * 256 * 1024, 256, 1024, wm, 1280, 256, 0, scr, r, lane); continue; } r -= I_BR;
                if (r < I_BR) { p0_transpose_item(AIN(16) + (size_t)layer * 256 * 1024, 256, 1024, wm, 1280, 512, 0, scr, r, lane); continue; } r -= I_BR;
                if (r < I_BA) { p0_transpose_item(AIN(17) + (size_t)layer * 512 * 1024, 512, 1024, wm, 1280, 768, 0, scr, r, lane); continue; } r -= I_BA;
                p0_transpose_item(AIN(18) + (size_t)layer * 1024 * 1024, 1024, 1024, (bf16_t*)((char*)P_Wb + WOFF_OUT) + (size_t)layer * 1024 * 1024, 1024, 0, 0, scr, r, lane); continue;
            }
            r -= 2 * I_L;
            if (r < I_FGU) { p0_transpose_item(AIN(20), 1024, 5632, (bf16_t*)((char*)P_Wb + WOFF_FGU), 1024, 0, 1, scr, r, lane); continue; } r -= I_FGU;
            if (r < I_FDN) { p0_transpose_item_f8(AIN(21), 2816, 1024, (unsigned char*)P_Wb + WOFF_FDN, 2816, 0, pg8::F8S_WDN, scr, r, lane); continue; } r -= I_FDN;
            if (r < 8 * I_MGU) { const int e = r / I_MGU; r -= e * I_MGU; p0_transpose_item_f8(AIN(23) + (size_t)e * 1024 * 7168, 1024, 7168, (unsigned char*)P_Wb + WOFF_MGU + (size_t)e * 7168 * 1024, 1024, 1, pg8::F8S_WGU, scr, r, lane); continue; } r -= 8 * I_MGU;
            { const int e = r / I_MDN; r -= e * I_MDN; p0_transpose_item_f8(AIN(24) + (size_t)e * 3584 * 1024, 3584, 1024, (unsigned char*)P_Wb + WOFF_MDN + (size_t)e * 1024 * 3584, 3584, 0, pg8::F8S_WDN, scr, r, lane); }
        }
        for (int i = bx * 512 + tid; i < 2 * 4 * 128 * 128; i += G * 512) { const int q = i & 127, p_ = (i >> 7) & 127; ((bf16_t*)((char*)P_Wb + WOFF_SGU))[i] = q <= p_ ? f2bf(AIN(8)[i]) : (bf16_t)0; }
        for (int i = bx * 512 + tid; i < 2 * 4 * 64 * 64; i += G * 512) { const int c = i & 63, d = (i >> 6) & 63, lg = i >> 12; ((bf16_t*)((char*)P_Wb + WOFF_POOL))[i] = f2bf(AIN(4)[((size_t)lg * 64 + c) * 64 + d]); }
        {
            const float* g1 = AIN(2); unsigned char* xn8 = (unsigned char*)P_Wb + WOFF_XN8;
            for (int m = gw; m + 3 * NGW < T; m += 4 * NGW) rms_rows4<true>(P_x, m, NGW, g1, P_XN, xn8, lane);
            for (int m = gw + (((T - gw + NGW - 1) / NGW) & ~3) * NGW; m < T; m += NGW) rms_row<true>(P_x + (size_t)m * D, g1, P_XN + (size_t)m * D, xn8 + (size_t)m * D, lane);
        }
    }
    SEAM(0);

#pragma unroll
    for (int layer = 0; layer < 2; ++layer) {
        const int pb = 1 + layer * 16;
        const float lam_init = layer == 0 ? 0.2f : 0.35550906f;

        if (layer != 0) {
            if (IN(pb + 0)) REPFOR(1) { REPBAR; PHASE_TID; const float* g1 = AIN(2) + layer * D;
                unsigned char* xn8 = (unsigned char*)P_Wb + WOFF_XN8;
                for (int m = gw; m + 3 * NGW < T; m += 4 * NGW) rms_rows4_bf<true>(P_HS, m, NGW, g1, P_XN, xn8, lane);
                for (int m = gw + (((T - gw + NGW - 1) / NGW) & ~3) * NGW; m < T; m += NGW) rms_row_bf<true>(P_HS + (size_t)m * D, g1, P_XN + (size_t)m * D, xn8 + (size_t)m * D, lane); }
            SEAM(pb + 0);
        }
        if (IN(pb + 1)) REPFOR(2) {
            REPBAR;
            {
                pg8::Gemm g{(const char*)P_Wb + WOFF_XN8, D / 2, D / 2}; pg8::SchedPlainOff S{T / 256, (INC - ZP) / 256, ZP / 256, G, bx, D / 128, (const char*)P_Wb + WOFF_IN8 + (size_t)layer * 7168 * 1024};
                pg8::EpiZ<true> E{P_Z, (bf16_t*)(P_ws + WS_G), AIN(10) + layer * 64, AIN(11) + layer * 64, (LAS float*)(lds + pg8::STAGE_BYTES)};
                pg8::gemm_phase<pg8::EpiZ<true>, pg8::SchedPlainOff, true, true>(lds, g, S, E, wave);
            }
            {
                pg8::Gemm g{(const char*)P_XN, D, D}; pg8::SchedPlain S{T / 256, ZP / 256, G, bx, D / 64, (const char*)P_Wb + WOFF_IN + (size_t)layer * 7168 * 1024 * 2};
                pg8::EpiZ<false> E{P_Z, (bf16_t*)(P_ws + WS_G), AIN(10) + layer * 64, AIN(11) + layer * 64, (LAS float*)(lds + pg8::STAGE_BYTES)};
                pg8::gemm_phase<pg8::EpiZ<false>, pg8::SchedPlain, true>(lds, g, S, E, wave);
            }
        }
        SEAM(pb + 1);
        if (IN(pb + 2)) {
            PHASE_TID;
            const float* cw = AIN(6) + layer * 768;
            REPFOR(3) { REPBAR;
            for (int t = gw; t + 3 * NGW < T; t += 4 * NGW) conv_rows4(P_Z, t, NGW, cw, P_Y, lane);
            for (int t = gw + (((T - gw + NGW - 1) / NGW) & ~3) * NGW; t < T; t += NGW) conv_row(P_Z, t, cw, P_Y, lane);
            for (int u = gw; u < (T / 32) * 4; u += NGW) pool_unit_mfma(P_Z, (const bf16_t*)((const char*)P_Wb + WOFF_POOL) + (size_t)layer * 16384, AIN(5) + layer * 256, P_Y, u, lane);
            for (int it = bx; it < T / 128; it += G) sgu_seg_mfma(P_Z, AIN(7) + layer * 256, (const bf16_t*)((const char*)P_Wb + WOFF_SGU) + (size_t)layer * 65536, AIN(9) + layer * 512, P_Y, lds, it, tid);
            }
        }
        if (IN(pb + 3)) REPFOR(4) {
            REPBAR;
            fa::attn_phase(lds, P_Z, AIN(1), AIN(12) + layer * 256, AIN(13) + layer * 128, lam_init, P_Y, G, bx, wave);
        }
        SEAM(pb + 3);
        if (IN(pb + 4)) REPFOR(5) {
            REPBAR;
            __syncthreads();
            pg8::Gemm g{(const char*)P_Y, YW, YW}; pg8::SchedMerge S{T / 256, D / 256, G, bx, (const char*)P_Wb + WOFF_MRG + (size_t)layer * 1024 * 1280 * 2};
            pg8::EpiMerge E{(const bf16_t*)(P_ws + WS_G), P_XN};
            pg8::gemm_phase<pg8::EpiMerge, pg8::SchedMerge, true>(lds, g, S, E, wave);
        }
        SEAM(pb + 4);
        if (IN(pb + 5)) {
            pg8::Gemm g{(const char*)P_XN, D, D}; pg8::SchedPlain S{T / 256, D / 256, G, bx, D / 64, (const char*)P_Wb + WOFF_OUT + (size_t)layer * 1024 * 1024 * 2};
            if (layer == 0) { pg8::EpiResid<false, true> E{P_x, P_HS}; pg8::gemm_phase<pg8::EpiResid<false, true>, pg8::SchedPlain, true>(lds, g, S, E, wave); }
            else { pg8::EpiResid<true, true> E{P_HS, P_HS}; pg8::gemm_phase<pg8::EpiResid<true, true>, pg8::SchedPlain, true>(lds, g, S, E, wave); }
        }
        SEAM(pb + 5);
        if (layer == 0) {
            if (IN(pb + 6)) REPFOR(7) { REPBAR; PHASE_TID; const float* g2 = AIN(19); for (int m = gw; m + 3 * NGW < T; m += 4 * NGW) rms_rows4_bf<false>(P_HS, m, NGW, g2, P_XN, nullptr, lane);
                for (int m = gw + (((T - gw + NGW - 1) / NGW) & ~3) * NGW; m < T; m += NGW) rms_row_bf<false>(P_HS + (size_t)m * D, g2, P_XN + (size_t)m * D, nullptr, lane); }
            SEAM(pb + 6);
            if (IN(pb + 7)) REPFOR(8) {
                REPBAR;
                pg8::Gemm g{(const char*)P_XN, D, D}; pg8::SchedPlain S{T / 256, 2 * DFF / 256, G, bx, D / 64, (const char*)P_Wb + WOFF_FGU};
                pg8::EpiSwi8<false> E{(unsigned char*)P_Z, DFF};
                pg8::gemm_phase<pg8::EpiSwi8<false>, pg8::SchedPlain, true>(lds, g, S, E, wave);
            }
            SEAM(pb + 7);
            if (IN(pb + 8)) {
                pg8::Gemm g{(const char*)P_Z, DFF / 2, DFF / 2}; pg8::SchedPlainRev S{T / 256, D / 256, G, bx, DFF / 128, (const char*)P_Wb + WOFF_FDN};
                pg8::EpiResid<true, true, true> E{P_HS, P_HS};
                pg8::gemm_phase<pg8::EpiResid<true, true, true>, pg8::SchedPlainRev, true, true>(lds, g, S, E, wave);
            }
            SEAM(pb + 8);
        } else {
            if (IN(pb + 6)) REPFOR(7) {
                REPBAR; PHASE_TID;
                const float* g2 = AIN(19) + D; const float* rw = AIN(22);
                LAS int* hist = (LAS int*)lds;
                f32x4 RW[4][4][2];
#pragma unroll
                for (int j = 0; j < 4; ++j)
#pragma unroll
                    for (int q = 0; q < 4; ++q) { const f32x4* rp = (const f32x4*)(rw + (size_t)((lane + 64 * j) * 4 + q) * 8); RW[j][q][0] = rp[0]; RW[j][q][1] = rp[1]; }
                for (int ch = bx; ch < 256; ch += G) {
                    if (tid < 16) hist[tid] = 0;
                    __syncthreads();
#pragma unroll 1
                    for (int i = 0; i < 16; i += 4) router_rows4(P_HS, ch * 128 + wave * 16 + i, g2, RW, (unsigned char*)P_XN, P_tok_e, P_tok_w, hist, lane);
                    __syncthreads();
                    if (tid < 16) P_cnts[ch * 16 + tid] = hist[tid];
                    __syncthreads();
                }
            }
            SEAM(pb + 6);
            if (IN(pb + 7)) REPFOR(9) {
                REPBAR; PHASE_TID;
                LAS int* C = (LAS int*)lds;
                LAS int* PT = C + 4096;
                LAS int* TOT = PT + 1024; LAS int* BASE = TOT + 16; LAS int* PRE = BASE + 32; LAS int* W0C = PRE + 16;
                for (int i = tid; i < 4096; i += 512) C[i] = P_cnts[i];
                __syncthreads();
                { const int g = tid & 15, part = tid >> 4; int s_ = 0;
#pragma unroll
                  for (int c = 0; c < 8; ++c) s_ += C[(part * 8 + c) * 16 + g];
                  PT[part * 16 + g] = s_; }
                __syncthreads();
                if (tid < 16) { int s_ = 0; for (int q = 0; q < 32; ++q) s_ += PT[q * 16 + tid]; TOT[tid] = s_; }
                __syncthreads();
                if (tid == 0) { int b_ = 0; for (int g = 0; g < 16; ++g) { BASE[g] = b_; b_ += (TOT[g] + 255) & ~255; } BASE[16] = b_; }
                __syncthreads();
                if (bx == 0 && tid < 17) P_gbases[tid] = BASE[tid];
                for (int g = bx; g < 16; g += G) { for (int s_ = BASE[g] + TOT[g] + tid; s_ < BASE[g + 1]; s_ += 512) { P_slot_tok[s_] = -1; P_slot_w[s_] = 0.f; } }
                for (int ch = bx; ch < 256; ch += G) {
                    { const int g = tid & 15, part = tid >> 4; int s_ = 0;
#pragma unroll
                      for (int c = 0; c < 8; ++c) { const int cc = part * 8 + c; s_ += cc < ch ? C[cc * 16 + g] : 0; }
                      PT[512 + part * 16 + g] = s_; }
                    __syncthreads();
                    if (tid < 16) { int s_ = 0; for (int q = 0; q < 32; ++q) s_ += PT[512 + q * 16 + tid]; PRE[tid] = s_; }
                    int e0 = 0, e1 = 0, p0 = 0, p1 = 0;
                    if (tid < 128) { const int t = ch * 128 + tid; e0 = P_tok_e[2 * t]; e1 = 8 + P_tok_e[2 * t + 1];
#pragma unroll
                        for (int g = 0; g < 8; ++g) {
                            const unsigned long long m0 = __ballot(e0 == g), m1 = __ballot(e1 == 8 + g);
                            const int b0 = (int)__builtin_amdgcn_mbcnt_hi((unsigned)(m0 >> 32), __builtin_amdgcn_mbcnt_lo((unsigned)m0, 0u)), b1 = (int)__builtin_amdgcn_mbcnt_hi((unsigned)(m1 >> 32), __builtin_amdgcn_mbcnt_lo((unsigned)m1, 0u));
                            if (e0 == g) p0 = b0;
                            if (e1 == 8 + g) p1 = b1;
                            if (tid == 0) { W0C[g] = __popcll(m0); W0C[8 + g] = __popcll(m1); }
                        } }
                    __syncthreads();
                    if (tid < 128) { const int t = ch * 128 + tid;
                        if (tid >= 64) { p0 += W0C[e0]; p1 += W0C[e1]; }
                        const int s0 = BASE[e0] + PRE[e0] + p0, s1 = BASE[e1] + PRE[e1] + p1;
                        P_slot_tok[s0] = t; P_slot_w[s0] = P_tok_w[2 * t] * (1.0f / (pg8::F8S_ACT * pg8::F8S_WDN)); P_slot_tok[s1] = t; P_slot_w[s1] = P_tok_w[2 * t + 1] * (1.0f / (pg8::F8S_ACT * pg8::F8S_WDN)); }
                    __syncthreads();
                }
            }
            SEAM(pb + 7);
            LAS int* tg = (LAS int*)(lds + TG_OFF);
            if (IN(pb + 8) || IN(pb + 9) || IN(pb + 10) || IN(pb + 11)) {
                PHASE_TID;
                if (tid < 288) { const int r = tid * 256; int g = 0; int gb[16];
#pragma unroll
                    for (int q = 0; q < 16; ++q) gb[q] = P_gbases[q];
#pragma unroll
                    for (int q = 1; q < 16; ++q) if (r >= gb[q]) g = q;
                    tg[tid] = g; }
                __syncthreads();
            }
            if (IN(pb + 8)) REPFOR(10) {
                REPBAR;
                const int nT = __builtin_amdgcn_readfirstlane(P_gbases[16] >> 8);
                pg8::Gemm g{(const char*)P_XN, D / 2, D / 2}; pg8::SchedMoe1 S{nT, G, bx, (const char*)P_Wb + WOFF_MGU, P_slot_tok, tg};
                pg8::EpiSwi8<true> E{(unsigned char*)P_Z, DFE};
                pg8::gemm_phase<pg8::EpiSwi8<true>, pg8::SchedMoe1, true, true>(lds, g, S, E, wave);
            }
            SEAM(pb + 8);
            if (IN(pb + 9)) {
                const int t0 = 0, nT = 128;
                pg8::Gemm g{(const char*)P_Z, DFE / 2, DFE / 2}; pg8::SchedMoe2 S{t0, nT, G, bx, (const char*)P_Wb + WOFF_MDN, tg};
                pg8::EpiMoeDown<true> E{P_slot_tok, P_slot_w, P_out, P_HS};
                pg8::gemm_phase<pg8::EpiMoeDown<true>, pg8::SchedMoe2, true, true>(lds, g, S, E, wave);
            }
            SEAM(pb + 9);
            if (IN(pb + 10)) {
                const int t0 = __builtin_amdgcn_readfirstlane(P_gbases[8] >> 8), nT = 128;
                {
                    PHASE_TID; const int t2 = __builtin_amdgcn_readfirstlane(P_gbases[16] >> 8);
                    for (int s_ = (t0 + 128) * 256 + gw; s_ < t2 * 256; s_ += NGW) { const int tok = __builtin_amdgcn_readfirstlane(P_slot_tok[s_]);
                        if (tok >= 0) {
#pragma unroll
                            for (int j = 0; j < 4; ++j) { const u32x2 h2 = ((const u32x2*)(P_HS + (size_t)tok * D))[lane + 64 * j];
                                ((f32x4*)(P_out + (size_t)tok * D))[lane + 64 * j] = (f32x4){__uint_as_float(h2.x << 16), __uint_as_float(h2.x & 0xffff0000u), __uint_as_float(h2.y << 16), __uint_as_float(h2.y & 0xffff0000u)}; } } }
                }
                pg8::Gemm g{(const char*)P_Z, DFE / 2, DFE / 2}; pg8::SchedMoe2 S{t0, nT, G, bx, (const char*)P_Wb + WOFF_MDN, tg};
                pg8::EpiMoeDown<false> E{P_slot_tok, P_slot_w, P_out, P_HS};
                pg8::gemm_phase<pg8::EpiMoeDown<false>, pg8::SchedMoe2, true, true>(lds, g, S, E, wave);
            }
            SEAM(pb + 10);
            if (IN(pb + 11)) {
                const int t1 = __builtin_amdgcn_readfirstlane(P_gbases[8] >> 8), s0 = t1 - 128, s1 = __builtin_amdgcn_readfirstlane(P_gbases[16] >> 8) - t1 - 128;
                pg8::Gemm g{(const char*)P_Z, DFE / 2, DFE / 2}; pg8::SchedMoe3 S{s0, s1, t1, G, bx, (const char*)P_Wb + WOFF_MDN, tg};
                pg8::EpiMoeDownAtomic E{P_slot_tok, P_slot_w, P_out};
                pg8::gemm_phase<pg8::EpiMoeDownAtomic, pg8::SchedMoe3, true, true>(lds, g, S, E, wave);
            }
        }
    }
#undef IN
#undef SEAM
#undef REPFOR
#undef REPBAR
#undef PHASE_TID
}

static void launch_mega(const Args& base, int lo, int hi, int grid, unsigned char* ws, hipStream_t stream) {
    Args a = base; a.ph_lo = lo; a.ph_hi = hi;
    (void)hipMemsetAsync(ws + WS_CTL, 0, CTL_ZERO_BYTES, stream);
    hipLaunchKernelGGL(mega, dim3(grid), dim3(NWAVES * 64), LDS_BYTES, stream, a);
}

extern "C" void kernel_launch(void* const* d_in, const int* in_sizes, int n_in, void* d_out, int out_size, void* d_ws, size_t ws_size, hipStream_t stream) {
    float* out = (float*)d_out;
    unsigned char* ws = (unsigned char*)d_ws;

    static int grid = 0;
    if (grid == 0) {
        if (n_in != 25 || ws_size < WS_END) { fprintf(stderr, "kernel_launch: n_in %d ws %zu (need %zu)\n", n_in, ws_size, (size_t)WS_END); grid = -1; return; }
        int dev = 0, cus = 0, per_cu = 0;
        if (hipGetDevice(&dev) != hipSuccess || hipDeviceGetAttribute(&cus, hipDeviceAttributeMultiprocessorCount, dev) != hipSuccess) { grid = -1; return; }
        if (hipFuncSetAttribute((const void*)mega, hipFuncAttributeMaxDynamicSharedMemorySize, LDS_BYTES) != hipSuccess) { fprintf(stderr, "hipFuncSetAttribute failed\n"); grid = -1; return; }
        if (hipOccupancyMaxActiveBlocksPerMultiprocessor(&per_cu, (const void*)mega, NWAVES * 64, LDS_BYTES) != hipSuccess || per_cu < 1) { fprintf(stderr, "occupancy query: %d\n", per_cu); }
        (void)hipGetLastError();
        grid = cus;
    }
    if (grid < 0) return;
    Args base{};
    for (int i = 0; i < 25; ++i) base.in[i] = (const float*)d_in[i];
    base.out = out; base.ws = ws;

    launch_mega(base, 0, 29, grid, ws, stream);
}
```

```cpp
#include <hip/hip_runtime.h>
#include <stdint.h>
#include <stdio.h>

typedef unsigned short bf16_t;
constexpr int T = 32768, D = 1024, SEQ = 2048;
constexpr int INC = 7168;
constexpr int ZP = 3072;
constexpr int OFF_POOL = 0, OFF_CONV = 256, OFF_SGU = 1024, OFF_ATTN = 1536, OFF_GATE = 3072;
constexpr int DFF = 2816, DFE = 3584, NE = 8;
constexpr int YW = 1280;
constexpr float EPS = 1e-6f;

__device__ __forceinline__ float bf2f(bf16_t v) { return __uint_as_float((unsigned)v << 16); }
__device__ __forceinline__ bf16_t f2bf(float f) { unsigned u = __float_as_uint(f); return (bf16_t)((u + 0x7fffu + ((u >> 16) & 1u)) >> 16); }
template <int CTRL> __device__ __forceinline__ float dpp_(float x) { return __builtin_bit_cast(float, __builtin_amdgcn_mov_dpp(__builtin_bit_cast(int, x), CTRL, 0xf, 0xf, true)); }
__device__ __forceinline__ float sum_xor16(float x) { auto s_ = __builtin_amdgcn_permlane16_swap(__float_as_uint(x), __float_as_uint(x), false, false); return __uint_as_float(s_[0]) + __uint_as_float(s_[1]); }
__device__ __forceinline__ float sum_xor32(float x) { auto s_ = __builtin_amdgcn_permlane32_swap(__float_as_uint(x), __float_as_uint(x), false, false); return __uint_as_float(s_[0]) + __uint_as_float(s_[1]); }
__device__ __forceinline__ float max_xor16(float x) { auto s_ = __builtin_amdgcn_permlane16_swap(__float_as_uint(x), __float_as_uint(x), false, false); return fmaxf(__uint_as_float(s_[0]), __uint_as_float(s_[1])); }
__device__ __forceinline__ float max_xor32(float x) { auto s_ = __builtin_amdgcn_permlane32_swap(__float_as_uint(x), __float_as_uint(x), false, false); return fmaxf(__uint_as_float(s_[0]), __uint_as_float(s_[1])); }
__device__ __forceinline__ float quad_sum(float v) { v += dpp_<0xB1>(v); v += dpp_<0x4E>(v); return v; }
__device__ __forceinline__ float wave_sum(float v) {
    v += dpp_<0xB1>(v); v += dpp_<0x4E>(v); v += dpp_<0x141>(v); v += dpp_<0x128>(v);
    return sum_xor32(sum_xor16(v));
}
__device__ __forceinline__ float wave_max(float v) {
    v = fmaxf(v, dpp_<0xB1>(v)); v = fmaxf(v, dpp_<0x4E>(v)); v = fmaxf(v, dpp_<0x141>(v)); v = fmaxf(v, dpp_<0x128>(v));
    return max_xor32(max_xor16(v));
}

__device__ __forceinline__ int rel_bucket(int rel) {
    const int n = rel < 0 ? -rel : rel; int v;
    if (n < 8) v = n; else if (n < 12) v = 8; else if (n < 16) v = 9; else if (n < 23) v = 10; else if (n < 32) v = 11; else if (n < 46) v = 12; else if (n < 64) v = 13; else if (n < 91) v = 14; else v = 15;
    return (rel > 0 ? 16 : 0) + v;
}


#define GAS __attribute__((address_space(1)))
#define LAS __attribute__((address_space(3)))
typedef float f32x4 __attribute__((ext_vector_type(4)));
typedef float f32x2 __attribute__((ext_vector_type(2)));
typedef short bf16x8 __attribute__((ext_vector_type(8)));
typedef unsigned u32x4 __attribute__((ext_vector_type(4)));
typedef unsigned u32x2 __attribute__((ext_vector_type(2)));
typedef int i32x4 __attribute__((ext_vector_type(4)));
typedef int i32x8 __attribute__((ext_vector_type(8)));

constexpr int NWAVES = 8;
constexpr size_t MiB = 1u << 20;
constexpr size_t WS_CTL = 0, CTL_ZERO_BYTES = 64 * 1024;
constexpr size_t WS_CNT = 64 * 1024;
constexpr size_t WS_TOKE = 128 * 1024;
constexpr size_t WS_TOKW = WS_TOKE + 256 * 1024;
constexpr size_t WS_SLOTT = WS_TOKW + 256 * 1024;
constexpr size_t WS_SLOTW = WS_SLOTT + 320 * 1024;
constexpr size_t WS_W = 4 * MiB;
constexpr size_t WOFF_IN = 0;
constexpr size_t WOFF_MRG = WOFF_IN + 2ull * 7168 * 1024 * 2;
constexpr size_t WOFF_OUT = WOFF_MRG + 2ull * 1024 * 1280 * 2;
constexpr size_t WOFF_FGU = WOFF_OUT + 2ull * 1024 * 1024 * 2;
constexpr size_t WOFF_FDN = WOFF_FGU + 5632ull * 1024 * 2;
constexpr size_t WOFF_MGU = WOFF_FDN + 1024ull * 2816 * 2;
constexpr size_t WOFF_XN8 = WOFF_MGU + 56 * MiB;
constexpr size_t WOFF_IN8 = WOFF_MGU + 88 * MiB;
constexpr size_t WOFF_MDN = WOFF_MGU + 8ull * 7168 * 1024 * 2;
constexpr size_t WOFF_SGU = WOFF_MDN + 8ull * 1024 * 3584 * 2;
constexpr size_t WOFF_POOL = WOFF_SGU + 2ull * 4 * 128 * 128 * 2;
constexpr size_t W_BYTES = WOFF_POOL + 2ull * 4 * 64 * 64 * 2;
static_assert(W_BYTES <= 222 * MiB, "weights");
constexpr size_t WS_XN = WS_W + 222 * MiB;
constexpr size_t WS_Z = WS_XN + 64 * MiB;
constexpr size_t WS_G = WS_Z + 192 * MiB;
constexpr size_t WS_Y = WS_Z + 448 * MiB;
constexpr size_t WS_HS = WS_Y + 80 * MiB;
constexpr size_t WS_END = WS_HS + 64 * MiB;
constexpr int SLOT_CAP = 69632;

constexpr int CW_BAR = 1024;
constexpr int RING_BYTES = 131072;
constexpr int MISC_OFF = RING_BYTES + 12288;
constexpr int TG_OFF = MISC_OFF + 256;
constexpr int LDS_BYTES = 151552;

#define XB_TMO      128
#define XB_XCNT(j)  (256  + 64 * (j))
#define XB_XSUB(j)  (1280 + 64 * (j))
#define XB_XGEN(j)  (2304 + 64 * (j))
#define XB_TOP      3328
#define XB_TOPGEN   3392
#define XCD_BAR_WORDS 3456
#define XB_SPIN_CAP (1u << 22)
__device__ __forceinline__ unsigned xb_ld(unsigned* p)              { return __hip_atomic_load(p, __ATOMIC_RELAXED, __HIP_MEMORY_SCOPE_AGENT); }
__device__ __forceinline__ unsigned xb_add(unsigned* p, unsigned v) { return __hip_atomic_fetch_add(p, v, __ATOMIC_RELAXED, __HIP_MEMORY_SCOPE_AGENT); }
__device__ __forceinline__ unsigned xb_xcc_id() { return (unsigned)__builtin_amdgcn_s_getreg((3 << 11) | 20) & 0xFu; }
#define XB_SPIN(cond, bar) do { unsigned _sp = 0; while (cond) { __builtin_amdgcn_s_sleep(1); \
    if ((++_sp & 255u) == 0u) { if (xb_ld(&(bar)[XB_TMO])) break; if (_sp > XB_SPIN_CAP) { atomicAdd(&(bar)[XB_TMO], 1u); break; } } } } while (0)
__device__ __forceinline__ int lane_id() { unsigned m = ~0u; asm volatile("" : "+s"(m)); return (int)__builtin_amdgcn_mbcnt_hi(m, __builtin_amdgcn_mbcnt_lo(m, 0u)); }
struct XcdBarrier { unsigned* bar; unsigned x; volatile LAS unsigned* st; int wave; };
__device__ __forceinline__ XcdBarrier xcd_barrier_post(unsigned* bar, volatile LAS unsigned* st, int wave) {
    XcdBarrier b; b.bar = bar; b.x = xb_xcc_id(); b.st = st; b.wave = wave;
    if (threadIdx.x == 0) (void)xb_add(&bar[XB_XCNT(b.x)], 1u);
    return b;
}
__device__ __forceinline__ void xcd_barrier_complete(unsigned* bar, unsigned x, unsigned& nloc, unsigned& nx) {
    const unsigned G = gridDim.x * gridDim.y * gridDim.z;
    unsigned sum, cnt, mine, sp = 0u;
    for (;;) {
        sum = 0u; cnt = 0u; mine = 0u;
#pragma unroll
        for (unsigned j = 0; j < 16; ++j) { const unsigned c = xb_ld(&bar[XB_XCNT(j)]); sum += c; cnt += (c > 0u) ? 1u : 0u; mine = (j == x) ? c : mine; }
        if (sum == G) break;
        __builtin_amdgcn_s_sleep(1);
        if ((++sp & 255u) == 0u) { if (xb_ld(&bar[XB_TMO])) break; if (sp > XB_SPIN_CAP) { atomicAdd(&bar[XB_TMO], 1u); break; } }
    }
    nloc = mine > 0u ? mine : 1u; nx = cnt > 0u ? cnt : 1u;
}
__device__ __forceinline__ void xcd_barrier(const XcdBarrier& b) {
    asm volatile("s_waitcnt vmcnt(0)" ::: "memory");
    __syncthreads();
    if (b.wave == 0 && lane_id() == 0) {
        unsigned* bar = b.bar; unsigned bx_ = b.x;
        asm volatile("" : "+s"(bar), "+s"(bx_));
        __builtin_amdgcn_s_waitcnt(0);
        unsigned nloc = b.st[0], nx = b.st[1];
        if (nloc == 0u) { xcd_barrier_complete(bar, bx_, nloc, nx); b.st[0] = nloc; b.st[1] = nx; }
        const unsigned old = xb_add(&bar[XB_XSUB(bx_)], 1u);
        const unsigned gen = old / nloc;
        if (old + 1u == (gen + 1u) * nloc) {
            __builtin_amdgcn_fence(__ATOMIC_RELEASE, "agent");
            asm volatile("s_waitcnt vmcnt(0)" ::: "memory");
            const unsigned og = xb_add(&bar[XB_TOP], 1u);
            const unsigned tg = og / nx;
            if (og + 1u == (tg + 1u) * nx) xb_add(&bar[XB_TOPGEN], 1u);
            else XB_SPIN(xb_ld(&bar[XB_TOPGEN]) == tg, bar);
            __builtin_amdgcn_fence(__ATOMIC_ACQUIRE, "agent");
            xb_add(&bar[XB_XGEN(bx_)], 1u);
            asm volatile("s_waitcnt vmcnt(0)" ::: "memory");
        } else {
            XB_SPIN(xb_ld(&bar[XB_XGEN(bx_)]) == gen, bar);
            __builtin_amdgcn_fence(__ATOMIC_ACQUIRE, "agent");
            asm volatile("s_waitcnt vmcnt(0)" ::: "memory");
        }
    }
    __syncthreads();
}

namespace pg8 {
constexpr int BM = 256, BK = 64, HALF = 128, HTB = HALF * BK * 2, STAGE_BYTES = 8 * HTB, NXCD = 8;
#ifndef WGM_BIG
#define WGM_BIG 2
#endif
#ifndef WGM_SMALL
#define WGM_SMALL 4
#endif
__host__ __device__ __forceinline__ int lds_byte(int r, int c) { const int st = (r >> 4) * 2 + (c >> 5), rr = r & 15, cc = c & 31, ob = rr * 64 + cc * 2; return st * 1024 + (ob ^ (((ob >> 9) & 1) << 5)); }
__host__ __device__ __forceinline__ void stage_rc(int b, int& R, int& C) { const int st = b / 1024, sb = b % 1024, swz = sb ^ (((sb >> 9) & 1) << 5); R = (st >> 1) * 16 + swz / 64; C = (st & 1) * 32 + (swz % 64) / 2; }
__host__ __device__ __forceinline__ int perm32(int rho) { const int n = rho >> 4, i = rho & 15; return 8 * (i >> 2) + 4 * n + (i & 3); }

struct Unit { int pm, pn, kb, nt, idx; const char* B; };
struct Gemm { const char* A; int lda, ldb; };

__device__ __forceinline__ bool static_tile(int nM, int nN, int G, int c, int i, int& pm, int& pn) {
    const int WGM = nN > 4 ? WGM_BIG : WGM_SMALL;
    const int nwg = nM * nN; const long L = (long)i * G + c; if (L >= nwg) return false;
    int wgid = (int)L; { const int q = nwg / NXCD, r = nwg % NXCD, xcd = wgid % NXCD, off = wgid / NXCD; wgid = (xcd < r ? xcd * (q + 1) : r * (q + 1) + (xcd - r) * q) + off; }
    const int nig = WGM * nN, gid = wgid / nig, fm = gid * WGM, gsz = (nM - fm) < WGM ? (nM - fm) : WGM;
    pm = fm + ((wgid % nig) % gsz); pn = (wgid % nig) / gsz; return true;
}
struct SchedPlain {
    static constexpr bool GATHER = false;
    int nM, nN, G, c, nt; const char* B;
    __device__ __forceinline__ bool next(int i, Unit& u) const { if (!static_tile(nM, nN, G, c, i, u.pm, u.pn)) return false; u.kb = 0; u.nt = nt; u.B = B; return true; }
    __device__ __forceinline__ int arow(const Unit& u, int r) const { return u.pm * BM + r; }
};
struct SchedPlainRev {
    static constexpr bool GATHER = false;
    int nM, nN, G, c, nt; const char* B;
    __device__ __forceinline__ bool next(int i, Unit& u) const { if (!static_tile(nM, nN, G, c, i, u.pm, u.pn)) return false; u.pm = nM - 1 - u.pm; u.kb = 0; u.nt = nt; u.B = B; return true; }
    __device__ __forceinline__ int arow(const Unit& u, int r) const { return u.pm * BM + r; }
};
struct SchedPlainOff {
    static constexpr bool GATHER = false;
    int nM, nN, pn0, G, c, nt; const char* B;
    __device__ __forceinline__ bool next(int i, Unit& u) const { if (!static_tile(nM, nN, G, c, i, u.pm, u.pn)) return false; u.pn += pn0; u.kb = 0; u.nt = nt; u.B = B; return true; }
    __device__ __forceinline__ int arow(const Unit& u, int r) const { return u.pm * BM + r; }
};
struct SchedMerge {
    static constexpr bool GATHER = false;
    int nM, nN, G, c; const char* B;
    __device__ __forceinline__ bool next(int i, Unit& u) const { if (!static_tile(nM, nN, G, c, i >> 2, u.pm, u.pn)) return false; const int br = i & 3; u.kb = br * 512; u.nt = br == 3 ? 8 : 4; u.idx = i; u.B = B; return true; }
    __device__ __forceinline__ int arow(const Unit& u, int r) const { return u.pm * BM + r; }
};
struct SchedMoe1 {
    static constexpr bool GATHER = true;
    int nT, G, c; const char* B; const int* slot_tok; const LAS int* tg;
    __device__ __forceinline__ bool next(int i, Unit& u) const { if (!static_tile(nT, 28, G, c, i, u.pm, u.pn)) return false; u.kb = 0; u.nt = 8; u.B = B + (size_t)(__builtin_amdgcn_readfirstlane(tg[u.pm]) & 7) * (7168ull * 1024); return true; }
    __device__ __forceinline__ int arow(const Unit& u, int r) const { const int t = slot_tok[u.pm * BM + r]; return t < 0 ? 0 : t; }
};
struct SchedMoe2 {
    static constexpr bool GATHER = false;
    int t0, nT, G, c; const char* B; const LAS int* tg;
    __device__ __forceinline__ bool next(int i, Unit& u) const { if (!static_tile(nT, 4, G, c, i, u.pm, u.pn)) return false; u.pm = t0 + nT - 1 - u.pm; u.kb = 0; u.nt = 28; u.B = B + (size_t)(__builtin_amdgcn_readfirstlane(tg[u.pm]) & 7) * (1024ull * 3584); return true; }
    __device__ __forceinline__ int arow(const Unit& u, int r) const { return u.pm * BM + r; }
};

struct SchedMoe3 {
    static constexpr bool GATHER = false;
    int s0, s1, t1, G, c; const char* B; const LAS int* tg;
    __device__ __forceinline__ bool next(int i, Unit& u) const { const int L = i * G + c; if (L >= (s0 + s1) * 16) return false; const int kp = L & 3, st = L >> 4;
        u.pn = (L >> 2) & 3; u.pm = st < s0 ? 128 + st : t1 + 128 + (st - s0); u.kb = (kp < 2 ? kp * 8 : 16 + (kp - 2) * 6) * 128; u.nt = kp < 2 ? 8 : 6; u.B = B + (size_t)(__builtin_amdgcn_readfirstlane(tg[u.pm]) & 7) * (1024ull * 3584); return true; }
    __device__ __forceinline__ int arow(const Unit& u, int r) const { return u.pm * BM + r; }
};

__device__ __forceinline__ unsigned cvt_pk_bf16(float lo, float hi) { unsigned r; asm volatile("v_cvt_pk_bf16_f32 %0, %1, %2" : "=v"(r) : "v"(lo), "v"(hi)); return r; }
__device__ __forceinline__ f32x2 gelu_pk(f32x2 v) {
    const f32x2 av = __builtin_elementwise_abs(v), d = av * 0.2316418882f + 1.0f;
    f32x2 t; t.x = __builtin_amdgcn_rcpf(d.x); t.y = __builtin_amdgcn_rcpf(d.y);
    f32x2 q = t * 0.5307027145f + (-0.7265760135f); q = q * t + 0.7107068705f; q = q * t + (-0.142248368f); q = q * t + 0.127414796f; q = q * t;
    const f32x2 s = (v * v) * (-0.72134752044f);
    f32x2 e; e.x = __builtin_amdgcn_exp2f(s.x); e.y = __builtin_amdgcn_exp2f(s.y);
    const f32x2 m = v * (q * e), r = v - m;
    f32x2 o; o.x = v.x < 0.f ? m.x : r.x; o.y = v.y < 0.f ? m.y : r.y; return o;
}
__device__ __forceinline__ void swiglu8(const f32x4 G0, const f32x4 G1, const f32x4 U0, const f32x4 U1, float negl, float c2, f32x4& v0, f32x4& v1) {
    const f32x4 a0 = G0 * negl, a1 = G1 * negl;
    f32x4 e0, e1;
#pragma unroll
    for (int j = 0; j < 4; ++j) { e0[j] = __builtin_amdgcn_exp2f(a0[j]); e1[j] = __builtin_amdgcn_exp2f(a1[j]); }
    const f32x4 p0 = (G0 * U0) * c2, p1 = (G1 * U1) * c2;
    const f32x4 d0 = e0 + 1.0f, d1 = e1 + 1.0f;
    f32x4 r0, r1;
#pragma unroll
    for (int j = 0; j < 4; ++j) { r0[j] = __builtin_amdgcn_rcpf(d0[j]); r1[j] = __builtin_amdgcn_rcpf(d1[j]); }
    v0 = p0 * r0; v1 = p1 * r1;
}
__device__ __forceinline__ void sigm8(f32x4& v0, f32x4& v1, float negl) {
    const f32x4 a0 = v0 * negl, a1 = v1 * negl;
    f32x4 e0, e1;
#pragma unroll
    for (int j = 0; j < 4; ++j) { e0[j] = __builtin_amdgcn_exp2f(a0[j]); e1[j] = __builtin_amdgcn_exp2f(a1[j]); }
    const f32x4 d0 = e0 + 1.0f, d1 = e1 + 1.0f;
#pragma unroll
    for (int j = 0; j < 4; ++j) { v0[j] = __builtin_amdgcn_rcpf(d0[j]); v1[j] = __builtin_amdgcn_rcpf(d1[j]); }
}
__device__ __forceinline__ float sigm(float v) { return __builtin_amdgcn_rcpf(1.0f + __builtin_amdgcn_exp2f(-1.44269504089f * v)); }

template <bool IN8>
struct EpiZ {
    static constexpr bool PERM = true, CHAIN = false;
    bf16_t* Z; bf16_t* Gt; const float* qg; const float* kg; LAS float* X;
    __device__ __forceinline__ void operator()(const f32x4 (&acc)[2][2][4][2], const Unit& u, int wr, int wc, int fr, int fq) const {
        asm volatile("" : "+v"(fr), "+v"(fq));
        const int row0 = u.pm * BM + wr * 64 + fr, col0 = u.pn * BM + wc * 32 + 8 * fq;
        const int mode = (u.pn >= 12) ? 2 : ((u.pn == 4 || u.pn == 5) ? 1 : ((u.pn >= 6 && u.pn <= 9) ? 3 : 0));
        const unsigned toff = (unsigned)(((wr * 4 + wc) * 64 + fq * 16 + fr) * 16);
        const int gti = u.pn - 12;
        char* gbase = (char*)Gt + (size_t)(((gti >> 2) * 128 + u.pm) * 4 + (gti & 3)) * 131072 + toff;
        float rs[2][4][2];
#pragma unroll
        for (int ai = 0; ai < 2; ++ai)
#pragma unroll
            for (int m = 0; m < 4; ++m) { rs[ai][m][0] = 1.f; rs[ai][m][1] = 1.f; }
        f32x4 g0 = {1.f, 1.f, 1.f, 1.f}, g1 = {1.f, 1.f, 1.f, 1.f};
        if (mode == 3) {
#pragma unroll
            for (int ai = 0; ai < 2; ++ai)
#pragma unroll
                for (int m = 0; m < 4; ++m)
#pragma unroll
                    for (int bj = 0; bj < 2; ++bj) { const f32x4 v0 = acc[ai][bj][m][0], v1 = acc[ai][bj][m][1];
                        float ss = (v0[0] * v0[0] + v0[1] * v0[1]) + (v0[2] * v0[2] + v0[3] * v0[3]) + (v1[0] * v1[0] + v1[1] * v1[1]) + (v1[2] * v1[2] + v1[3] * v1[3]);
                        ss = sum_xor32(sum_xor16(ss));
                        if (fq == 0) X[((ai * 128 + wr * 64 + m * 16 + fr) * 2 + bj) * 4 + wc] = ss;
                        rs[ai][m][bj] = ss; }
            asm volatile("s_waitcnt lgkmcnt(0)\n\ts_barrier" ::: "memory");
#pragma unroll
            for (int ai = 0; ai < 2; ++ai)
#pragma unroll
                for (int m = 0; m < 4; ++m)
#pragma unroll
                    for (int bj = 0; bj < 2; ++bj) rs[ai][m][bj] = rsqrtf((rs[ai][m][bj] + X[((ai * 128 + wr * 64 + m * 16 + fr) * 2 + bj) * 4 + (wc ^ 1)]) * (1.0f / 64.0f) + EPS);
            const float* gp = (u.pn < 8 ? qg : kg) + 32 * (wc & 1) + 8 * fq;
            const float qs_ = u.pn < 8 ? 0.125f * 1.4426950408889634f : 1.0f;
            g0 = *(const f32x4*)gp * qs_; g1 = *(const f32x4*)(gp + 4) * qs_;
            asm volatile("s_waitcnt lgkmcnt(0)\n\ts_barrier" ::: "memory");
        }
#pragma unroll
        for (int ai = 0; ai < 2; ++ai)
#pragma unroll
            for (int m = 0; m < 4; ++m) { bf16_t* rowp = Z + (size_t)(row0 + ai * HALF + m * 16) * ZP + col0;
#pragma unroll
                for (int bj = 0; bj < 2; ++bj) { f32x4 v0 = acc[ai][bj][m][0], v1 = acc[ai][bj][m][1];
                    if (mode == 1) { f32x2 a = gelu_pk((f32x2){v0[0], v0[1]}), b = gelu_pk((f32x2){v0[2], v0[3]}), c = gelu_pk((f32x2){v1[0], v1[1]}), d = gelu_pk((f32x2){v1[2], v1[3]});
                        v0 = (f32x4){a.x, a.y, b.x, b.y}; v1 = (f32x4){c.x, c.y, d.x, d.y}; }
                    else if (mode == 2) { sigm8(v0, v1, IN8 ? -1.44269504089f / 1024.0f : -1.44269504089f); v0 = __builtin_elementwise_max(v0, (f32x4){1e-20f, 1e-20f, 1e-20f, 1e-20f}); v1 = __builtin_elementwise_max(v1, (f32x4){1e-20f, 1e-20f, 1e-20f, 1e-20f}); }
                    else if (mode == 3) { const float r = rs[ai][m][bj]; v0 = v0 * g0 * r; v1 = v1 * g1 * r; }
                    u32x4 w; w.x = cvt_pk_bf16(v0[0], v0[1]); w.y = cvt_pk_bf16(v0[2], v0[3]); w.z = cvt_pk_bf16(v1[0], v1[1]); w.w = cvt_pk_bf16(v1[2], v1[3]);
                    if (mode == 2) *(u32x4*)(gbase + ((ai * 4 + m) * 2 + bj) * 8192) = w; else *(u32x4*)(rowp + bj * HALF) = w; } }
    }
};
__device__ __forceinline__ float sat8(float v) { return __builtin_amdgcn_fmed3f(v, -448.f, 448.f); }
__device__ __forceinline__ unsigned pk4_fp8(float a, float b, float c, float d) { unsigned w = 0; w = __builtin_amdgcn_cvt_pk_fp8_f32(a, b, w, false); w = __builtin_amdgcn_cvt_pk_fp8_f32(c, d, w, true); return w; }
constexpr float F8S_HN = 16.f, F8S_WGU = 64.f, F8S_ACT = 4.f, F8S_WDN = 128.f;
template <bool IN8>
struct EpiSwi8 {
    static constexpr bool PERM = true, CHAIN = false;
    unsigned char* ACT; int ldc;
    __device__ __forceinline__ void operator()(const f32x4 (&acc)[2][2][4][2], const Unit& u, int wr, int wc, int fr, int fq) const {
        asm volatile("" : "+v"(fr), "+v"(fq));
        const int row0 = u.pm * BM + wr * 64 + fr, col0 = u.pn * HALF + wc * 32 + 8 * fq;
        constexpr float US = IN8 ? 1.0f / (F8S_HN * F8S_WGU) : 1.0f;
#pragma unroll
        for (int ai = 0; ai < 2; ++ai)
#pragma unroll
            for (int m = 0; m < 4; ++m) { unsigned char* rowp = ACT + (size_t)(row0 + ai * HALF + m * 16) * ldc + col0;
                f32x4 v0, v1;
                swiglu8(acc[ai][0][m][0], acc[ai][0][m][1], acc[ai][1][m][0], acc[ai][1][m][1], -1.44269504089f * US, US * US * F8S_ACT, v0, v1);
                u32x2 w; w.x = pk4_fp8(sat8(v0[0]), sat8(v0[1]), sat8(v0[2]), sat8(v0[3])); w.y = pk4_fp8(sat8(v1[0]), sat8(v1[1]), sat8(v1[2]), sat8(v1[3]));
                *(u32x2*)rowp = w; }
    }
};
struct EpiSwi {
    static constexpr bool PERM = true, CHAIN = false;
    bf16_t* ACT; int ldc;
    __device__ __forceinline__ void operator()(const f32x4 (&acc)[2][2][4][2], const Unit& u, int wr, int wc, int fr, int fq) const {
        asm volatile("" : "+v"(fr), "+v"(fq));
        const int row0 = u.pm * BM + wr * 64 + fr, col0 = u.pn * HALF + wc * 32 + 8 * fq;
#pragma unroll
        for (int ai = 0; ai < 2; ++ai)
#pragma unroll
            for (int m = 0; m < 4; ++m) { bf16_t* rowp = ACT + (size_t)(row0 + ai * HALF + m * 16) * ldc + col0;
                f32x4 v0, v1;
                swiglu8(acc[ai][0][m][0], acc[ai][0][m][1], acc[ai][1][m][0], acc[ai][1][m][1], -1.44269504089f, 1.0f, v0, v1);
                u32x4 w; w.x = cvt_pk_bf16(v0[0], v0[1]); w.y = cvt_pk_bf16(v0[2], v0[3]); w.z = cvt_pk_bf16(v1[0], v1[1]); w.w = cvt_pk_bf16(v1[2], v1[3]);
                *(u32x4*)rowp = w; }
    }
};
template <bool INBF, bool OUTBF, bool F8ACC = false>
struct EpiResid {
    static constexpr bool PERM = false, CHAIN = false;
    const void* hin; void* out;
    __device__ __forceinline__ void operator()(const f32x4 (&acc)[2][2][4][2], const Unit& u, int wr, int wc, int fr, int fq) const {
        asm volatile("" : "+v"(fr), "+v"(fq));
        const int row0 = u.pm * BM + wr * 64 + fr, col0 = u.pn * BM + wc * 32 + 4 * fq;
#pragma unroll
        for (int ai = 0; ai < 2; ++ai) {
            f32x4 hv[4][2][2];
#pragma unroll
            for (int m = 0; m < 4; ++m) { const size_t ro = (size_t)(row0 + ai * HALF + m * 16) * D + col0;
#pragma unroll
                for (int bj = 0; bj < 2; ++bj)
#pragma unroll
                    for (int n = 0; n < 2; ++n) {
                        if constexpr (INBF) { const u32x2 h2 = *(const u32x2*)((const bf16_t*)hin + ro + bj * HALF + n * 16);
                            hv[m][bj][n] = (f32x4){__uint_as_float(h2.x << 16), __uint_as_float(h2.x & 0xffff0000u), __uint_as_float(h2.y << 16), __uint_as_float(h2.y & 0xffff0000u)}; }
                        else hv[m][bj][n] = *(const f32x4*)((const float*)hin + ro + bj * HALF + n * 16); } }
            asm volatile("" ::: "memory");
#pragma unroll
            for (int m = 0; m < 4; ++m) { const size_t ro = (size_t)(row0 + ai * HALF + m * 16) * D + col0;
#pragma unroll
                for (int bj = 0; bj < 2; ++bj)
#pragma unroll
                    for (int n = 0; n < 2; ++n) { const f32x4 v = F8ACC ? hv[m][bj][n] + acc[ai][bj][m][n] * (1.0f / (F8S_ACT * F8S_WDN)) : hv[m][bj][n] + acc[ai][bj][m][n];
                        if constexpr (OUTBF) { u32x2 hb; hb.x = cvt_pk_bf16(v[0], v[1]); hb.y = cvt_pk_bf16(v[2], v[3]); *(u32x2*)((bf16_t*)out + ro + bj * HALF + n * 16) = hb; }
                        else *(f32x4*)((float*)out + ro + bj * HALF + n * 16) = v; } }
            asm volatile("" ::: "memory");
        }
    }
};
template <bool FIRST>
struct EpiMoeDown {
    static constexpr bool PERM = false, CHAIN = false;
    const int* slot_tok; const float* slot_w; float* out; bf16_t* hs;
    __device__ __forceinline__ void operator()(const f32x4 (&acc)[2][2][4][2], const Unit& u, int wr, int wc, int fr, int fq) const {
        asm volatile("" : "+v"(fr), "+v"(fq));
        const int row0 = u.pm * BM + wr * 64 + fr, col0 = u.pn * BM + wc * 32 + 4 * fq;
#pragma unroll
        for (int ai = 0; ai < 2; ++ai) {
            int tk[4]; float ww[4];
#pragma unroll
            for (int m = 0; m < 4; ++m) { const int slot = row0 + ai * HALF + m * 16; tk[m] = slot_tok[slot]; ww[m] = slot_w[slot]; }
            f32x4 hv[4][2][2];
#pragma unroll
            for (int m = 0; m < 4; ++m) { const size_t ro = (size_t)(tk[m] < 0 ? 0 : tk[m]) * D + col0;
#pragma unroll
                for (int bj = 0; bj < 2; ++bj)
#pragma unroll
                    for (int n = 0; n < 2; ++n) {
                        { const u32x2 h2 = *(const u32x2*)(hs + ro + bj * HALF + n * 16);
                            hv[m][bj][n] = (f32x4){__uint_as_float(h2.x << 16), __uint_as_float(h2.x & 0xffff0000u), __uint_as_float(h2.y << 16), __uint_as_float(h2.y & 0xffff0000u)}; } } }
            asm volatile("" ::: "memory");
#pragma unroll
            for (int m = 0; m < 4; ++m) { if (tk[m] >= 0) { const size_t ro = (size_t)tk[m] * D + col0; const float w = ww[m];
#pragma unroll
                for (int bj = 0; bj < 2; ++bj)
#pragma unroll
                    for (int n = 0; n < 2; ++n) { const f32x4 v = hv[m][bj][n] + acc[ai][bj][m][n] * w;
                        if constexpr (FIRST) { u32x2 hb; hb.x = cvt_pk_bf16(v[0], v[1]); hb.y = cvt_pk_bf16(v[2], v[3]); *(u32x2*)(hs + ro + bj * HALF + n * 16) = hb; }
                        else *(f32x4*)(out + ro + bj * HALF + n * 16) = v; } } }
            asm volatile("" ::: "memory");
        }
    }
};
struct EpiMoeDownAtomic {
    static constexpr bool PERM = false, CHAIN = false;
    const int* slot_tok; const float* slot_w; float* out;
    __device__ __forceinline__ void operator()(const f32x4 (&acc)[2][2][4][2], const Unit& u, int wr, int wc, int fr, int fq) const {
        asm volatile("" : "+v"(fr), "+v"(fq));
        const int row0 = u.pm * BM + wr * 64 + fr, col0 = u.pn * BM + wc * 32 + 4 * fq;
#pragma unroll
        for (int ai = 0; ai < 2; ++ai)
#pragma unroll
            for (int m = 0; m < 4; ++m) { const int slot = row0 + ai * HALF + m * 16; const int tok = slot_tok[slot]; const float w = slot_w[slot];
                if (tok >= 0) { float* ro = out + (size_t)tok * D + col0;
#pragma unroll
                    for (int bj = 0; bj < 2; ++bj)
#pragma unroll
                        for (int n = 0; n < 2; ++n)
#pragma unroll
                            for (int e = 0; e < 4; ++e) __hip_atomic_fetch_add(ro + bj * HALF + n * 16 + e, acc[ai][bj][m][n][e] * w, __ATOMIC_RELAXED, __HIP_MEMORY_SCOPE_AGENT); } }
    }
};
struct EpiMerge {
    static constexpr bool PERM = true, CHAIN = true;
    const bf16_t* Gt; bf16_t* MG;
    __device__ __forceinline__ bool resets(const Unit& u) const { return (u.kb >> 9) == 3; }
    __device__ __forceinline__ void operator()(f32x4 (&acc)[2][2][4][2], const Unit& u, int wr, int wc, int fr, int fq) const {
        asm volatile("" : "+v"(fr), "+v"(fq));
        const unsigned toff = (unsigned)(((wr * 4 + wc) * 64 + fq * 16 + fr) * 16);
        const int br = u.kb >> 9;
        const unsigned moff = (unsigned)((wr * 64 + fr) * D + wc * 32 + 8 * fq) * 2u;
        const char* gt = (const char*)Gt + (size_t)((br * 128 + u.pm) * 4 + u.pn) * 131072 + toff;
        const size_t nxo = br != 3 ? (size_t)128 * 4 * 131072 : 0;
        char* mt = (char*)MG + ((size_t)u.pm * BM * D + u.pn * BM) * 2;
        u32x4 gq[2][4], nq[2][4];
#define MRG_LOAD(slot_, q_) do { _Pragma("unroll") for (int c_ = 0; c_ < 4; ++c_) { const size_t o_ = (size_t)(((((q_) >> 1) * 4 + 2 * ((q_) & 1) + (c_ >> 1)) * 2 + (c_ & 1)) * 8192); \
            gq[slot_][c_] = *(const u32x4*)(gt + o_); nq[slot_][c_] = *(const u32x4*)(gt + o_ + nxo); } } while (0)
        MRG_LOAD(0, 0); MRG_LOAD(1, 1);
#pragma unroll
        for (int q = 0; q < 4; ++q) {
            const int sl = q & 1, ai = q >> 1, mh = q & 1;
#pragma unroll
            for (int cp = 0; cp < 4; cp += 2) {
                f32x4 ga[2], gb[2];
#pragma unroll
                for (int c = 0; c < 2; ++c) { const u32x4 g4 = gq[sl][cp + c];
                    ga[c] = (f32x4){__uint_as_float(g4.x << 16), __uint_as_float(g4.x & 0xffff0000u), __uint_as_float(g4.y << 16), __uint_as_float(g4.y & 0xffff0000u)};
                    gb[c] = (f32x4){__uint_as_float(g4.z << 16), __uint_as_float(g4.z & 0xffff0000u), __uint_as_float(g4.w << 16), __uint_as_float(g4.w & 0xffff0000u)}; }
                if (br != 3) {
                    f32x4 ra[2], rb[2];
#pragma unroll
                    for (int c = 0; c < 2; ++c) { const u32x4 n4 = nq[sl][cp + c];
                        ra[c] = (f32x4){__builtin_amdgcn_rcpf(__uint_as_float(n4.x << 16)), __builtin_amdgcn_rcpf(__uint_as_float(n4.x & 0xffff0000u)), __builtin_amdgcn_rcpf(__uint_as_float(n4.y << 16)), __builtin_amdgcn_rcpf(__uint_as_float(n4.y & 0xffff0000u))};
                        rb[c] = (f32x4){__builtin_amdgcn_rcpf(__uint_as_float(n4.z << 16)), __builtin_amdgcn_rcpf(__uint_as_float(n4.z & 0xffff0000u)), __builtin_amdgcn_rcpf(__uint_as_float(n4.w << 16)), __builtin_amdgcn_rcpf(__uint_as_float(n4.w & 0xffff0000u))}; }
#pragma unroll
                    for (int c = 0; c < 2; ++c) { const int m = 2 * mh + ((cp + c) >> 1), bj = (cp + c) & 1; acc[ai][bj][m][0] *= ga[c] * ra[c]; acc[ai][bj][m][1] *= gb[c] * rb[c]; }
                } else {
#pragma unroll
                    for (int c = 0; c < 2; ++c) { const int m = 2 * mh + ((cp + c) >> 1), bj = (cp + c) & 1;
                        const f32x4 v0 = acc[ai][bj][m][0] * ga[c], v1 = acc[ai][bj][m][1] * gb[c];
                        u32x4 w; w.x = cvt_pk_bf16(v0[0], v0[1]); w.y = cvt_pk_bf16(v0[2], v0[3]); w.z = cvt_pk_bf16(v1[0], v1[1]); w.w = cvt_pk_bf16(v1[2], v1[3]);
                        *(u32x4*)(mt + (size_t)((ai * HALF + m * 16) * D + bj * HALF) * 2 + moff) = w; }
                }
            }
            asm volatile("" ::: "memory");
            if (q + 2 < 4) { if (q == 0) MRG_LOAD(0, 2); else MRG_LOAD(1, 3); }
        }
#undef MRG_LOAD
    }
};

template <class Sched> __device__ __forceinline__ unsigned a_off(const Sched& S, const Unit& u, int lda, int tid, int h, int i) {
    int R, C; stage_rc(tid * 16 + i * 8192, R, C);
    if constexpr (Sched::GATHER) return (unsigned)(S.arow(u, h * HALF + R) * lda + C) * 2u; else return (unsigned)((h * HALF + R) * lda + C) * 2u;
}
constexpr int TOKB_OFF = STAGE_BYTES + 8192;
__device__ __forceinline__ unsigned a_off_lds(const LAS unsigned char* lds, int par, int lda, int tid, int h, int i) {
    int R, C; stage_rc(tid * 16 + i * 8192, R, C);
    int t = *(const LAS int*)(lds + TOKB_OFF + par * 1024 + (h * HALF + R) * 4); t = t < 0 ? 0 : t;
    return (unsigned)(t * lda + C) * 2u;
}
template <class Epi, class Sched, bool ALIGN_EPI, bool F8 = false>
__device__ __forceinline__ void gemm_phase(LAS unsigned char* lds, const Gemm g, const Sched& S, const Epi& E, int wave_) {
    int tid = wave_ * 64 + lane_id(); asm volatile("" : "+v"(tid));
    const int wid = __builtin_amdgcn_readfirstlane(tid >> 6), lane = tid & 63, wr = wid >> 2, wc = wid & 3, fr = lane & 15, fq = lane >> 4;
    unsigned voffB[2];
#pragma unroll
    for (int i = 0; i < 2; ++i) { int R, C; stage_rc(tid * 16 + i * 8192, R, C); const int Rb = Epi::PERM ? ((R & ~31) + perm32(R & 31)) : R; voffB[i] = (unsigned)(Rb * g.ldb + C) * 2u; }
    const size_t kstep = (size_t)(BK * 2);
    const size_t hstepB = (size_t)HALF * g.ldb * 2, tstepB = 2 * hstepB;
    const size_t tstepA = (size_t)BM * g.lda * 2;
    const unsigned ldsw = (unsigned)wid * 1024u;
    const int aoff = lds_byte(wr * 64 + fr, fq * 8), boff = lds_byte(wc * 32 + fr, fq * 8);
#define PG8_SA(b, h) (((b) * 2 + (h)) * HTB)
#define PG8_SB(b, h) ((4 + (b) * 2 + (h)) * HTB)
#define PG8_STAGE2(bufoff, gbase, v0_, v1_) do { \
        __builtin_amdgcn_global_load_lds((const unsigned*)((const char*)(gbase) + (v0_)), (LAS unsigned*)(lds + (bufoff) + ldsw), 16, 0, 0); \
        __builtin_amdgcn_global_load_lds((const unsigned*)((const char*)(gbase) + (v1_)), (LAS unsigned*)(lds + (bufoff) + ldsw + 8192), 16, 0, 0); } while (0)
#define PG8_STAGEB(bufoff, gbase) PG8_STAGE2(bufoff, gbase, voffB[0], voffB[1])
#define PG8_AOFF(u_, h_, i_) a_off<Sched>(S, u_, g.lda, tid, h_, i_)
#define PG8_ABASE(u_) (Sched::GATHER ? g.A + (u_).kb : g.A + (size_t)(u_).pm * tstepA + (u_).kb)
#define PG8_LDA(dst, b, h) do { _Pragma("unroll") for (int m = 0; m < 4; ++m) { \
        if constexpr (F8) { const i32x4 lo_ = *(const LAS i32x4*)(lds + PG8_SA(b, h) + aoff + m * 2048), hi_ = *(const LAS i32x4*)(lds + PG8_SA(b, h) + aoff + m * 2048 + 1024); dst##8[m] = __builtin_shufflevector(lo_, hi_, 0, 1, 2, 3, 4, 5, 6, 7); } \
        else { _Pragma("unroll") for (int k = 0; k < 2; ++k) dst[m][k] = *(const LAS bf16x8*)(lds + PG8_SA(b, h) + aoff + m * 2048 + k * 1024); } } } while (0)
#define PG8_LDB(dst, b, h) do { _Pragma("unroll") for (int n = 0; n < 2; ++n) { \
        if constexpr (F8) { const i32x4 lo_ = *(const LAS i32x4*)(lds + PG8_SB(b, h) + boff + n * 2048), hi_ = *(const LAS i32x4*)(lds + PG8_SB(b, h) + boff + n * 2048 + 1024); dst##8[n] = __builtin_shufflevector(lo_, hi_, 0, 1, 2, 3, 4, 5, 6, 7); } \
        else { _Pragma("unroll") for (int k = 0; k < 2; ++k) dst[n][k] = *(const LAS bf16x8*)(lds + PG8_SB(b, h) + boff + n * 2048 + k * 1024); } } } while (0)
#define PG8_MMA(ai, bj, At, Bt) do { __builtin_amdgcn_s_setprio(1); _Pragma("unroll") for (int m = 0; m < 4; ++m) _Pragma("unroll") for (int n = 0; n < 2; ++n) { \
        if constexpr (F8) asm volatile("v_mfma_f32_16x16x128_f8f6f4 %0, %1, %2, %0" : "+v"(acc[ai][bj][m][n]) : "v"(Bt##8[n]), "v"(At##8[m])); \
        else { _Pragma("unroll") for (int k = 0; k < 2; ++k) acc[ai][bj][m][n] = __builtin_amdgcn_mfma_f32_16x16x32_bf16(Bt[n][k], At[m][k], acc[ai][bj][m][n], 0, 0, 0); } } \
        __builtin_amdgcn_s_setprio(0); } while (0)
#define PG8_WAIT_V(n) asm volatile("s_waitcnt vmcnt(" #n ")" ::: "memory")
#define PG8_WAIT_L(n) asm volatile("s_waitcnt lgkmcnt(" #n ")" ::: "memory")
#define PG8_BAR __builtin_amdgcn_s_barrier()
#define PG8_SCHED __builtin_amdgcn_sched_barrier(0)
    Unit cur, nxt; int ui = 0;
    if (!S.next(0, cur)) return;
    f32x4 acc[2][2][4][2];
#pragma unroll
    for (int a = 0; a < 2; ++a)
#pragma unroll
        for (int b = 0; b < 2; ++b)
#pragma unroll
            for (int m = 0; m < 4; ++m)
#pragma unroll
                for (int n = 0; n < 2; ++n) acc[a][b][m][n] = (f32x4){0.f, 0.f, 0.f, 0.f};
    bf16x8 At[4][2], B0[2][2], B1[2][2];
    i32x8 At8[4], B08[2], B18[2];
    unsigned ca00 = PG8_AOFF(cur, 0, 0), ca01 = PG8_AOFF(cur, 0, 1), ca10 = PG8_AOFF(cur, 1, 0), ca11 = PG8_AOFF(cur, 1, 1);
    const char* cA = PG8_ABASE(cur);
    const char* cB = cur.B + (size_t)cur.pn * tstepB + cur.kb;
    {
        PG8_STAGEB(PG8_SB(0, 0), cB); PG8_STAGEB(PG8_SB(0, 1), cB + hstepB); PG8_STAGE2(PG8_SA(0, 0), cA, ca00, ca01); PG8_STAGE2(PG8_SA(0, 1), cA, ca10, ca11);
        if (wr == 1) PG8_BAR;
        PG8_WAIT_V(2); PG8_BAR;
        PG8_STAGEB(PG8_SB(1, 0), cB + kstep); PG8_STAGE2(PG8_SA(1, 0), cA + kstep, ca00, ca01); PG8_STAGEB(PG8_SB(1, 1), cB + hstepB + kstep);
        PG8_WAIT_V(6); PG8_BAR;
    }
    for (;;) {
        const bool has_next = S.next(ui + 1, nxt);
        if constexpr (Sched::GATHER) { if (has_next && wr == 0) __builtin_amdgcn_global_load_lds((const unsigned*)(S.slot_tok + (size_t)nxt.pm * BM + tid), (LAS unsigned*)(lds + TOKB_OFF + ((ui + 1) & 1) * 1024 + wid * 256), 4, 0, 0); }
        const char* nA = cA; const char* nB = cB;
        if (has_next) { nA = PG8_ABASE(nxt); nB = nxt.B + (size_t)nxt.pn * tstepB + nxt.kb; }
        const int nt = cur.nt;
        for (int t = 0; t < nt; t += 2) {
            const bool last = (t == nt - 2);
            const char* a1 = cA + (size_t)(t + 1) * kstep;
            const char* a2 = last ? nA : cA + (size_t)(t + 2) * kstep; const char* b2 = last ? nB : cB + (size_t)(t + 2) * kstep;
            const char* a3 = a2 + kstep; const char* b3 = b2 + kstep;
            unsigned o00 = ca00, o01 = ca01, o10 = ca10, o11 = ca11;
            if constexpr (Sched::GATHER) { if (last && has_next) { const int par_ = (ui + 1) & 1; o00 = a_off_lds(lds, par_, g.lda, tid, 0, 0); o01 = a_off_lds(lds, par_, g.lda, tid, 0, 1); o10 = a_off_lds(lds, par_, g.lda, tid, 1, 0); o11 = a_off_lds(lds, par_, g.lda, tid, 1, 1); } }
            PG8_LDB(B0, 0, 0); PG8_LDB(B1, 0, 1); PG8_SCHED; PG8_LDA(At, 0, 0); PG8_STAGE2(PG8_SA(1, 1), a1, ca10, ca11);
            PG8_WAIT_V(8); PG8_WAIT_L(0); PG8_BAR; PG8_MMA(0, 0, At, B0); PG8_MMA(0, 1, At, B1); PG8_BAR; PG8_SCHED;
            PG8_LDA(At, 0, 1); PG8_STAGEB(PG8_SB(0, 0), b2); PG8_STAGEB(PG8_SB(0, 1), b2 + hstepB); PG8_STAGE2(PG8_SA(0, 0), a2, o00, o01);
            PG8_WAIT_V(8); PG8_WAIT_L(0); PG8_BAR; PG8_MMA(1, 0, At, B0); PG8_MMA(1, 1, At, B1); PG8_BAR; PG8_SCHED;
            PG8_LDB(B0, 1, 0); PG8_LDB(B1, 1, 1); PG8_SCHED; PG8_LDA(At, 1, 0); PG8_STAGE2(PG8_SA(0, 1), a2, o10, o11);
            PG8_WAIT_V(8); PG8_WAIT_L(0); PG8_BAR; PG8_MMA(0, 0, At, B0); PG8_MMA(0, 1, At, B1); PG8_BAR; PG8_SCHED;
            PG8_LDA(At, 1, 1); PG8_STAGEB(PG8_SB(1, 0), b3); PG8_STAGEB(PG8_SB(1, 1), b3 + hstepB); PG8_STAGE2(PG8_SA(1, 0), a3, o00, o01);
            PG8_WAIT_V(8); PG8_WAIT_L(0); PG8_BAR; PG8_MMA(1, 0, At, B0); PG8_MMA(1, 1, At, B1); PG8_BAR; PG8_SCHED;
            if constexpr (Sched::GATHER) { if (last) { ca00 = o00; ca01 = o01; ca10 = o10; ca11 = o11; } }
        }
        if constexpr (ALIGN_EPI) { if (wr == 0) PG8_BAR; }
        if constexpr (F8) asm volatile("s_nop 15\n\ts_nop 15" ::: "memory");
        E(acc, cur, wr, wc, fr, fq);
        if (!has_next) break;
        bool zero_acc = true;
        if constexpr (Epi::CHAIN) zero_acc = E.resets(cur);
        if (zero_acc)
#pragma unroll
        for (int a = 0; a < 2; ++a)
#pragma unroll
            for (int b = 0; b < 2; ++b)
#pragma unroll
                for (int m = 0; m < 4; ++m)
#pragma unroll
                    for (int n = 0; n < 2; ++n) acc[a][b][m][n] = (f32x4){0.f, 0.f, 0.f, 0.f};
        cur = nxt; cA = nA; cB = nB; ++ui;
        if constexpr (ALIGN_EPI) { if (wr == 1) PG8_BAR; }
    }
    PG8_WAIT_V(0);
    if constexpr (!ALIGN_EPI) { if (wr == 0) PG8_BAR; }
    PG8_BAR;
#undef PG8_SA
#undef PG8_SB
#undef PG8_STAGE2
#undef PG8_STAGEB
#undef PG8_AOFF
#undef PG8_ABASE
#undef PG8_LDA
#undef PG8_LDB
#undef PG8_MMA
#undef PG8_WAIT_V
#undef PG8_WAIT_L
#undef PG8_BAR
#undef PG8_SCHED
}
}

__device__ __forceinline__ unsigned pk2(float lo, float hi) { return (unsigned)f2bf(lo) | ((unsigned)f2bf(hi) << 16); }

__device__ __forceinline__ void p0_transpose_item(const float* W, int K, int N, bf16_t* WT, int ldk, int koff, int mode, LAS float* scr, int item, int lane) {
    const int nblk = N / 32, kb = item / nblk, nb = item % nblk, k0 = 64 * kb, n0 = 32 * nb;
    float tv[32];
#pragma unroll
    for (int i = 0; i < 32; ++i) { const int kk = 2 * i + (lane >> 5); tv[i] = W[(size_t)(k0 + kk) * N + n0 + (lane & 31)]; }
#pragma unroll
    for (int i = 0; i < 32; ++i) { const int kk = 2 * i + (lane >> 5); scr[kk * 33 + (lane & 31)] = tv[i]; }
    asm volatile("s_waitcnt lgkmcnt(0)" ::: "memory");
    int r0 = n0;
    if (mode == 1) { const int dff = N >> 1, hf = n0 >= dff ? 1 : 0, c = n0 - hf * dff; r0 = (c >> 7) * 256 + hf * 128 + (c & 127); }
    const int c8 = lane & 7;
#pragma unroll
    for (int j = 0; j < 4; ++j) { const int n = (lane >> 3) + 8 * j; const LAS float* s = scr + (8 * c8) * 33 + n;
        u32x4 o; o.x = pk2(s[0 * 33], s[1 * 33]); o.y = pk2(s[2 * 33], s[3 * 33]); o.z = pk2(s[4 * 33], s[5 * 33]); o.w = pk2(s[6 * 33], s[7 * 33]);
        *(u32x4*)(WT + (size_t)(r0 + n) * ldk + koff + k0 + 8 * c8) = o; }
    asm volatile("s_waitcnt lgkmcnt(0)" ::: "memory");
}

__device__ __forceinline__ void p0_transpose_item_f8(const float* W, int K, int N, unsigned char* WT8, int ldk, int mode, float sc, LAS float* scr, int item, int lane) {
    const int nblk = N / 32, kb = item / nblk, nb = item % nblk, k0 = 64 * kb, n0 = 32 * nb;
    float tv[32];
#pragma unroll
    for (int i = 0; i < 32; ++i) { const int kk = 2 * i + (lane >> 5); tv[i] = W[(size_t)(k0 + kk) * N + n0 + (lane & 31)]; }
#pragma unroll
    for (int i = 0; i < 32; ++i) { const int kk = 2 * i + (lane >> 5); scr[kk * 33 + (lane & 31)] = tv[i] * sc; }
    asm volatile("s_waitcnt lgkmcnt(0)" ::: "memory");
    int r0 = n0;
    if (mode == 1) { const int dff = N >> 1, hf = n0 >= dff ? 1 : 0, c = n0 - hf * dff; r0 = (c >> 7) * 256 + hf * 128 + (c & 127); }
    const int c8 = lane & 7;
#pragma unroll
    for (int j = 0; j < 4; ++j) { const int n = (lane >> 3) + 8 * j; const LAS float* s = scr + (8 * c8) * 33 + n;
        u32x2 o; o.x = pg8::pk4_fp8(pg8::sat8(s[0 * 33]), pg8::sat8(s[1 * 33]), pg8::sat8(s[2 * 33]), pg8::sat8(s[3 * 33])); o.y = pg8::pk4_fp8(pg8::sat8(s[4 * 33]), pg8::sat8(s[5 * 33]), pg8::sat8(s[6 * 33]), pg8::sat8(s[7 * 33]));
        *(u32x2*)(WT8 + (size_t)(r0 + n) * ldk + k0 + 8 * c8) = o; }
    asm volatile("s_waitcnt lgkmcnt(0)" ::: "memory");
}

struct Args {
    const float* in[25]; float* out; unsigned char* ws;
    int ph_lo, ph_hi;
};

template <bool O8>
__device__ __forceinline__ void rms_row(const float* __restrict__ xrow, const float* __restrict__ g, bf16_t* __restrict__ orow, unsigned char* __restrict__ o8row, int lane) {
    const f32x4* p = (const f32x4*)xrow;
    f32x4 v[4]; float ss = 0.f;
#pragma unroll
    for (int j = 0; j < 4; ++j) { v[j] = p[lane + 64 * j]; ss += (v[j].x * v[j].x + v[j].y * v[j].y) + (v[j].z * v[j].z + v[j].w * v[j].w); }
    ss = wave_sum(ss);
    const float r = rsqrtf(ss * (1.0f / D) + EPS);
    u32x2* op = (u32x2*)orow;
#pragma unroll
    for (int j = 0; j < 4; ++j) { const f32x4 gg = ((const f32x4*)g)[lane + 64 * j]; const float y0 = v[j].x * r * gg.x, y1 = v[j].y * r * gg.y, y2 = v[j].z * r * gg.z, y3 = v[j].w * r * gg.w;
        u32x2 w; w.x = pk2(y0, y1); w.y = pk2(y2, y3); op[lane + 64 * j] = w;
        if constexpr (O8) ((unsigned*)o8row)[lane + 64 * j] = pg8::pk4_fp8(pg8::sat8(y0 * pg8::F8S_HN), pg8::sat8(y1 * pg8::F8S_HN), pg8::sat8(y2 * pg8::F8S_HN), pg8::sat8(y3 * pg8::F8S_HN)); }
}


template <bool O8>
__device__ __forceinline__ void rms_rows4(const float* __restrict__ x, int row, int st, const float* __restrict__ g, bf16_t* __restrict__ o, unsigned char* __restrict__ o8, int lane) {
    f32x4 v[4][4];
#pragma unroll
    for (int i = 0; i < 4; ++i)
#pragma unroll
        for (int j = 0; j < 4; ++j) v[i][j] = ((const f32x4*)(x + (size_t)(row + i * st) * D))[lane + 64 * j];
    f32x4 gg[4];
#pragma unroll
    for (int j = 0; j < 4; ++j) gg[j] = ((const f32x4*)g)[lane + 64 * j];
    float ss[4];
#pragma unroll
    for (int i = 0; i < 4; ++i) { ss[i] = 0.f;
#pragma unroll
        for (int j = 0; j < 4; ++j) ss[i] += (v[i][j].x * v[i][j].x + v[i][j].y * v[i][j].y) + (v[i][j].z * v[i][j].z + v[i][j].w * v[i][j].w); }
#pragma unroll
    for (int i = 0; i < 4; ++i) ss[i] = wave_sum(ss[i]);
    float eps_ = EPS; asm volatile("" : "+v"(eps_));
#pragma unroll
    for (int i = 0; i < 4; ++i) { const float r = rsqrtf(ss[i] * (1.0f / D) + eps_); u32x2* op = (u32x2*)(o + (size_t)(row + i * st) * D);
#pragma unroll
        for (int j = 0; j < 4; ++j) { const float y0 = v[i][j].x * r * gg[j].x, y1 = v[i][j].y * r * gg[j].y, y2 = v[i][j].z * r * gg[j].z, y3 = v[i][j].w * r * gg[j].w;
            u32x2 w; w.x = pk2(y0, y1); w.y = pk2(y2, y3); op[lane + 64 * j] = w;
            if constexpr (O8) ((unsigned*)(o8 + (size_t)(row + i * st) * D))[lane + 64 * j] = pg8::pk4_fp8(pg8::sat8(y0 * pg8::F8S_HN), pg8::sat8(y1 * pg8::F8S_HN), pg8::sat8(y2 * pg8::F8S_HN), pg8::sat8(y3 * pg8::F8S_HN)); } }
}

__device__ __forceinline__ void bf8_to_f32(const u32x4 a, float (&v)[8]) {
    v[0] = __uint_as_float(a.x << 16); v[1] = __uint_as_float(a.x & 0xffff0000u); v[2] = __uint_as_float(a.y << 16); v[3] = __uint_as_float(a.y & 0xffff0000u);
    v[4] = __uint_as_float(a.z << 16); v[5] = __uint_as_float(a.z & 0xffff0000u); v[6] = __uint_as_float(a.w << 16); v[7] = __uint_as_float(a.w & 0xffff0000u);
}
template <bool O8>
__device__ __forceinline__ void rms_row_bf(const bf16_t* __restrict__ xrow, const float* __restrict__ g, bf16_t* __restrict__ orow, unsigned char* __restrict__ o8row, int lane) {
    float v[2][8]; float ss = 0.f;
#pragma unroll
    for (int j = 0; j < 2; ++j) { bf8_to_f32(((const u32x4*)xrow)[lane + 64 * j], v[j]);
#pragma unroll
        for (int e = 0; e < 8; ++e) ss += v[j][e] * v[j][e]; }
    ss = wave_sum(ss);
    const float r = rsqrtf(ss * (1.0f / D) + EPS);
#pragma unroll
    for (int j = 0; j < 2; ++j) { const f32x4 ga = ((const f32x4*)g)[2 * (lane + 64 * j)], gb = ((const f32x4*)g)[2 * (lane + 64 * j) + 1];
        const float y0 = v[j][0] * r * ga.x, y1 = v[j][1] * r * ga.y, y2 = v[j][2] * r * ga.z, y3 = v[j][3] * r * ga.w, y4 = v[j][4] * r * gb.x, y5 = v[j][5] * r * gb.y, y6 = v[j][6] * r * gb.z, y7 = v[j][7] * r * gb.w;
        u32x4 w; w.x = pk2(y0, y1); w.y = pk2(y2, y3); w.z = pk2(y4, y5); w.w = pk2(y6, y7);
        ((u32x4*)orow)[lane + 64 * j] = w;
        if constexpr (O8) { u32x2 w8; w8.x = pg8::pk4_fp8(pg8::sat8(y0 * pg8::F8S_HN), pg8::sat8(y1 * pg8::F8S_HN), pg8::sat8(y2 * pg8::F8S_HN), pg8::sat8(y3 * pg8::F8S_HN)); w8.y = pg8::pk4_fp8(pg8::sat8(y4 * pg8::F8S_HN), pg8::sat8(y5 * pg8::F8S_HN), pg8::sat8(y6 * pg8::F8S_HN), pg8::sat8(y7 * pg8::F8S_HN)); ((u32x2*)o8row)[lane + 64 * j] = w8; } }
}
template <bool O8>
__device__ __forceinline__ void rms_rows4_bf(const bf16_t* __restrict__ x, int row, int st, const float* __restrict__ g, bf16_t* __restrict__ o, unsigned char* __restrict__ o8, int lane) {
    u32x4 raw[4][2];
#pragma unroll
    for (int i = 0; i < 4; ++i)
#pragma unroll
        for (int j = 0; j < 2; ++j) raw[i][j] = ((const u32x4*)(x + (size_t)(row + i * st) * D))[lane + 64 * j];
    f32x4 gg[2][2];
#pragma unroll
    for (int j = 0; j < 2; ++j) { gg[j][0] = ((const f32x4*)g)[2 * (lane + 64 * j)]; gg[j][1] = ((const f32x4*)g)[2 * (lane + 64 * j) + 1]; }
    float eps_ = EPS; asm volatile("" : "+v"(eps_));
#pragma unroll
    for (int i = 0; i < 4; ++i) { float v[2][8]; float ss = 0.f;
#pragma unroll
        for (int j = 0; j < 2; ++j) { bf8_to_f32(raw[i][j], v[j]);
#pragma unroll
            for (int e = 0; e < 8; ++e) ss += v[j][e] * v[j][e]; }
        ss = wave_sum(ss);
        const float r = rsqrtf(ss * (1.0f / D) + eps_);
#pragma unroll
        for (int j = 0; j < 2; ++j) { const f32x4 ga = gg[j][0], gb = gg[j][1];
            const float y0 = v[j][0] * r * ga.x, y1 = v[j][1] * r * ga.y, y2 = v[j][2] * r * ga.z, y3 = v[j][3] * r * ga.w, y4 = v[j][4] * r * gb.x, y5 = v[j][5] * r * gb.y, y6 = v[j][6] * r * gb.z, y7 = v[j][7] * r * gb.w;
            u32x4 w; w.x = pk2(y0, y1); w.y = pk2(y2, y3); w.z = pk2(y4, y5); w.w = pk2(y6, y7);
            ((u32x4*)(o + (size_t)(row + i * st) * D))[lane + 64 * j] = w;
            if constexpr (O8) { u32x2 w8; w8.x = pg8::pk4_fp8(pg8::sat8(y0 * pg8::F8S_HN), pg8::sat8(y1 * pg8::F8S_HN), pg8::sat8(y2 * pg8::F8S_HN), pg8::sat8(y3 * pg8::F8S_HN)); w8.y = pg8::pk4_fp8(pg8::sat8(y4 * pg8::F8S_HN), pg8::sat8(y5 * pg8::F8S_HN), pg8::sat8(y6 * pg8::F8S_HN), pg8::sat8(y7 * pg8::F8S_HN)); ((u32x2*)(o8 + (size_t)(row + i * st) * D))[lane + 64 * j] = w8; } } }
}

__device__ __forceinline__ void qknorm_row(bf16_t* __restrict__ Z, int t, const float* __restrict__ qg, const float* __restrict__ kg, int lane) {
    bf16_t* p = Z + (size_t)t * ZP + OFF_ATTN + lane * 16;
    const u32x4 a = *(const u32x4*)p, b = *(const u32x4*)(p + 8);
    float v[16];
    v[0] = __uint_as_float(a.x << 16); v[1] = __uint_as_float(a.x & 0xffff0000u); v[2] = __uint_as_float(a.y << 16); v[3] = __uint_as_float(a.y & 0xffff0000u);
    v[4] = __uint_as_float(a.z << 16); v[5] = __uint_as_float(a.z & 0xffff0000u); v[6] = __uint_as_float(a.w << 16); v[7] = __uint_as_float(a.w & 0xffff0000u);
    v[8] = __uint_as_float(b.x << 16); v[9] = __uint_as_float(b.x & 0xffff0000u); v[10] = __uint_as_float(b.y << 16); v[11] = __uint_as_float(b.y & 0xffff0000u);
    v[12] = __uint_as_float(b.z << 16); v[13] = __uint_as_float(b.z & 0xffff0000u); v[14] = __uint_as_float(b.w << 16); v[15] = __uint_as_float(b.w & 0xffff0000u);
    float ss = 0.f;
#pragma unroll
    for (int i = 0; i < 16; ++i) ss += v[i] * v[i];
    ss = quad_sum(ss);
    const float r = rsqrtf(ss * (1.0f / 64.0f) + EPS);
    const float* g = (lane < 32 ? qg : kg) + (lane & 3) * 16;
    unsigned o[8];
#pragma unroll
    for (int i = 0; i < 8; ++i) o[i] = pk2(v[2 * i] * r * g[2 * i], v[2 * i + 1] * r * g[2 * i + 1]);
    *(u32x4*)p = (u32x4){o[0], o[1], o[2], o[3]}; *(u32x4*)(p + 8) = (u32x4){o[4], o[5], o[6], o[7]};
}

__device__ __forceinline__ void conv_row(const bf16_t* __restrict__ Z, int t, const float* __restrict__ cw, bf16_t* __restrict__ Y, int lane) {
    const int s = t & (SEQ - 1), c = lane * 4;
    float y0 = 0.f, y1 = 0.f, y2 = 0.f, y3 = 0.f;
#pragma unroll
    for (int j = 0; j < 3; ++j) {
        if (s - 2 + j >= 0) { const bf16_t* zr = Z + (size_t)(t - 2 + j) * ZP + OFF_CONV;
            const u32x2 cg = *(const u32x2*)(zr + 256 + c), hh = *(const u32x2*)(zr + 512 + c); const f32x4 w = *(const f32x4*)(cw + j * 256 + c);
            y0 += w.x * __uint_as_float(cg.x << 16) * __uint_as_float(hh.x << 16); y1 += w.y * __uint_as_float(cg.x & 0xffff0000u) * __uint_as_float(hh.x & 0xffff0000u);
            y2 += w.z * __uint_as_float(cg.y << 16) * __uint_as_float(hh.y << 16); y3 += w.w * __uint_as_float(cg.y & 0xffff0000u) * __uint_as_float(hh.y & 0xffff0000u); }
    }
    const u32x2 bg = *(const u32x2*)(Z + (size_t)t * ZP + OFF_CONV + c);
    u32x2 o; o.x = pk2(__uint_as_float(bg.x << 16) * y0, __uint_as_float(bg.x & 0xffff0000u) * y1); o.y = pk2(__uint_as_float(bg.y << 16) * y2, __uint_as_float(bg.y & 0xffff0000u) * y3);
    *(u32x2*)(Y + (size_t)t * YW + 256 + c) = o;
}


__device__ __forceinline__ void qknorm_rows4(bf16_t* __restrict__ Z, int t, int st, const float* __restrict__ qg, const float* __restrict__ kg, int lane) {
    u32x4 a[4], b[4];
#pragma unroll
    for (int i = 0; i < 4; ++i) { const bf16_t* p = Z + (size_t)(t + i * st) * ZP + OFF_ATTN + lane * 16; a[i] = *(const u32x4*)p; b[i] = *(const u32x4*)(p + 8); }
    const float* g = (lane < 32 ? qg : kg) + (lane & 3) * 16;
    const f32x4 g0 = *(const f32x4*)g, g1 = *(const f32x4*)(g + 4), g2 = *(const f32x4*)(g + 8), g3 = *(const f32x4*)(g + 12);
#pragma unroll
    for (int i = 0; i < 4; ++i) {
        float v[16];
        v[0] = __uint_as_float(a[i].x << 16); v[1] = __uint_as_float(a[i].x & 0xffff0000u); v[2] = __uint_as_float(a[i].y << 16); v[3] = __uint_as_float(a[i].y & 0xffff0000u);
        v[4] = __uint_as_float(a[i].z << 16); v[5] = __uint_as_float(a[i].z & 0xffff0000u); v[6] = __uint_as_float(a[i].w << 16); v[7] = __uint_as_float(a[i].w & 0xffff0000u);
        v[8] = __uint_as_float(b[i].x << 16); v[9] = __uint_as_float(b[i].x & 0xffff0000u); v[10] = __uint_as_float(b[i].y << 16); v[11] = __uint_as_float(b[i].y & 0xffff0000u);
        v[12] = __uint_as_float(b[i].z << 16); v[13] = __uint_as_float(b[i].z & 0xffff0000u); v[14] = __uint_as_float(b[i].w << 16); v[15] = __uint_as_float(b[i].w & 0xffff0000u);
        float ss = 0.f;
#pragma unroll
        for (int e = 0; e < 16; ++e) ss += v[e] * v[e];
        ss = quad_sum(ss);
        const float r = rsqrtf(ss * (1.0f / 64.0f) + EPS);
        u32x4 o0, o1;
        o0.x = pk2(v[0] * r * g0.x, v[1] * r * g0.y); o0.y = pk2(v[2] * r * g0.z, v[3] * r * g0.w); o0.z = pk2(v[4] * r * g1.x, v[5] * r * g1.y); o0.w = pk2(v[6] * r * g1.z, v[7] * r * g1.w);
        o1.x = pk2(v[8] * r * g2.x, v[9] * r * g2.y); o1.y = pk2(v[10] * r * g2.z, v[11] * r * g2.w); o1.z = pk2(v[12] * r * g3.x, v[13] * r * g3.y); o1.w = pk2(v[14] * r * g3.z, v[15] * r * g3.w);
        bf16_t* p = Z + (size_t)(t + i * st) * ZP + OFF_ATTN + lane * 16;
        *(u32x4*)p = o0; *(u32x4*)(p + 8) = o1;
    }
}
__device__ __forceinline__ void conv_rows4(const bf16_t* __restrict__ Z, int t, int st, const float* __restrict__ cw, bf16_t* __restrict__ Y, int lane) {
    const int c = lane * 4;
    u32x2 cg[4][3], hh[4][3], bg[4];
#pragma unroll
    for (int i = 0; i < 4; ++i) { const int tt = t + i * st, s = tt & (SEQ - 1);
#pragma unroll
        for (int j = 0; j < 3; ++j) { const int back = (s - 2 + j >= 0) ? (2 - j) : 0;
            const bf16_t* zr = Z + (size_t)(tt - back) * ZP + OFF_CONV; cg[i][j] = *(const u32x2*)(zr + 256 + c); hh[i][j] = *(const u32x2*)(zr + 512 + c); }
        bg[i] = *(const u32x2*)(Z + (size_t)tt * ZP + OFF_CONV + c); }
    f32x4 w[3];
#pragma unroll
    for (int j = 0; j < 3; ++j) w[j] = *(const f32x4*)(cw + j * 256 + c);
#pragma unroll
    for (int i = 0; i < 4; ++i) { const int tt = t + i * st, s = tt & (SEQ - 1);
        float y0 = 0.f, y1 = 0.f, y2 = 0.f, y3 = 0.f;
#pragma unroll
        for (int j = 0; j < 3; ++j) { const float mk = (s - 2 + j >= 0) ? 1.0f : 0.0f;
            y0 += mk * w[j].x * __uint_as_float(cg[i][j].x << 16) * __uint_as_float(hh[i][j].x << 16); y1 += mk * w[j].y * __uint_as_float(cg[i][j].x & 0xffff0000u) * __uint_as_float(hh[i][j].x & 0xffff0000u);
            y2 += mk * w[j].z * __uint_as_float(cg[i][j].y << 16) * __uint_as_float(hh[i][j].y << 16); y3 += mk * w[j].w * __uint_as_float(cg[i][j].y & 0xffff0000u) * __uint_as_float(hh[i][j].y & 0xffff0000u); }
        u32x2 o; o.x = pk2(__uint_as_float(bg[i].x << 16) * y0, __uint_as_float(bg[i].x & 0xffff0000u) * y1); o.y = pk2(__uint_as_float(bg[i].y << 16) * y2, __uint_as_float(bg[i].y & 0xffff0000u) * y3);
        *(u32x2*)(Y + (size_t)tt * YW + 256 + c) = o; }
}

__device__ __forceinline__ unsigned offb_(unsigned row, unsigned ch) { return 256u * row + 16u * (ch ^ (((row & 3u) << 2) | ((row >> 2) & 3u))); }
typedef float f32x16_t __attribute__((ext_vector_type(16)));
typedef short s16x4_t __attribute__((ext_vector_type(4)));
__device__ __forceinline__ s16x4_t vtr_(const LAS unsigned char* p) { return __builtin_bit_cast(s16x4_t, __builtin_amdgcn_ds_read_tr16_b64_v4i16((LAS s16x4_t*)p)); }
__device__ __forceinline__ unsigned cvtpk_(float lo, float hi) { unsigned r; asm volatile("v_cvt_pk_bf16_f32 %0, %1, %2" : "=v"(r) : "v"(lo), "v"(hi)); return r; }
__device__ __forceinline__ void sgu_seg_mfma(const bf16_t* __restrict__ Z, const float* __restrict__ lng, const bf16_t* __restrict__ wsb  , const float* __restrict__ sb,
                                             bf16_t* __restrict__ Y, LAS unsigned char* L, int seg, int tid) {
    const int lane = tid & 63, w = __builtin_amdgcn_readfirstlane(tid >> 6), t0 = seg * 128;
    {
        const f32x4 gg = *(const f32x4*)(lng + 4 * lane);
        u32x2 raw[16];
#pragma unroll
        for (int i = 0; i < 16; ++i) raw[i] = *(const u32x2*)(Z + (size_t)(t0 + w * 16 + i) * ZP + OFF_SGU + 256 + 4 * lane);
#pragma unroll
        for (int i = 0; i < 16; ++i) {
            const float x0 = __uint_as_float(raw[i].x << 16), x1 = __uint_as_float(raw[i].x & 0xffff0000u), x2 = __uint_as_float(raw[i].y << 16), x3 = __uint_as_float(raw[i].y & 0xffff0000u);
            const float s = wave_sum((x0 + x1) + (x2 + x3));
            const float mu = s * (1.0f / 256.0f);
            const float d0 = x0 - mu, d1 = x1 - mu, d2 = x2 - mu, d3 = x3 - mu;
            const float q = wave_sum((d0 * d0 + d1 * d1) + (d2 * d2 + d3 * d3));
            const float rs = rsqrtf(q * (1.0f / 256.0f) + EPS);
            u32x2 o; o.x = cvtpk_(d0 * rs * gg.x, d1 * rs * gg.y); o.y = cvtpk_(d2 * rs * gg.z, d3 * rs * gg.w);
            const unsigned row = (unsigned)(w * 16 + i), ch = (unsigned)(4 * lane);
            *(LAS u32x2*)(L + (ch >> 7) * 32768u + offb_(row, (ch & 127u) >> 3) + ((ch & 4u) ? 8u : 0u)) = o;
        }
    }
    __syncthreads();
    const int r = lane & 31, hh = lane >> 5, ct = w >> 2;
    const unsigned blk = (lane >> 4) & 1, qq = (lane & 15) >> 2, pp = lane & 3;
#pragma unroll
    for (int g = 0; g < 4; ++g) {
        const int pt = (w + g) & 3;
        const unsigned c = (unsigned)((g & 1) * 2 + ct);
        const LAS unsigned char* img = L + (g >> 1) * 32768;
        const unsigned va0 = offb_(8u * hh + qq, 4u * c + 2u * blk + (pp >> 1)) + 8u * (pp & 1), va1 = offb_(8u * hh + 4u + qq, 4u * c + 2u * blk + (pp >> 1)) + 8u * (pp & 1);
        const bf16_t* wrow = wsb + ((size_t)g * 128 + 32 * pt + r) * 128 + 8 * hh;
        f32x16_t acc;
#pragma unroll
        for (int i = 0; i < 16; ++i) acc[i] = 0.f;
        const int nks = 2 * (pt + 1);
        for (int ks = 0; ks < nks; ++ks) {
            const s16x4_t lo = vtr_(img + va0 + ks * 4096), hi = vtr_(img + va1 + ks * 4096);
            const bf16x8 a = {lo[0], lo[1], lo[2], lo[3], hi[0], hi[1], hi[2], hi[3]};
            const bf16x8 bw = *(const bf16x8*)(wrow + 16 * ks);
            acc = __builtin_amdgcn_mfma_f32_32x32x16_bf16(a, bw, acc, 0, 0, 0);
        }
        const int p = 32 * pt + r;
        const float bias = sb[g * 128 + p];
        const bf16_t* up = Z + (size_t)(t0 + p) * ZP + OFF_SGU + g * 64 + 32 * ct + 4 * hh;
        bf16_t* yp = Y + (size_t)(t0 + p) * YW + 512 + g * 64 + 32 * ct + 4 * hh;
        u32x2 uvv[4];
#pragma unroll
        for (int gq = 0; gq < 4; ++gq) uvv[gq] = *(const u32x2*)(up + 8 * gq);
        asm volatile("" ::: "memory");
#pragma unroll
        for (int gq = 0; gq < 4; ++gq) { const u32x2 uv = uvv[gq];
            u32x2 o; o.x = cvtpk_(__uint_as_float(uv.x << 16) * (acc[4 * gq + 0] + bias), __uint_as_float(uv.x & 0xffff0000u) * (acc[4 * gq + 1] + bias));
            o.y = cvtpk_(__uint_as_float(uv.y << 16) * (acc[4 * gq + 2] + bias), __uint_as_float(uv.y & 0xffff0000u) * (acc[4 * gq + 3] + bias));
            *(u32x2*)(yp + 8 * gq) = o; }
    }
    __syncthreads();
}

__device__ __forceinline__ void pool_unit_mfma(const bf16_t* __restrict__ Z, const bf16_t* __restrict__ pwt  , const float* __restrict__ ps, bf16_t* __restrict__ Y, int unit, int lane) {
    const int g = unit & 3, tt = unit >> 2, r = lane & 31, hh = lane >> 5;
    const int t = tt * 32 + r, s = t & (SEQ - 1), win = 2 << g;
    const int cnt = (s + 1) < win ? (s + 1) : win;
    const float icnt = 1.0f / (float)cnt;
    f32x16_t acc0, acc1;
#pragma unroll
    for (int i = 0; i < 16; ++i) { acc0[i] = 0.f; acc1[i] = 0.f; }
#pragma unroll
    for (int ks = 0; ks < 4; ++ks) {
        const bf16_t* zp = Z + (size_t)t * ZP + OFF_POOL + g * 64 + 16 * ks + 8 * hh;
        float sm[8];
#pragma unroll
        for (int e = 0; e < 8; ++e) sm[e] = 0.f;
        u32x4 self = {0u, 0u, 0u, 0u};
        for (int d = 0; d < win; ++d) {
            if (d < cnt) { const u32x4 v = *(const u32x4*)(zp - (size_t)d * ZP); if (d == 0) self = v;
                sm[0] += __uint_as_float(v.x << 16); sm[1] += __uint_as_float(v.x & 0xffff0000u); sm[2] += __uint_as_float(v.y << 16); sm[3] += __uint_as_float(v.y & 0xffff0000u);
                sm[4] += __uint_as_float(v.z << 16); sm[5] += __uint_as_float(v.z & 0xffff0000u); sm[6] += __uint_as_float(v.w << 16); sm[7] += __uint_as_float(v.w & 0xffff0000u); }
        }
        u32x4 pb;
        pb.x = cvtpk_(sm[0] * icnt - __uint_as_float(self.x << 16), sm[1] * icnt - __uint_as_float(self.x & 0xffff0000u));
        pb.y = cvtpk_(sm[2] * icnt - __uint_as_float(self.y << 16), sm[3] * icnt - __uint_as_float(self.y & 0xffff0000u));
        pb.z = cvtpk_(sm[4] * icnt - __uint_as_float(self.z << 16), sm[5] * icnt - __uint_as_float(self.z & 0xffff0000u));
        pb.w = cvtpk_(sm[6] * icnt - __uint_as_float(self.w << 16), sm[7] * icnt - __uint_as_float(self.w & 0xffff0000u));
        const bf16x8 bp = __builtin_bit_cast(bf16x8, pb);
        const bf16x8 a0 = *(const bf16x8*)(pwt + ((size_t)g * 64 + r) * 64 + 16 * ks + 8 * hh);
        const bf16x8 a1 = *(const bf16x8*)(pwt + ((size_t)g * 64 + 32 + r) * 64 + 16 * ks + 8 * hh);
        acc0 = __builtin_amdgcn_mfma_f32_32x32x16_bf16(a0, bp, acc0, 0, 0, 0);
        acc1 = __builtin_amdgcn_mfma_f32_32x32x16_bf16(a1, bp, acc1, 0, 0, 0);
    }
    bf16_t* yp = Y + (size_t)t * YW + g * 64 + 4 * hh;
    f32x4 sc0[4], sc1[4];
#pragma unroll
    for (int gq = 0; gq < 4; ++gq) { sc0[gq] = *(const f32x4*)(ps + g * 64 + 8 * gq + 4 * hh); sc1[gq] = *(const f32x4*)(ps + g * 64 + 32 + 8 * gq + 4 * hh); }
    asm volatile("" ::: "memory");
#pragma unroll
    for (int gq = 0; gq < 4; ++gq) {
        const f32x4 s0 = sc0[gq], s1 = sc1[gq];
        u32x2 o; o.x = cvtpk_(acc0[4 * gq + 0] * s0.x, acc0[4 * gq + 1] * s0.y); o.y = cvtpk_(acc0[4 * gq + 2] * s0.z, acc0[4 * gq + 3] * s0.w); *(u32x2*)(yp + 8 * gq) = o;
        o.x = cvtpk_(acc1[4 * gq + 0] * s1.x, acc1[4 * gq + 1] * s1.y); o.y = cvtpk_(acc1[4 * gq + 2] * s1.z, acc1[4 * gq + 3] * s1.w); *(u32x2*)(yp + 32 + 8 * gq) = o;
    }
}

__device__ __forceinline__ void router_row(const float* __restrict__ hrow, const float* __restrict__ g, const float* __restrict__ rw, bf16_t* __restrict__ orow, int& e0o, int& e1o, float& w0o, float& w1o, int lane) {
    const f32x4* p = (const f32x4*)hrow;
    f32x4 v[4]; float ss = 0.f;
#pragma unroll
    for (int j = 0; j < 4; ++j) { v[j] = p[lane + 64 * j]; ss += (v[j].x * v[j].x + v[j].y * v[j].y) + (v[j].z * v[j].z + v[j].w * v[j].w); }
    ss = wave_sum(ss);
    const float r = rsqrtf(ss * (1.0f / D) + EPS);
    float lg[8];
#pragma unroll
    for (int e = 0; e < 8; ++e) lg[e] = 0.f;
    u32x2* op = (u32x2*)orow;
#pragma unroll
    for (int j = 0; j < 4; ++j) {
        const int k = (lane + 64 * j) * 4; const f32x4 gg = *(const f32x4*)(g + k);
        const float x0 = v[j].x * r * gg.x, x1 = v[j].y * r * gg.y, x2 = v[j].z * r * gg.z, x3 = v[j].w * r * gg.w;
        u32x2 w; w.x = pk2(x0, x1); w.y = pk2(x2, x3); op[lane + 64 * j] = w;
        const f32x4* rp = (const f32x4*)(rw + (size_t)k * 8);
#pragma unroll
        for (int q = 0; q < 4; ++q) { const float xx = q == 0 ? x0 : (q == 1 ? x1 : (q == 2 ? x2 : x3)); const f32x4 ra = rp[q * 2], rb = rp[q * 2 + 1];
            lg[0] = fmaf(xx, ra.x, lg[0]); lg[1] = fmaf(xx, ra.y, lg[1]); lg[2] = fmaf(xx, ra.z, lg[2]); lg[3] = fmaf(xx, ra.w, lg[3]);
            lg[4] = fmaf(xx, rb.x, lg[4]); lg[5] = fmaf(xx, rb.y, lg[5]); lg[6] = fmaf(xx, rb.z, lg[6]); lg[7] = fmaf(xx, rb.w, lg[7]); }
    }
#pragma unroll
    for (int e = 0; e < 8; ++e) lg[e] = wave_sum(lg[e]);
    int i0 = 0; float v0 = lg[0];
#pragma unroll
    for (int e = 1; e < 8; ++e) if (lg[e] > v0) { v0 = lg[e]; i0 = e; }
    int i1 = -1; float v1 = -3e38f;
#pragma unroll
    for (int e = 0; e < 8; ++e) if (e != i0 && lg[e] > v1) { v1 = lg[e]; i1 = e; }
    const float e1 = __expf(v1 - v0);
    e0o = i0; e1o = i1; w0o = 1.0f / (1.0f + e1); w1o = e1 / (1.0f + e1);
}


namespace fa {
typedef float f32x16 __attribute__((ext_vector_type(16)));
typedef short s16x4 __attribute__((ext_vector_type(4)));
typedef short v4i16_t __attribute__((ext_vector_type(4)));
constexpr int TAB_OFF = 131072;
constexpr int TABN = 328;
constexpr float C2 = 0.125f * 1.4426950408889634f;
constexpr float LOG2E = 1.4426950408889634f;
__device__ __forceinline__ unsigned off_b(unsigned row, unsigned ch) { return 256u * row + 16u * (ch ^ (((row & 3u) << 2) | ((row >> 2) & 3u))); }
__device__ __forceinline__ s16x4 vtr(const LAS unsigned char* p) { return __builtin_bit_cast(s16x4, __builtin_amdgcn_ds_read_tr16_b64_v4i16((LAS v4i16_t*)p)); }
__device__ __forceinline__ float max3f(float a, float b, float c) { float r; asm("v_max3_f32 %0, %1, %2, %3" : "=v"(r) : "v"(a), "v"(b), "v"(c)); return r; }
__device__ __forceinline__ float max2f(float a, float b) { float r; asm("v_max_f32_e32 %0, %1, %2" : "=v"(r) : "v"(a), "v"(b)); return r; }
__device__ __forceinline__ unsigned cvtpk(float lo, float hi) { unsigned r; asm volatile("v_cvt_pk_bf16_f32 %0, %1, %2" : "=v"(r) : "v"(lo), "v"(hi)); return r; }

__device__ __forceinline__ void attn_phase(LAS unsigned char* lds, const bf16_t* __restrict__ Z, const float* __restrict__ relb, const float* __restrict__ dl, const float* __restrict__ sg,
                                           float lam_init, bf16_t* __restrict__ Y, int G, int bx, int wave_) {
    int tid = wave_ * 64 + lane_id(); asm volatile("" : "+v"(tid));
    const int lane = tid & 63, w = __builtin_amdgcn_readfirstlane(tid >> 6), m = w >> 2, r32 = w & 3, r = lane & 31, hh = lane >> 5;
    const float l1 = wave_sum(dl[lane] * dl[64 + lane]), l2 = wave_sum(dl[128 + lane] * dl[192 + lane]);
    const float lam = __expf(l1) - __expf(l2) + lam_init;
    LAS float* TAB = (LAS float*)(lds + TAB_OFF);
    unsigned goff[2];
#pragma unroll
    for (int i = 0; i < 2; ++i) { const unsigned pos = (unsigned)w * 1024u + (unsigned)i * 8192u + (unsigned)lane * 16u, row = pos >> 8, p = (pos >> 4) & 15u;
        const unsigned ch = p ^ (((row & 3u) << 2) | ((row >> 2) & 3u)); goff[i] = row * (unsigned)(ZP * 2) + ch * 16u; }
    unsigned kaddr[4];
#pragma unroll
    for (int s = 0; s < 4; ++s) kaddr[s] = off_b((unsigned)r, (unsigned)(m * 8 + 2 * s + hh));
    unsigned vaddr[4][2];
    { const unsigned blk = (lane >> 4) & 1, q = (lane & 15) >> 2, p = lane & 3;
#pragma unroll
      for (int c = 0; c < 4; ++c)
#pragma unroll
          for (int t = 0; t < 2; ++t) vaddr[c][t] = off_b(8u * t + 4u * hh + q, 4u * c + 2u * blk + (p >> 1)) + 8u * (p & 1); }

    const int vcu = (G % 8 == 0) ? (bx % 8) * (G / 8) + bx / 8 : bx;
    int tab_h = -1;
    for (int ui = 0;; ++ui) {
        const int pidx = vcu + G * (ui >> 1);
        if (pidx >= 512) break;
        const int j8 = pidx & 7, h = (pidx >> 3) & 3, b = pidx >> 5;
        const int qb = (ui & 1) ? 15 - j8 : j8;
        const int q0 = qb * 128, nkt = 2 * qb + 2, qs = q0 + 32 * r32;
        const int my_nkt = r32 < 2 ? nkt - 1 : nkt;
        const char* zb = (const char*)Z + (size_t)(b * SEQ) * ZP * 2;
        const char* kbase = zb + (OFF_ATTN + 512 + h * 128) * 2;
        const char* vbase = zb + (OFF_ATTN + 1024 + h * 128) * 2;
        __syncthreads();
        if (h != tab_h) {
            for (int idx = tid; idx < 2 * 4 * TABN; idx += 512) { const int mm = idx / (4 * TABN), c = (idx / TABN) & 3, y = idx % TABN; TAB[idx] = relb[rel_bucket(y - c - 256) * 8 + h * 2 + mm] * LOG2E; }
            tab_h = h;
        }
        const float b15p = relb[15 * 8 + h * 2 + m] * LOG2E;
        bf16x8 Qf[4];
        { const char* qp = zb + ((size_t)(qs + r) * ZP + OFF_ATTN + h * 128 + m * 64 + 8 * hh) * 2;
#pragma unroll
          for (int s = 0; s < 4; ++s) Qf[s] = *(const bf16x8*)(qp + s * 32); }
        asm volatile("s_waitcnt vmcnt(0)" ::: "memory");
#define FA_LOAD_TILE(kt_, buf_) do { const size_t to_ = (size_t)(kt_) * 64 * ZP * 2; LAS unsigned char* lb_ = lds + (buf_) * 32768 + w * 1024; \
        __builtin_amdgcn_global_load_lds((const unsigned*)(kbase + to_ + goff[0]), (LAS unsigned*)(lb_), 16, 0, 0); \
        __builtin_amdgcn_global_load_lds((const unsigned*)(kbase + to_ + goff[1]), (LAS unsigned*)(lb_ + 8192), 16, 0, 0); \
        __builtin_amdgcn_global_load_lds((const unsigned*)(vbase + to_ + goff[0]), (LAS unsigned*)(lb_ + 16384), 16, 0, 0); \
        __builtin_amdgcn_global_load_lds((const unsigned*)(vbase + to_ + goff[1]), (LAS unsigned*)(lb_ + 16384 + 8192), 16, 0, 0); } while (0)
        FA_LOAD_TILE(0, 0); FA_LOAD_TILE(1, 1);
        f32x16 O[4];
#pragma unroll
        for (int c = 0; c < 4; ++c)
#pragma unroll
            for (int i = 0; i < 16; ++i) O[c][i] = 0.f;
        float mref = 0.f, lsum = 0.f;
        const int sq = qs + r, sqa = sq >> 2, sqc = sq & 3;
        const LAS float* tabl = TAB + (m * 4 + sqc) * TABN + 256 - 4 * sqa + 4 * hh;
        f32x16 S0, S1;
#pragma unroll
        for (int i = 0; i < 16; ++i) { S0[i] = 0.f; S1[i] = 0.f; }
        bf16x8 P[4];
#pragma unroll
        for (int i = 0; i < 4; ++i) P[i] = (bf16x8){0, 0, 0, 0, 0, 0, 0, 0};
        constexpr float THR = 8.0f;
        for (int t = 0; t <= nkt; ++t) {
            if (t < nkt) { if (t + 1 < nkt) asm volatile("s_waitcnt vmcnt(4) lgkmcnt(0)\n\ts_barrier" ::: "memory"); else asm volatile("s_waitcnt vmcnt(0) lgkmcnt(0)\n\ts_barrier" ::: "memory"); }
            else asm volatile("s_waitcnt lgkmcnt(0)\n\ts_barrier" ::: "memory");
            if (t + 2 < nkt) FA_LOAD_TILE(t + 2, (t + 2) & 3);
            const bool do_qk = t < my_nkt, do_pv = t >= 1 && (t - 1) < my_nkt;
            float alpha = 1.f, sub = 0.f; bool moved = false;
            if (do_qk) {
                const LAS unsigned char* Kb = lds + (t & 3) * 32768;
                bf16x8 kf[8];
#pragma unroll
                for (int s_ = 0; s_ < 4; ++s_) { kf[2 * s_] = *(const LAS bf16x8*)(Kb + kaddr[s_]); kf[2 * s_ + 1] = *(const LAS bf16x8*)(Kb + kaddr[s_] + 8192); }
#pragma unroll
                for (int i = 0; i < 16; ++i) { S0[i] = 0.f; S1[i] = 0.f; }
                __builtin_amdgcn_sched_barrier(0);
#pragma unroll
                for (int s_ = 0; s_ < 4; ++s_) { S0 = __builtin_amdgcn_mfma_f32_32x32x16_bf16(kf[2 * s_], Qf[s_], S0, 0, 0, 0); S1 = __builtin_amdgcn_mfma_f32_32x32x16_bf16(kf[2 * s_ + 1], Qf[s_], S1, 0, 0, 0); }
                __builtin_amdgcn_sched_barrier(0);
                const bool nearb = (64 * t + 63 - qs) > -91;
                if (nearb) {
                    const LAS float* tb = tabl + 64 * t;
#pragma unroll
                    for (int g = 0; g < 4; ++g) { const f32x4 b0 = *(const LAS f32x4*)(tb + 8 * g), b1 = *(const LAS f32x4*)(tb + 32 + 8 * g);
#pragma unroll
                        for (int e = 0; e < 4; ++e) { S0[4 * g + e] += b0[e]; S1[4 * g + e] += b1[e]; } }
                }
                float mx = max3f(S0[0], S1[0], S0[1]);
                mx = max3f(mx, S1[1], S0[2]);
#pragma unroll
                for (int i = 2; i < 15; ++i) mx = max3f(mx, S1[i], S0[i + 1]);
                mx = max2f(mx, S1[15]);
                mx = max_xor32(mx);
                if (!nearb) mx += b15p;
                if (!__all(mx <= mref + THR)) {
                    const float mn = fmaxf(mref, mx);
                    alpha = __builtin_amdgcn_exp2f(mref - mn); lsum *= alpha; mref = mn; moved = true;
                }
                sub = nearb ? mref : (mref - b15p);
            }
#define FA_PV_STEP(FILL) do { const LAS unsigned char* Vb = lds + ((t + 3) & 3) * 32768 + 16384; s16x4 vlo[2][4], vhi[2][4]; \
                _Pragma("unroll") for (int c = 0; c < 4; ++c) { vlo[0][c] = vtr(Vb + vaddr[c][0]); vhi[0][c] = vtr(Vb + vaddr[c][1]); } \
                _Pragma("unroll") for (int ks = 0; ks < 4; ++ks) { \
                    if (ks < 3) { _Pragma("unroll") for (int c = 0; c < 4; ++c) { vlo[(ks + 1) & 1][c] = vtr(Vb + vaddr[c][0] + (ks + 1) * 4096); vhi[(ks + 1) & 1][c] = vtr(Vb + vaddr[c][1] + (ks + 1) * 4096); } } \
                    __builtin_amdgcn_sched_barrier(0); \
                    _Pragma("unroll") for (int c = 0; c < 4; ++c) { const s16x4 lo = vlo[ks & 1][c], hi = vhi[ks & 1][c]; \
                        const bf16x8 a = {lo[0], lo[1], lo[2], lo[3], hi[0], hi[1], hi[2], hi[3]}; \
                        O[c] = __builtin_amdgcn_mfma_f32_32x32x16_bf16(a, P[ks], O[c], 0, 0, 0); \
                        if (FILL) { const int j = ks * 4 + c; float e0 = __builtin_amdgcn_exp2f(S0[j] - sub), e1 = __builtin_amdgcn_exp2f(S1[j] - sub); \
                            asm volatile("" : "+v"(e0), "+v"(e1)); S0[j] = e0; S1[j] = e1; lsum += e0 + e1; } \
                        __builtin_amdgcn_sched_barrier(0); } } } while (0)
            if (do_pv) {
                if (!do_qk) sub = 1e30f;
                FA_PV_STEP(true);
                if (moved) {
#pragma unroll
                    for (int c = 0; c < 4; ++c)
#pragma unroll
                        for (int i = 0; i < 16; ++i) O[c][i] *= alpha;
                }
            } else if (do_qk) {
#pragma unroll
                for (int j = 0; j < 16; ++j) { const float e0 = __builtin_amdgcn_exp2f(S0[j] - sub), e1 = __builtin_amdgcn_exp2f(S1[j] - sub); S0[j] = e0; S1[j] = e1; lsum += e0 + e1; }
            }
#undef FA_PV_STEP
            if (do_qk) {
#pragma unroll
                for (int s2 = 0; s2 < 2; ++s2) {
                    u32x4 a, c4;
                    a.x = cvtpk(S0[8 * s2 + 0], S0[8 * s2 + 1]); a.y = cvtpk(S0[8 * s2 + 2], S0[8 * s2 + 3]); a.z = cvtpk(S0[8 * s2 + 4], S0[8 * s2 + 5]); a.w = cvtpk(S0[8 * s2 + 6], S0[8 * s2 + 7]);
                    c4.x = cvtpk(S1[8 * s2 + 0], S1[8 * s2 + 1]); c4.y = cvtpk(S1[8 * s2 + 2], S1[8 * s2 + 3]); c4.z = cvtpk(S1[8 * s2 + 4], S1[8 * s2 + 5]); c4.w = cvtpk(S1[8 * s2 + 6], S1[8 * s2 + 7]);
                    P[s2] = __builtin_bit_cast(bf16x8, a); P[2 + s2] = __builtin_bit_cast(bf16x8, c4);
                }
            }
        }
#undef FA_LOAD_TILE
        lsum = sum_xor32(lsum);
        const float inv = m == 0 ? 1.0f / lsum : lam / lsum;
        asm volatile("s_waitcnt lgkmcnt(0)\n\ts_barrier" ::: "memory");
        LAS float* EX = (LAS float*)lds + (size_t)r32 * 4096 + lane;
        if (m == 1) {
#pragma unroll
            for (int c = 0; c < 4; ++c)
#pragma unroll
                for (int i = 0; i < 16; ++i) EX[(c * 16 + i) * 64] = O[c][i] * inv;
        }
        asm volatile("s_waitcnt lgkmcnt(0)\n\ts_barrier" ::: "memory");
        if (m == 0) {
            float ss = 0.f;
#pragma unroll
            for (int c = 0; c < 4; ++c)
#pragma unroll
                for (int i = 0; i < 16; ++i) { const float o = O[c][i] * inv - EX[(c * 16 + i) * 64]; O[c][i] = o; ss += o * o; }
            ss = sum_xor32(ss);
            const float rn = rsqrtf(ss * (1.0f / 128.0f) + EPS) * (1.0f - lam_init);
            bf16_t* yp = Y + (size_t)(b * SEQ + qs + r) * YW + 768 + h * 128 + 4 * hh;
            f32x4 sgv[4][4];
#pragma unroll
            for (int c = 0; c < 4; ++c)
#pragma unroll
                for (int g = 0; g < 4; ++g) sgv[c][g] = *(const f32x4*)(sg + 32 * c + 8 * g + 4 * hh);
            asm volatile("" ::: "memory");
#pragma unroll
            for (int c = 0; c < 4; ++c)
#pragma unroll
                for (int g = 0; g < 4; ++g) { const f32x4 gg = sgv[c][g];
                    u32x2 o; o.x = cvtpk(O[c][4 * g + 0] * rn * gg.x, O[c][4 * g + 1] * rn * gg.y); o.y = cvtpk(O[c][4 * g + 2] * rn * gg.z, O[c][4 * g + 3] * rn * gg.w);
                    *(u32x2*)(yp + 32 * c + 8 * g) = o; }
        }
    }
    __syncthreads();
}
}


__device__ __forceinline__ void router_rows4(const bf16_t* __restrict__ h, int t, const float* __restrict__ g, const f32x4 (&RW)[4][4][2], unsigned char* __restrict__ XNo,
                                             int* __restrict__ tok_e, float* __restrict__ tok_w, LAS int* hist, int lane) {
    f32x4 v[4][4];
#pragma unroll
    for (int i = 0; i < 4; ++i)
#pragma unroll
        for (int j = 0; j < 4; ++j) { const u32x2 h2 = ((const u32x2*)(h + (size_t)(t + i) * D))[lane + 64 * j];
            v[i][j] = (f32x4){__uint_as_float(h2.x << 16), __uint_as_float(h2.x & 0xffff0000u), __uint_as_float(h2.y << 16), __uint_as_float(h2.y & 0xffff0000u)}; }
    f32x4 gg[4];
#pragma unroll
    for (int j = 0; j < 4; ++j) gg[j] = ((const f32x4*)g)[lane + 64 * j];
#pragma unroll
    for (int i = 0; i < 4; ++i) {
        float ss = 0.f;
#pragma unroll
        for (int j = 0; j < 4; ++j) ss += (v[i][j].x * v[i][j].x + v[i][j].y * v[i][j].y) + (v[i][j].z * v[i][j].z + v[i][j].w * v[i][j].w);
        ss = wave_sum(ss);
        const float r = rsqrtf(ss * (1.0f / D) + EPS);
        float lg[8];
#pragma unroll
        for (int e = 0; e < 8; ++e) lg[e] = 0.f;
        unsigned* op = (unsigned*)(XNo + (size_t)(t + i) * D);
#pragma unroll
        for (int j = 0; j < 4; ++j) {
            const float x0 = v[i][j].x * r * gg[j].x, x1 = v[i][j].y * r * gg[j].y, x2 = v[i][j].z * r * gg[j].z, x3 = v[i][j].w * r * gg[j].w;
            op[lane + 64 * j] = pg8::pk4_fp8(pg8::sat8(x0 * pg8::F8S_HN), pg8::sat8(x1 * pg8::F8S_HN), pg8::sat8(x2 * pg8::F8S_HN), pg8::sat8(x3 * pg8::F8S_HN));
#pragma unroll
            for (int q = 0; q < 4; ++q) { const float xx = q == 0 ? x0 : (q == 1 ? x1 : (q == 2 ? x2 : x3)); const f32x4 ra = RW[j][q][0], rb = RW[j][q][1];
                lg[0] = fmaf(xx, ra.x, lg[0]); lg[1] = fmaf(xx, ra.y, lg[1]); lg[2] = fmaf(xx, ra.z, lg[2]); lg[3] = fmaf(xx, ra.w, lg[3]);
                lg[4] = fmaf(xx, rb.x, lg[4]); lg[5] = fmaf(xx, rb.y, lg[5]); lg[6] = fmaf(xx, rb.z, lg[6]); lg[7] = fmaf(xx, rb.w, lg[7]); }
        }
#pragma unroll
        for (int e = 0; e < 8; ++e) lg[e] = wave_sum(lg[e]);
        int i0 = 0; float v0 = lg[0];
#pragma unroll
        for (int e = 1; e < 8; ++e) if (lg[e] > v0) { v0 = lg[e]; i0 = e; }
        int i1 = -1; float v1 = -3e38f;
#pragma unroll
        for (int e = 0; e < 8; ++e) if (e != i0 && lg[e] > v1) { v1 = lg[e]; i1 = e; }
        const float e1 = __expf(v1 - v0);
        if (lane == 0) { tok_e[2 * (t + i)] = i0; tok_e[2 * (t + i) + 1] = i1; tok_w[2 * (t + i)] = 1.0f / (1.0f + e1); tok_w[2 * (t + i) + 1] = e1 / (1.0f + e1);
            __hip_atomic_fetch_add(&hist[i0], 1, __ATOMIC_RELAXED, __HIP_MEMORY_SCOPE_WORKGROUP); __hip_atomic_fetch_add(&hist[8 + i1], 1, __ATOMIC_RELAXED, __HIP_MEMORY_SCOPE_WORKGROUP); }
    }
}

__device__ __forceinline__ unsigned long long karg_u64(int i) {
    const __attribute__((address_space(4))) unsigned long long* ka = (const __attribute__((address_space(4))) unsigned long long*)__builtin_amdgcn_kernarg_segment_ptr();
    asm volatile("" : "+s"(ka));
    return ka[i];
}
#define AIN(i) ((const float*)karg_u64(i))
#define AOUT ((float*)karg_u64(25))
#define AWS ((unsigned char*)karg_u64(26))
__global__ void __launch_bounds__(NWAVES * 64, 2) mega(Args args) {
    extern __shared__ __attribute__((aligned(16))) unsigned char lds_raw[];
    LAS unsigned char* lds = (LAS unsigned char*)lds_raw;
    volatile LAS unsigned* MISC = (volatile LAS unsigned*)(lds + MISC_OFF);
    const int tid0 = threadIdx.x, wave = __builtin_amdgcn_readfirstlane(tid0 >> 6);
    const int G = gridDim.x, bx = blockIdx.x;
    const int gw = bx * NWAVES + wave, NGW = G * NWAVES;
#define PHASE_TID int tid = wave * 64 + lane_id(); asm volatile("" : "+v"(tid)); const int lane = tid & 63; (void)lane
    for (int u = tid0; u < (LDS_BYTES - MISC_OFF) / 4; u += NWAVES * 64) ((LAS unsigned*)(lds + MISC_OFF))[u] = 0u;
    __syncthreads();
    XcdBarrier bar = xcd_barrier_post((unsigned*)(AWS + WS_CTL) + CW_BAR, MISC + 8, wave);
#define IN(k) true
#define SEAM(k) do { if (IN(k) && IN((k) + 1)) xcd_barrier(bar); } while (0)
#ifndef PROBE_REP
#define PROBE_REP 0
#endif
#define REPFOR(bit) _Pragma("unroll") for (int rep_ = 0; rep_ < 1 + ((PROBE_REP >> (bit)) & 1); ++rep_)
#define REPBAR do { if (rep_) xcd_barrier(bar); } while (0)

#define P_x AIN(0)
#define P_out AOUT
#define P_ws AWS
#define P_Wb ((bf16_t*)(AWS + WS_W))
#define P_XN ((bf16_t*)(AWS + WS_XN))
#define P_Z ((bf16_t*)(AWS + WS_Z))
#define P_Y ((bf16_t*)(AWS + WS_Y))
#define P_HS ((bf16_t*)(AWS + WS_HS))
#define P_cnts ((int*)(AWS + WS_CNT))
#define P_tok_e ((int*)(AWS + WS_TOKE))
#define P_tok_w ((float*)(AWS + WS_TOKW))
#define P_slot_tok ((int*)(AWS + WS_SLOTT))
#define P_slot_w ((float*)(AWS + WS_SLOTW))
#define P_gbases (P_cnts + 256 * 16)

    if (IN(0)) REPFOR(0) {
        REPBAR; PHASE_TID;
        LAS float* scr = (LAS float*)(lds + wave * 16384);
        constexpr int I_IN = (1024 / 64) * (7168 / 32), I_BR = (256 / 64) * (1024 / 32), I_BA = (512 / 64) * (1024 / 32), I_OUT = (1024 / 64) * (1024 / 32);
        constexpr int I_FGU = (1024 / 64) * (5632 / 32), I_FDN = (2816 / 64) * (1024 / 32), I_MGU = (1024 / 64) * (7168 / 32), I_MDN = (3584 / 64) * (1024 / 32);
        constexpr int I_L = I_IN + 3 * I_BR + I_BA + I_OUT;
        constexpr int NITEMS = 2 * I_L + I_FGU + I_FDN + 8 * I_MGU + 8 * I_MDN;
        for (int it = gw; it < NITEMS; it += NGW) {
            int r = it;
            if (r < 2 * I_L) {
                const int layer = r / I_L; r -= layer * I_L;
                if (r < I_IN) {
                    if (32 * (r % (7168 / 32)) >= ZP) p0_transpose_item_f8(AIN(3) + (size_t)layer * 1024 * 7168, 1024, 7168, (unsigned char*)P_Wb + WOFF_IN8 + (size_t)layer * 7168 * 1024, 1024, 0, pg8::F8S_WGU, scr, r, lane);
                    else p0_transpose_item(AIN(3) + (size_t)layer * 1024 * 7168, 1024, 7168, (bf16_t*)((char*)P_Wb + WOFF_IN) + (size_t)layer * 7168 * 1024, 1024, 0, 0, scr, r, lane);
                    continue; } r -= I_IN;
                bf16_t* wm = (bf16_t*)((char*)P_Wb + WOFF_MRG) + (size_t)layer * 1024 * 1280;
                if (r < I_BR) { p0_transpose_item(AIN(14) + (size_t)layer * 256 * 1024, 256, 1024, wm, 1280, 0, 0, scr, r, lane); continue; } r -= I_BR;
                if (r < I_BR) { p0_transpose_item(AIN(15) + (size_t)layer * 256 * 1024, 256, 1024, wm, 1280, 256, 0, scr, r, lane); continue; } r -= I_BR;
                if (r < I_BR) { p0_transpose_item(AIN(16) + (size_t)layer * 256 * 1024, 256, 1024, wm, 1280, 512, 0, scr, r, lane); continue; } r -= I_BR;
                if (r < I_BA) { p0_transpose_item(AIN(17) + (size_t)layer * 512 * 1024, 512, 1024, wm, 1280, 768, 0, scr, r, lane); continue; } r -= I_BA;
                p0_transpose_item(AIN(18) + (size_t)layer * 1024 * 1024, 1024, 1024, (bf16_t*)((char*)P_Wb + WOFF_OUT) + (size_t)layer * 1024 * 1024, 1024, 0, 0, scr, r, lane); continue;
            }
            r -= 2 * I_L;
            if (r < I_FGU) { p0_transpose_item(AIN(20), 1024, 5632, (bf16_t*)((char*)P_Wb + WOFF_FGU), 1024, 0, 1, scr, r, lane); continue; } r -= I_FGU;
            if (r < I_FDN) { p0_transpose_item_f8(AIN(21), 2816, 1024, (unsigned char*)P_Wb + WOFF_FDN, 2816, 0, pg8::F8S_WDN, scr, r, lane); continue; } r -= I_FDN;
            if (r < 8 * I_MGU) { const int e = r / I_MGU; r -= e * I_MGU; p0_transpose_item_f8(AIN(23) + (size_t)e * 1024 * 7168, 1024, 7168, (unsigned char*)P_Wb + WOFF_MGU + (size_t)e * 7168 * 1024, 1024, 1, pg8::F8S_WGU, scr, r, lane); continue; } r -= 8 * I_MGU;
            { const int e = r / I_MDN; r -= e * I_MDN; p0_transpose_item_f8(AIN(24) + (size_t)e * 3584 * 1024, 3584, 1024, (unsigned char*)P_Wb + WOFF_MDN + (size_t)e * 1024 * 3584, 3584, 0, pg8::F8S_WDN, scr, r, lane); }
        }
        for (int i = bx * 512 + tid; i < 2 * 4 * 128 * 128; i += G * 512) { const int q = i & 127, p_ = (i >> 7) & 127; ((bf16_t*)((char*)P_Wb + WOFF_SGU))[i] = q <= p_ ? f2bf(AIN(8)[i]) : (bf16_t)0; }
        for (int i = bx * 512 + tid; i < 2 * 4 * 64 * 64; i += G * 512) { const int c = i & 63, d = (i >> 6) & 63, lg = i >> 12; ((bf16_t*)((char*)P_Wb + WOFF_POOL))[i] = f2bf(AIN(4)[((size_t)lg * 64 + c) * 64 + d]); }
        {
            const float* g1 = AIN(2); unsigned char* xn8 = (unsigned char*)P_Wb + WOFF_XN8;
            for (int m = gw; m + 3 * NGW < T; m += 4 * NGW) rms_rows4<true>(P_x, m, NGW, g1, P_XN, xn8, lane);
            for (int m = gw + (((T - gw + NGW - 1) / NGW) & ~3) * NGW; m < T; m += NGW) rms_row<true>(P_x + (size_t)m * D, g1, P_XN + (size_t)m * D, xn8 + (size_t)m * D, lane);
        }
    }
    SEAM(0);

#pragma unroll
    for (int layer = 0; layer < 2; ++layer) {
        const int pb = 1 + layer * 16;
        const float lam_init = layer == 0 ? 0.2f : 0.35550906f;

        if (layer != 0) {
            if (IN(pb + 0)) REPFOR(1) { REPBAR; PHASE_TID; const float* g1 = AIN(2) + layer * D;
                unsigned char* xn8 = (unsigned char*)P_Wb + WOFF_XN8;
                for (int m = gw; m + 3 * NGW < T; m += 4 * NGW) rms_rows4_bf<true>(P_HS, m, NGW, g1, P_XN, xn8, lane);
                for (int m = gw + (((T - gw + NGW - 1) / NGW) & ~3) * NGW; m < T; m += NGW) rms_row_bf<true>(P_HS + (size_t)m * D, g1, P_XN + (size_t)m * D, xn8 + (size_t)m * D, lane); }
            SEAM(pb + 0);
        }
        if (IN(pb + 1)) REPFOR(2) {
            REPBAR;
            {
                pg8::Gemm g{(const char*)P_Wb + WOFF_XN8, D / 2, D / 2}; pg8::SchedPlainOff S{T / 256, (INC - ZP) / 256, ZP / 256, G, bx, D / 128, (const char*)P_Wb + WOFF_IN8 + (size_t)layer * 7168 * 1024};
                pg8::EpiZ<true> E{P_Z, (bf16_t*)(P_ws + WS_G), AIN(10) + layer * 64, AIN(11) + layer * 64, (LAS float*)(lds + pg8::STAGE_BYTES)};
                pg8::gemm_phase<pg8::EpiZ<true>, pg8::SchedPlainOff, true, true>(lds, g, S, E, wave);
            }
            {
                pg8::Gemm g{(const char*)P_XN, D, D}; pg8::SchedPlain S{T / 256, ZP / 256, G, bx, D / 64, (const char*)P_Wb + WOFF_IN + (size_t)layer * 7168 * 1024 * 2};
                pg8::EpiZ<false> E{P_Z, (bf16_t*)(P_ws + WS_G), AIN(10) + layer * 64, AIN(11) + layer * 64, (LAS float*)(lds + pg8::STAGE_BYTES)};
                pg8::gemm_phase<pg8::EpiZ<false>, pg8::SchedPlain, true>(lds, g, S, E, wave);
            }
        }
        SEAM(pb + 1);
        if (IN(pb + 2)) {
            PHASE_TID;
            const float* cw = AIN(6) + layer * 768;
            REPFOR(3) { REPBAR;
            for (int t = gw; t + 3 * NGW < T; t += 4 * NGW) conv_rows4(P_Z, t, NGW, cw, P_Y, lane);
            for (int t = gw + (((T - gw + NGW - 1) / NGW) & ~3) * NGW; t < T; t += NGW) conv_row(P_Z, t, cw, P_Y, lane);
            for (int u = gw; u < (T / 32) * 4; u += NGW) pool_unit_mfma(P_Z, (const bf16_t*)((const char*)P_Wb + WOFF_POOL) + (size_t)layer * 16384, AIN(5) + layer * 256, P_Y, u, lane);
            for (int it = bx; it < T / 128; it += G) sgu_seg_mfma(P_Z, AIN(7) + layer * 256, (const bf16_t*)((const char*)P_Wb + WOFF_SGU) + (size_t)layer * 65536, AIN(9) + layer * 512, P_Y, lds, it, tid);
            }
        }
        if (IN(pb + 3)) REPFOR(4) {
            REPBAR;
            fa::attn_phase(lds, P_Z, AIN(1), AIN(12) + layer * 256, AIN(13) + layer * 128, lam_init, P_Y, G, bx, wave);
        }
        SEAM(pb + 3);
        if (IN(pb + 4)) REPFOR(5) {
            REPBAR;
            __syncthreads();
            pg8::Gemm g{(const char*)P_Y, YW, YW}; pg8::SchedMerge S{T / 256, D / 256, G, bx, (const char*)P_Wb + WOFF_MRG + (size_t)layer * 1024 * 1280 * 2};
            pg8::EpiMerge E{(const bf16_t*)(P_ws + WS_G), P_XN};
            pg8::gemm_phase<pg8::EpiMerge, pg8::SchedMerge, true>(lds, g, S, E, wave);
        }
        SEAM(pb + 4);
        if (IN(pb + 5)) {
            pg8::Gemm g{(const char*)P_XN, D, D}; pg8::SchedPlain S{T / 256, D / 256, G, bx, D / 64, (const char*)P_Wb + WOFF_OUT + (size_t)layer * 1024 * 1024 * 2};
            if (layer == 0) { pg8::EpiResid<false, true> E{P_x, P_HS}; pg8::gemm_phase<pg8::EpiResid<false, true>, pg8::SchedPlain, true>(lds, g, S, E, wave); }
            else { pg8::EpiResid<true, true> E{P_HS, P_HS}; pg8::gemm_phase<pg8::EpiResid<true, true>, pg8::SchedPlain, true>(lds, g, S, E, wave); }
        }
        SEAM(pb + 5);
        if (layer == 0) {
            if (IN(pb + 6)) REPFOR(7) { REPBAR; PHASE_TID; const float* g2 = AIN(19); for (int m = gw; m + 3 * NGW < T; m += 4 * NGW) rms_rows4_bf<false>(P_HS, m, NGW, g2, P_XN, nullptr, lane);
                for (int m = gw + (((T - gw + NGW - 1) / NGW) & ~3) * NGW; m < T; m += NGW) rms_row_bf<false>(P_HS + (size_t)m * D, g2, P_XN + (size_t)m * D, nullptr, lane); }
            SEAM(pb + 6);
            if (IN(pb + 7)) REPFOR(8) {
                REPBAR;
                pg8::Gemm g{(const char*)P_XN, D, D}; pg8::SchedPlain S{T / 256, 2 * DFF / 256, G, bx, D / 64, (const char*)P_Wb + WOFF_FGU};
                pg8::EpiSwi8<false> E{(unsigned char*)P_Z, DFF};
                pg8::gemm_phase<pg8::EpiSwi8<false>, pg8::SchedPlain, true>(lds, g, S, E, wave);
            }
            SEAM(pb + 7);
            if (IN(pb + 8)) {
                pg8::Gemm g{(const char*)P_Z, DFF / 2, DFF / 2}; pg8::SchedPlainRev S{T / 256, D / 256, G, bx, DFF / 128, (const char*)P_Wb + WOFF_FDN};
                pg8::EpiResid<true, true, true> E{P_HS, P_HS};
                pg8::gemm_phase<pg8::EpiResid<true, true, true>, pg8::SchedPlainRev, true, true>(lds, g, S, E, wave);
            }
            SEAM(pb + 8);
        } else {
            if (IN(pb + 6)) REPFOR(7) {
                REPBAR; PHASE_TID;
                const float* g2 = AIN(19) + D; const float* rw = AIN(22);
                LAS int* hist = (LAS int*)lds;
                f32x4 RW[4][4][2];
#pragma unroll
                for (int j = 0; j < 4; ++j)
#pragma unroll
                    for (int q = 0; q < 4; ++q) { const f32x4* rp = (const f32x4*)(rw + (size_t)((lane + 64 * j) * 4 + q) * 8); RW[j][q][0] = rp[0]; RW[j][q][1] = rp[1]; }
                for (int ch = bx; ch < 256; ch += G) {
                    if (tid < 16) hist[tid] = 0;
                    __syncthreads();
#pragma unroll 1
                    for (int i = 0; i < 16; i += 4) router_rows4(P_HS, ch * 128 + wave * 16 + i, g2, RW, (unsigned char*)P_XN, P_tok_e, P_tok_w, hist, lane);
                    __syncthreads();
                    if (tid < 16) P_cnts[ch * 16 + tid] = hist[tid];
                    __syncthreads();
                }
            }
            SEAM(pb + 6);
            if (IN(pb + 7)) REPFOR(9) {
                REPBAR; PHASE_TID;
                LAS int* C = (LAS int*)lds;
                LAS int* PT = C + 4096;
                LAS int* TOT = PT + 1024; LAS int* BASE = TOT + 16; LAS int* PRE = BASE + 32; LAS int* W0C = PRE + 16;
                for (int i = tid; i < 4096; i += 512) C[i] = P_cnts[i];
                __syncthreads();
                { const int g = tid & 15, part = tid >> 4; int s_ = 0;
#pragma unroll
                  for (int c = 0; c < 8; ++c) s_ += C[(part * 8 + c) * 16 + g];
                  PT[part * 16 + g] = s_; }
                __syncthreads();
                if (tid < 16) { int s_ = 0; for (int q = 0; q < 32; ++q) s_ += PT[q * 16 + tid]; TOT[tid] = s_; }
                __syncthreads();
                if (tid == 0) { int b_ = 0; for (int g = 0; g < 16; ++g) { BASE[g] = b_; b_ += (TOT[g] + 255) & ~255; } BASE[16] = b_; }
                __syncthreads();
                if (bx == 0 && tid < 17) P_gbases[tid] = BASE[tid];
                for (int g = bx; g < 16; g += G) { for (int s_ = BASE[g] + TOT[g] + tid; s_ < BASE[g + 1]; s_ += 512) { P_slot_tok[s_] = -1; P_slot_w[s_] = 0.f; } }
                for (int ch = bx; ch < 256; ch += G) {
                    { const int g = tid & 15, part = tid >> 4; int s_ = 0;
#pragma unroll
                      for (int c = 0; c < 8; ++c) { const int cc = part * 8 + c; s_ += cc < ch ? C[cc * 16 + g] : 0; }
                      PT[512 + part * 16 + g] = s_; }
                    __syncthreads();
                    if (tid < 16) { int s_ = 0; for (int q = 0; q < 32; ++q) s_ += PT[512 + q * 16 + tid]; PRE[tid] = s_; }
                    int e0 = 0, e1 = 0, p0 = 0, p1 = 0;
                    if (tid < 128) { const int t = ch * 128 + tid; e0 = P_tok_e[2 * t]; e1 = 8 + P_tok_e[2 * t + 1];
#pragma unroll
                        for (int g = 0; g < 8; ++g) {
                            const unsigned long long m0 = __ballot(e0 == g), m1 = __ballot(e1 == 8 + g);
                            const int b0 = (int)__builtin_amdgcn_mbcnt_hi((unsigned)(m0 >> 32), __builtin_amdgcn_mbcnt_lo((unsigned)m0, 0u)), b1 = (int)__builtin_amdgcn_mbcnt_hi((unsigned)(m1 >> 32), __builtin_amdgcn_mbcnt_lo((unsigned)m1, 0u));
                            if (e0 == g) p0 = b0;
                            if (e1 == 8 + g) p1 = b1;
                            if (tid == 0) { W0C[g] = __popcll(m0); W0C[8 + g] = __popcll(m1); }
                        } }
                    __syncthreads();
                    if (tid < 128) { const int t = ch * 128 + tid;
                        if (tid >= 64) { p0 += W0C[e0]; p1 += W0C[e1]; }
                        const int s0 = BASE[e0] + PRE[e0] + p0, s1 = BASE[e1] + PRE[e1] + p1;
                        P_slot_tok[s0] = t; P_slot_w[s0] = P_tok_w[2 * t] * (1.0f / (pg8::F8S_ACT * pg8::F8S_WDN)); P_slot_tok[s1] = t; P_slot_w[s1] = P_tok_w[2 * t + 1] * (1.0f / (pg8::F8S_ACT * pg8::F8S_WDN)); }
                    __syncthreads();
                }
            }
            SEAM(pb + 7);
            LAS int* tg = (LAS int*)(lds + TG_OFF);
            if (IN(pb + 8) || IN(pb + 9) || IN(pb + 10) || IN(pb + 11)) {
                PHASE_TID;
                if (tid < 288) { const int r = tid * 256; int g = 0; int gb[16];
#pragma unroll
                    for (int q = 0; q < 16; ++q) gb[q] = P_gbases[q];
#pragma unroll
                    for (int q = 1; q < 16; ++q) if (r >= gb[q]) g = q;
                    tg[tid] = g; }
                __syncthreads();
            }
            if (IN(pb + 8)) REPFOR(10) {
                REPBAR;
                const int nT = __builtin_amdgcn_readfirstlane(P_gbases[16] >> 8);
                pg8::Gemm g{(const char*)P_XN, D / 2, D / 2}; pg8::SchedMoe1 S{nT, G, bx, (const char*)P_Wb + WOFF_MGU, P_slot_tok, tg};
                pg8::EpiSwi8<true> E{(unsigned char*)P_Z, DFE};
                pg8::gemm_phase<pg8::EpiSwi8<true>, pg8::SchedMoe1, true, true>(lds, g, S, E, wave);
            }
            SEAM(pb + 8);
            if (IN(pb + 9)) {
                const int t0 = 0, nT = 128;
                pg8::Gemm g{(const char*)P_Z, DFE / 2, DFE / 2}; pg8::SchedMoe2 S{t0, nT, G, bx, (const char*)P_Wb + WOFF_MDN, tg};
                pg8::EpiMoeDown<true> E{P_slot_tok, P_slot_w, P_out, P_HS};
                pg8::gemm_phase<pg8::EpiMoeDown<true>, pg8::SchedMoe2, true, true>(lds, g, S, E, wave);
            }
            SEAM(pb + 9);
            if (IN(pb + 10)) {
                const int t0 = __builtin_amdgcn_readfirstlane(P_gbases[8] >> 8), nT = 128;
                {
                    PHASE_TID; const int t2 = __builtin_amdgcn_readfirstlane(P_gbases[16] >> 8);
                    for (int s_ = (t0 + 128) * 256 + gw; s_ < t2 * 256; s_ += NGW) { const int tok = __builtin_amdgcn_readfirstlane(P_slot_tok[s_]);
                        if (tok >= 0) {
#pragma unroll
                            for (int j = 0; j < 4; ++j) { const u32x2 h2 = ((const u32x2*)(P_HS + (size_t)tok * D))[lane + 64 * j];
                                ((f32x4*)(P_out + (size_t)tok * D))[lane + 64 * j] = (f32x4){__uint_as_float(h2.x << 16), __uint_as_float(h2.x & 0xffff0000u), __uint_as_float(h2.y << 16), __uint_as_float(h2.y & 0xffff0000u)}; } } }
                }
                pg8::Gemm g{(const char*)P_Z, DFE / 2, DFE / 2}; pg8::SchedMoe2 S{t0, nT, G, bx, (const char*)P_Wb + WOFF_MDN, tg};
                pg8::EpiMoeDown<false> E{P_slot_tok, P_slot_w, P_out, P_HS};
                pg8::gemm_phase<pg8::EpiMoeDown<false>, pg8::SchedMoe2, true, true>(lds, g, S, E, wave);
            }
            SEAM(pb + 10);
            if (IN(pb + 11)) {
                const int t1 = __builtin_amdgcn_readfirstlane(P_gbases[8] >> 8), s0 = t1 - 128, s1 = __builtin_amdgcn_readfirstlane(P_gbases[16] >> 8) - t1 - 128;
                pg8::Gemm g{(const char*)P_Z, DFE / 2, DFE / 2}; pg8::SchedMoe3 S{s0, s1, t1, G, bx, (const char*)P_Wb + WOFF_MDN, tg};
                pg8::EpiMoeDownAtomic E{P_slot_tok, P_slot_w, P_out};
                pg8::gemm_phase<pg8::EpiMoeDownAtomic, pg8::SchedMoe3, true, true>(lds, g, S, E, wave);
            }
        }
    }
#undef IN
#undef SEAM
#undef REPFOR
#undef REPBAR
#undef PHASE_TID
}

static void launch_mega(const Args& base, int lo, int hi, int grid, unsigned char* ws, hipStream_t stream) {
    Args a = base; a.ph_lo = lo; a.ph_hi = hi;
    (void)hipMemsetAsync(ws + WS_CTL, 0, CTL_ZERO_BYTES, stream);
    hipLaunchKernelGGL(mega, dim3(grid), dim3(NWAVES * 64), LDS_BYTES, stream, a);
}

extern "C" void kernel_launch(void* const* d_in, const int* in_sizes, int n_in, void* d_out, int out_size, void* d_ws, size_t ws_size, hipStream_t stream) {
    float* out = (float*)d_out;
    unsigned char* ws = (unsigned char*)d_ws;

    static int grid = 0;
    if (grid == 0) {
        if (n_in != 25 || ws_size < WS_END) { fprintf(stderr, "kernel_launch: n_in %d ws %zu (need %zu)\n", n_in, ws_size, (size_t)WS_END); grid = -1; return; }
        int dev = 0, cus = 0, per_cu = 0;
        if (hipGetDevice(&dev) != hipSuccess || hipDeviceGetAttribute(&cus, hipDeviceAttributeMultiprocessorCount, dev) != hipSuccess) { grid = -1; return; }
        if (hipFuncSetAttribute((const void*)mega, hipFuncAttributeMaxDynamicSharedMemorySize, LDS_BYTES) != hipSuccess) { fprintf(stderr, "hipFuncSetAttribute failed\n"); grid = -1; return; }
        if (hipOccupancyMaxActiveBlocksPerMultiprocessor(&per_cu, (const void*)mega, NWAVES * 64, LDS_BYTES) != hipSuccess || per_cu < 1) { fprintf(stderr, "occupancy query: %d\n", per_cu); }
        (void)hipGetLastError();
        grid = cus;
    }
    if (grid < 0) return;
    Args base{};
    for (int i = 0; i < 25; ++i) base.in[i] = (const float*)d_in[i];
    base.out = out; base.ws = ws;

    launch_mega(base, 0, 29, grid, ws, stream);
}
```
